# Optimizing an MI355X kernel written in HIP

```python
import math
import jax, jax.numpy as jnp
from jax import lax
import numpy as np


D_MODEL = 1024
BATCH = 16
SEQ = 4096
DEPTH = 4

N_MIXERS = 2
SB_HEADS = 16
SB_HEAD_DIM = D_MODEL // SB_HEADS
SB_BLOCK = 128
HG_EXPAND = 128
HG_HEADS = D_MODEL // HG_EXPAND
HG_DK = HG_EXPAND
HG_DV = D_MODEL // HG_HEADS
HG_CHUNK = 32
D_FF = 7 * D_MODEL // 2
N_EXPERTS = 8
TOP_K = 2
N_SB = (DEPTH + 1) // 2
N_HG = DEPTH // 2
N_DENSE = (DEPTH + 1) // 2
N_MOE = DEPTH // 2
DEEPNORM_ALPHA = (2.0 * DEPTH) ** 0.25
DEEPNORM_BETA = (8.0 * DEPTH) ** -0.25
LN_EPS = 1e-5
RMS_EPS = 1e-6

kernel_name = 'hybrid_stickbreaking_hgrn2_moe_trunk'


def layer_norm(x, g, b):
    xf = x.astype(jnp.float32)
    mu = jnp.mean(xf, axis=-1, keepdims=True)
    var = jnp.mean(jnp.square(xf - mu), axis=-1, keepdims=True)
    y = (xf - mu) * lax.rsqrt(var + LN_EPS)
    return (y * g.astype(jnp.float32) + b.astype(jnp.float32)).astype(x.dtype)


def swiglu(h, w13, w2):
    a, b = jnp.split(h @ w13, 2, axis=-1)
    return (jax.nn.silu(a) * b) @ w2


def stick_breaking_attention(h, w_qkv, w_o):
    bsz, seq, _ = h.shape
    q, k, v = jnp.split(h @ w_qkv, 3, axis=-1)

    def heads(t):
        return t.reshape(bsz, seq, SB_HEADS, SB_HEAD_DIM).transpose(0, 2, 1, 3)

    q, k, v = heads(q) * (SB_HEAD_DIM ** -0.5), heads(k), heads(v)
    outs = []
    for blk in range(seq // SB_BLOCK):
        t0, t1 = blk * SB_BLOCK, (blk + 1) * SB_BLOCK
        z = jnp.einsum('bhtd,bhsd->bhts', q[:, :, t0:t1], k[:, :, :t1]).astype(jnp.float32)
        strict = jnp.arange(t1)[None, :] < jnp.arange(t0, t1)[:, None]
        log_beta = jax.nn.log_sigmoid(z)
        log_1m_beta = jnp.where(strict, log_beta - z, 0.0)
        between = lax.cumsum(log_1m_beta, axis=3, reverse=True) - log_1m_beta
        a = jnp.where(strict, jnp.exp(log_beta + between), 0.0)
        outs.append(jnp.einsum('bhts,bhsd->bhtd', a.astype(v.dtype), v[:, :, :t1]))
    o = jnp.concatenate(outs, axis=2).transpose(0, 2, 1, 3).reshape(bsz, seq, D_MODEL)
    return o @ w_o


def hgrn2_recurrence(h, w_in, norm_g, w_o, lower_bound):
    bsz, seq, _ = h.shape
    n_chunks = seq // HG_CHUNK
    q, f, i, g = jnp.split(h @ w_in, 4, axis=-1)
    lb = lower_bound.astype(jnp.float32)
    ff = f.astype(jnp.float32)
    log_forget = jnp.log(lb + (1.0 - lb) * jax.nn.sigmoid(ff))
    key_in = (1.0 - lb) * jax.nn.sigmoid(-ff)

    def chunks(t, dh):
        t = t.astype(jnp.float32).reshape(bsz, n_chunks, HG_CHUNK, HG_HEADS, dh)
        return t.transpose(1, 0, 3, 2, 4)

    xs = (chunks(q, HG_DK), chunks(key_in, HG_DK), chunks(i, HG_DV), chunks(log_forget, HG_DK))
    causal = jnp.tril(jnp.ones((HG_CHUNK, HG_CHUNK), dtype=bool))
    mid = HG_CHUNK // 2

    def chunk_step(state, inp):
        qc, kc, vc, gc = inp
        cum = jnp.cumsum(gc, axis=2)
        g_ref = cum[:, :, mid - 1:mid]
        g_end = cum[:, :, HG_CHUNK - 1:]
        scores = jnp.einsum('bhtd,bhsd->bhts', qc * jnp.exp(cum - g_ref), kc * jnp.exp(g_ref - cum))
        scores = jnp.where(causal, scores, 0.0)
        o = (jnp.einsum('bhts,bhsv->bhtv', scores, vc)
             + jnp.einsum('bhtd,bhdv->bhtv', qc * jnp.exp(cum), state))
        new_state = (jnp.exp(g_end)[:, :, 0, :, None] * state
                     + jnp.einsum('bhsd,bhsv->bhdv', kc * jnp.exp(g_end - cum), vc))
        return new_state, o

    s0 = jnp.zeros((bsz, HG_HEADS, HG_DK, HG_DV), jnp.float32)
    _, o = lax.scan(chunk_step, s0, xs)
    o = o.transpose(1, 0, 3, 2, 4).reshape(bsz, seq, HG_HEADS, HG_DV)
    o = o * lax.rsqrt(jnp.mean(jnp.square(o), axis=-1, keepdims=True) + RMS_EPS) * norm_g.astype(jnp.float32)
    gate = jax.nn.silu(g.astype(jnp.float32)).reshape(bsz, seq, HG_HEADS, HG_DV)
    return (o * gate).reshape(bsz, seq, D_MODEL).astype(h.dtype) @ w_o


def moe_swiglu(h, router, w13, w2):
    logits = (h @ router).astype(jnp.float32)
    top_logits, top_idx = lax.top_k(logits, TOP_K)
    top_w = jax.nn.softmax(top_logits, axis=-1)
    gates = jnp.sum(jax.nn.one_hot(top_idx, N_EXPERTS, dtype=jnp.float32) * top_w[..., None], axis=-2)
    gates = gates.astype(h.dtype)
    out = jnp.zeros_like(h)
    for e in range(N_EXPERTS):
        out = out + gates[..., e:e + 1] * swiglu(h, w13[e], w2[e])
    return out


def setup_inputs(seed: int = 0) -> dict:
    key = jax.random.key(seed)
    ks = jax.random.split(key, 19)

    def normal(k, shape, scale):
        return scale * jax.random.normal(k, shape, jnp.float32)

    d, f = D_MODEL, D_FF
    return {
        'x': normal(ks[0], (BATCH, SEQ, d), 1.0),
        'c': normal(ks[1], (BATCH, d), 1.0),
        'ada_w': normal(ks[2], (DEPTH, d, 6 * d), 0.5 * d ** -0.5),
        'ada_b': normal(ks[3], (DEPTH, 6 * d), 0.02),
        'ln1_g': 1.0 + normal(ks[4], (DEPTH, d), 0.02),
        'ln1_b': normal(ks[5], (DEPTH, d), 0.02),
        'ln2_g': 1.0 + normal(ks[6], (DEPTH, d), 0.02),
        'ln2_b': normal(ks[7], (DEPTH, d), 0.02),
        'sb_w_qkv': normal(ks[8], (N_SB, d, 3 * d), d ** -0.5),
        'sb_w_o': normal(ks[9], (N_SB, d, d), DEEPNORM_BETA * d ** -0.5),
        'hg_w_in': normal(ks[10], (N_HG, d, 4 * d), d ** -0.5),
        'hg_norm_g': 1.0 + normal(ks[11], (N_HG, HG_DV), 0.02),
        'hg_w_o': normal(ks[12], (N_HG, d, d), DEEPNORM_BETA * d ** -0.5),
        'hg_lb_logits': normal(ks[13], (DEPTH, d), 0.5),
        'ffn_w13': normal(ks[14], (N_DENSE, d, 2 * f), d ** -0.5),
        'ffn_w2': normal(ks[15], (N_DENSE, f, d), DEEPNORM_BETA * f ** -0.5),
        'moe_router': normal(ks[16], (N_MOE, d, N_EXPERTS), d ** -0.5),
        'moe_w13': normal(ks[17], (N_MOE, N_EXPERTS, d, 2 * f), d ** -0.5),
        'moe_w2': normal(ks[18], (N_MOE, N_EXPERTS, f, d), DEEPNORM_BETA * f ** -0.5),
    }


def reference(x, c, ada_w, ada_b, ln1_g, ln1_b, ln2_g, ln2_b, sb_w_qkv, sb_w_o, hg_w_in, hg_norm_g,
              hg_w_o, hg_lb_logits, ffn_w13, ffn_w2, moe_router, moe_w13, moe_w2):
    p = jax.nn.softmax(hg_lb_logits.astype(jnp.float32), axis=0)
    lb_table = jnp.cumsum(p, axis=0) - p[0:1]
    cond = jax.nn.silu(c)
    for layer in range(DEPTH):
        mod = (cond @ ada_w[layer] + ada_b[layer])[:, None, :]
        shift1, scale1, gate1, shift2, scale2, gate2 = jnp.split(mod, 6, axis=-1)
        j = layer // N_MIXERS
        h = x * (1.0 + scale1) + shift1
        if layer % N_MIXERS == 0:
            y = stick_breaking_attention(h, sb_w_qkv[j], sb_w_o[j])
        else:
            y = hgrn2_recurrence(h, hg_w_in[j], hg_norm_g[j], hg_w_o[j], lb_table[layer])
        x = layer_norm(DEEPNORM_ALPHA * x + gate1 * y, ln1_g[layer], ln1_b[layer])
        h = x * (1.0 + scale2) + shift2
        if layer % 2 == 0:
            y = swiglu(h, ffn_w13[j], ffn_w2[j])
        else:
            y = moe_swiglu(h, moe_router[j], moe_w13[j], moe_w2[j])
        x = layer_norm(DEEPNORM_ALPHA * x + gate2 * y, ln2_g[layer], ln2_b[layer])
    return x
```

```cpp
#include <hip/hip_runtime.h>
#include <cstdio>
#include <cstdint>
#include <cmath>
namespace pg8 {
#define PG8_LAS __attribute__((address_space(3)))
typedef unsigned short bf16_t;
typedef short bf16x8 __attribute__((ext_vector_type(8)));
typedef float f32x4 __attribute__((ext_vector_type(4)));
typedef unsigned u32x4 __attribute__((ext_vector_type(4)));
constexpr int BM = 256, BK = 64, HALF = 128, HTB = HALF * BK * 2  , STAGE_BYTES = 8 * HTB, NXCD = 8, WGM = 8;

__host__ __device__ __forceinline__ int lds_byte(int r, int c) { const int st = (r >> 4) * 2 + (c >> 5), rr = r & 15, cc = c & 31, ob = rr * 64 + cc * 2; return st * 1024 + (ob ^ (((ob >> 9) & 1) << 5)); }
__host__ __device__ __forceinline__ void stage_rc(int b, int& R, int& C) { const int st = b / 1024, sb = b % 1024, swz = sb ^ (((sb >> 9) & 1) << 5); R = (st >> 1) * 16 + swz / 64; C = (st & 1) * 32 + (swz % 64) / 2; }
__host__ __device__ __forceinline__ int perm32(int rho) { const int n = rho >> 4, i = rho & 15; return 8 * (i >> 2) + 4 * n + (i & 3); }

struct Unit { int pm, pn, eb; };
struct Gemm { const bf16_t* A; const bf16_t* Bt; int M, N, K; size_t estride; };

struct StaticOrder {
    int nM, nN, nwg, G, c;
    __host__ __device__ void init(int M, int N, int G_, int c_) { nM = M / BM; nN = N / BM; nwg = nM * nN; G = G_; c = c_; }
    __host__ __device__ bool next(int i, Unit& u) const {
        const long L = (long)i * G + c; if (L >= nwg) return false;
        int wgid = (int)L; { const int q = nwg / NXCD, r = nwg % NXCD, xcd = wgid % NXCD, off = wgid / NXCD; wgid = (xcd < r ? xcd * (q + 1) : r * (q + 1) + (xcd - r) * q) + off; }
        const int nig = WGM * nN, gid = wgid / nig, fm = gid * WGM, gsz = (nM - fm) < WGM ? (nM - fm) : WGM;
        u.pm = fm + ((wgid % nig) % gsz); u.pn = (wgid % nig) / gsz; u.eb = 0; return true;
    }
    __device__ __forceinline__ void a_ready(const Unit&) const {}
    __device__ __forceinline__ void done(const Unit&) const {}
};

__device__ __forceinline__ unsigned cvt_pk_bf16(float lo, float hi) { unsigned r; asm volatile("v_cvt_pk_bf16_f32 %0, %1, %2" : "=v"(r) : "v"(lo), "v"(hi)); return r; }
typedef float f32x2 __attribute__((ext_vector_type(2)));
__device__ __forceinline__ f32x2 gelu_pk(f32x2 v) {
    const f32x2 av = __builtin_elementwise_abs(v), d = av * 0.2316418882f + 1.0f;
    f32x2 t; t.x = __builtin_amdgcn_rcpf(d.x); t.y = __builtin_amdgcn_rcpf(d.y);
    f32x2 q = t * 0.5307027145f + (-0.7265760135f); q = q * t + 0.7107068705f; q = q * t + (-0.142248368f); q = q * t + 0.127414796f; q = q * t;
    const f32x2 s = (v * v) * (-0.72134752044f);
    f32x2 e; e.x = __builtin_amdgcn_exp2f(s.x); e.y = __builtin_amdgcn_exp2f(s.y);
    const f32x2 m = v * (q * e), r = v - m;
    f32x2 o; o.x = v.x < 0.f ? m.x : r.x; o.y = v.y < 0.f ? m.y : r.y; return o;
}

template <int ACT  > struct EpiBf16 {
    static constexpr bool PERM = true, AFTER_DRAIN = false; static_assert(ACT == 0 || ACT == 1, "EpiBf16: ACT is 0 (none) or 1 (gelu_pk)");
    bf16_t* O; int ldc; const float* bias; int split_cols; size_t split_stride; float scale0;
    __device__ __forceinline__ void operator()(const f32x4 (&acc)[2][2][4][2], const Unit& u, int wr, int wc, int fr, int fq) const {
        const int row0 = u.pm * BM + wr * 64 + fr; int colt = u.pn * BM; bf16_t* base = O;
        float sc = 1.f; if (split_cols) { const int t = colt / split_cols; base += (size_t)t * split_stride; colt -= t * split_cols; if (t == 0) sc = scale0; }
        const int col0 = colt + wc * 32 + 8 * fq, bcol0 = u.pn * BM + wc * 32 + 8 * fq;
        f32x4 bv[2][2];
#pragma unroll
        for (int bj = 0; bj < 2; ++bj)
#pragma unroll
            for (int n = 0; n < 2; ++n) bv[bj][n] = bias ? *(const f32x4*)(bias + bcol0 + bj * HALF + 4 * n) : (f32x4){0.f, 0.f, 0.f, 0.f};
#pragma unroll
        for (int ai = 0; ai < 2; ++ai)
#pragma unroll
            for (int m = 0; m < 4; ++m) { bf16_t* rowp = base + (size_t)(row0 + ai * HALF + m * 16) * ldc + col0;
#pragma unroll
                for (int bj = 0; bj < 2; ++bj) { f32x4 v0 = acc[ai][bj][m][0] + bv[bj][0], v1 = acc[ai][bj][m][1] + bv[bj][1];
                    if (ACT == 1) { f32x2 a = gelu_pk((f32x2){v0[0], v0[1]}), b = gelu_pk((f32x2){v0[2], v0[3]}), c = gelu_pk((f32x2){v1[0], v1[1]}), d = gelu_pk((f32x2){v1[2], v1[3]});
                        v0 = (f32x4){a.x, a.y, b.x, b.y}; v1 = (f32x4){c.x, c.y, d.x, d.y}; }
                    v0 = v0 * sc; v1 = v1 * sc; u32x4 w; w.x = cvt_pk_bf16(v0[0], v0[1]); w.y = cvt_pk_bf16(v0[2], v0[3]); w.z = cvt_pk_bf16(v1[0], v1[1]); w.w = cvt_pk_bf16(v1[2], v1[3]);
                    *(u32x4*)(rowp + bj * HALF) = w; } }
    }
};
__device__ __forceinline__ float fast_sigmoid(float v) { return __builtin_amdgcn_rcpf(1.0f + __builtin_amdgcn_exp2f(-1.4426950408889634f * v)); }
__device__ __forceinline__ float fast_silu(float v) { return v * fast_sigmoid(v); }
struct EpiSwiGLU {
    static constexpr bool PERM = true, AFTER_DRAIN = false;
    bf16_t* O; int ldc;
    __device__ __forceinline__ void operator()(const f32x4 (&acc)[2][2][4][2], const Unit& u, int wr, int wc, int fr, int fq) const {
        const int row0 = u.pm * BM + wr * 64 + fr, col0 = u.pn * HALF + wc * 32 + 8 * fq;
#pragma unroll
        for (int ai = 0; ai < 2; ++ai)
#pragma unroll
            for (int m = 0; m < 4; ++m) { bf16_t* rowp = O + (size_t)(row0 + ai * HALF + m * 16) * ldc + col0;
                const f32x4 a0 = acc[ai][0][m][0], a1 = acc[ai][0][m][1], b0 = acc[ai][1][m][0], b1 = acc[ai][1][m][1];
                u32x4 w; w.x = cvt_pk_bf16(fast_silu(a0[0]) * b0[0], fast_silu(a0[1]) * b0[1]); w.y = cvt_pk_bf16(fast_silu(a0[2]) * b0[2], fast_silu(a0[3]) * b0[3]);
                w.z = cvt_pk_bf16(fast_silu(a1[0]) * b1[0], fast_silu(a1[1]) * b1[1]); w.w = cvt_pk_bf16(fast_silu(a1[2]) * b1[2], fast_silu(a1[3]) * b1[3]);
                *(u32x4*)rowp = w; }
    }
};
struct EpiHgIn {
    static constexpr bool PERM = true, AFTER_DRAIN = false;
    unsigned char* base0; const float* lb;
    static constexpr size_t OFF_F = (size_t)128 << 20, OFF_I = (size_t)384 << 20, OFF_G = (size_t)512 << 20;
    __device__ __forceinline__ void operator()(const f32x4 (&acc)[2][2][4][2], const Unit& u, int wr, int wc, int fr, int fq) const {
        const int sec = u.pn >> 2, row0 = u.pm * BM + wr * 64 + fr, col0 = (u.pn & 3) * BM + wc * 32 + 8 * fq;
        if (sec == 1) {
#pragma unroll
            for (int bj = 0; bj < 2; ++bj)
#pragma unroll
                for (int n = 0; n < 2; ++n) { const f32x4 l = *(const f32x4*)(lb + col0 + bj * HALF + 4 * n);
#pragma unroll
                    for (int ai = 0; ai < 2; ++ai)
#pragma unroll
                        for (int m = 0; m < 4; ++m) { float* rowp = (float*)(base0 + OFF_F) + (size_t)(row0 + ai * HALF + m * 16) * 1024 + col0; const f32x4 v = acc[ai][bj][m][n]; f32x4 o;
#pragma unroll
                            for (int i = 0; i < 4; ++i) o[i] = l[i] + (1.0f - l[i]) * fast_sigmoid(v[i]);
                            *(f32x4*)(rowp + bj * HALF + 4 * n) = o; } }
        } else {
            bf16_t* base = (bf16_t*)(base0 + (sec == 0 ? (size_t)0 : (sec == 2 ? OFF_I : OFF_G))); const bool act = (sec == 3);
#pragma unroll
            for (int ai = 0; ai < 2; ++ai)
#pragma unroll
                for (int m = 0; m < 4; ++m) { bf16_t* rowp = base + (size_t)(row0 + ai * HALF + m * 16) * 1024 + col0;
#pragma unroll
                    for (int bj = 0; bj < 2; ++bj) { f32x4 v0 = acc[ai][bj][m][0], v1 = acc[ai][bj][m][1];
                        if (act) {
#pragma unroll
                            for (int i = 0; i < 4; ++i) { v0[i] = fast_silu(v0[i]); v1[i] = fast_silu(v1[i]); } }
                        u32x4 w; w.x = cvt_pk_bf16(v0[0], v0[1]); w.y = cvt_pk_bf16(v0[2], v0[3]); w.z = cvt_pk_bf16(v1[0], v1[1]); w.w = cvt_pk_bf16(v1[2], v1[3]);
                        *(u32x4*)(rowp + bj * HALF) = w; } }
        }
    }
};
struct GroupedOrder {
    int nM, nN, nwg, G, c; int tb[9];
    __device__ __forceinline__ void init(const unsigned (&cnt)[8], int N, int G_, int c_) {
        int s = 0;
#pragma unroll
        for (int e = 0; e < 8; ++e) { tb[e] = s; s += (int)((cnt[e] + 255u) >> 8); }
        tb[8] = s; nM = s; nN = N / BM; nwg = nM * nN; G = G_; c = c_; }
    __device__ __forceinline__ bool next(int i, Unit& u) const {
        const long L = (long)i * G + c; if (L >= nwg) return false;
        int wgid = (int)L; { const int q = nwg / NXCD, r = nwg % NXCD, xcd = wgid % NXCD, off = wgid / NXCD; wgid = (xcd < r ? xcd * (q + 1) : r * (q + 1) + (xcd - r) * q) + off; }
        const int nig = WGM * nN, gid = wgid / nig, fm = gid * WGM, gsz = (nM - fm) < WGM ? (nM - fm) : WGM;
        u.pm = fm + ((wgid % nig) % gsz); u.pn = (wgid % nig) / gsz;
        int e = 0;
#pragma unroll
        for (int j = 1; j < 8; ++j) e += (u.pm >= tb[j]) ? 1 : 0;
        u.eb = e; return true;
    }
    __device__ __forceinline__ void a_ready(const Unit&) const {}
    __device__ __forceinline__ void done(const Unit&) const {}
};
template <class Epi, class Sched, bool ALIGN_EPI = false, bool SP2 = false>
__device__ __forceinline__ void gemm_phase(PG8_LAS unsigned char* lds, const Gemm g, const Sched& S, const Epi& E) {
    int tid_ = threadIdx.x; asm volatile("" : "+v"(tid_));
    const int tid = tid_, wid = __builtin_amdgcn_readfirstlane(tid >> 6), lane = tid & 63, wr = wid >> 2, wc = wid & 3, fr = lane & 15, fq = lane >> 4;
    const int K = g.K, nt = K / BK;
    unsigned voffA[2], voffB[2];
#pragma unroll
    for (int i = 0; i < 2; ++i) { int R, C; stage_rc(tid * 16 + i * 8192, R, C); const int Rb = Epi::PERM ? ((R & ~31) + perm32(R & 31)) : R;
        voffA[i] = (unsigned)(R * K + C) * 2u; voffB[i] = (unsigned)(Rb * K + C) * 2u; }
    const size_t kstep = (size_t)(BK * 2);
    const size_t hstep = (size_t)HALF * K * 2;
    const size_t tstep = 2 * hstep;
    const unsigned ldsw = (unsigned)wid * 1024u;
    const int aoff = lds_byte(wr * 64 + fr, fq * 8), boff = lds_byte(wc * 32 + fr, fq * 8);
#define PG8_SA(b, h) (((b) * 2 + (h)) * HTB)
#define PG8_SB(b, h) ((4 + (b) * 2 + (h)) * HTB)
#define PG8_STAGE(bufoff, gbase, voff) do { _Pragma("unroll") for (int _i = 0; _i < 2; ++_i) \
        __builtin_amdgcn_global_load_lds((const unsigned*)((const char*)(gbase) + (voff)[_i]), (PG8_LAS unsigned*)(lds + (bufoff) + ldsw + _i * 8192), 16, 0, 0); } while (0)
#define PG8_LDA(dst, b, h) do { _Pragma("unroll") for (int m = 0; m < 4; ++m) _Pragma("unroll") for (int k = 0; k < 2; ++k) dst[m][k] = *(const PG8_LAS bf16x8*)(lds + PG8_SA(b, h) + aoff + m * 2048 + k * 1024); } while (0)
#define PG8_LDB(dst, b, h) do { _Pragma("unroll") for (int n = 0; n < 2; ++n) _Pragma("unroll") for (int k = 0; k < 2; ++k) dst[n][k] = *(const PG8_LAS bf16x8*)(lds + PG8_SB(b, h) + boff + n * 2048 + k * 1024); } while (0)
#define PG8_MMA(ai, bj, At, Bt) do { __builtin_amdgcn_s_setprio(1); _Pragma("unroll") for (int m = 0; m < 4; ++m) _Pragma("unroll") for (int n = 0; n < 2; ++n) _Pragma("unroll") for (int k = 0; k < 2; ++k) \
        acc[ai][bj][m][n] = __builtin_amdgcn_mfma_f32_16x16x32_bf16(Bt[n][k], At[m][k], acc[ai][bj][m][n], 0, 0, 0); __builtin_amdgcn_s_setprio(0); } while (0)
#define PG8_WAIT_V(n) asm volatile("s_waitcnt vmcnt(" #n ")" ::: "memory")
#define PG8_WAIT_L(n) asm volatile("s_waitcnt lgkmcnt(" #n ")" ::: "memory")
#define PG8_BAR __builtin_amdgcn_s_barrier()
#define PG8_SCHED __builtin_amdgcn_sched_barrier(0)
    Unit cur, nxt; int ui = 0;
    if (!S.next(0, cur)) return;
    f32x4 acc[2][2][4][2];
#pragma unroll
    for (int a = 0; a < 2; ++a)
#pragma unroll
        for (int b = 0; b < 2; ++b)
#pragma unroll
            for (int m = 0; m < 4; ++m)
#pragma unroll
                for (int n = 0; n < 2; ++n) acc[a][b][m][n] = (f32x4){0.f, 0.f, 0.f, 0.f};
    bf16x8 At[4][2], B0[2][2], B1[2][2];
    const char* cA = (const char*)g.A + (size_t)cur.pm * tstep; const char* cB = (const char*)g.Bt + (size_t)cur.eb * g.estride + (size_t)cur.pn * tstep;
    S.a_ready(cur);
    if constexpr (SP2) {
        PG8_STAGE(PG8_SB(0, 0), cB, voffB); PG8_STAGE(PG8_SB(0, 1), cB + hstep, voffB); PG8_STAGE(PG8_SA(0, 0), cA, voffA); PG8_STAGE(PG8_SA(0, 1), cA + hstep, voffA);
        if (wr == 1) PG8_BAR;
        PG8_WAIT_V(2); PG8_BAR;
        PG8_STAGE(PG8_SB(1, 0), cB + kstep, voffB); PG8_STAGE(PG8_SA(1, 0), cA + kstep, voffA); PG8_STAGE(PG8_SB(1, 1), cB + hstep + kstep, voffB);
        PG8_WAIT_V(6); PG8_BAR;
    } else {
        PG8_STAGE(PG8_SB(0, 0), cB, voffB); PG8_STAGE(PG8_SA(0, 0), cA, voffA); PG8_STAGE(PG8_SB(0, 1), cB + hstep, voffB); PG8_STAGE(PG8_SA(0, 1), cA + hstep, voffA);
        if (wr == 1) PG8_BAR;
        PG8_WAIT_V(4); PG8_BAR;
        PG8_STAGE(PG8_SB(1, 0), cB + kstep, voffB); PG8_STAGE(PG8_SA(1, 0), cA + kstep, voffA); PG8_STAGE(PG8_SB(1, 1), cB + hstep + kstep, voffB);
        PG8_WAIT_V(6); PG8_BAR;
    }
    for (;;) {
        const bool has_next = S.next(ui + 1, nxt);
        const char* nA = has_next ? (const char*)g.A + (size_t)nxt.pm * tstep : cA; const char* nB = has_next ? (const char*)g.Bt + (size_t)nxt.eb * g.estride + (size_t)nxt.pn * tstep : cB;
        for (int t = 0; t < nt; t += 2) {
            const bool last = (t == nt - 2);
            const char* a1 = cA + (size_t)(t + 1) * kstep;
            const char* a2 = last ? nA : cA + (size_t)(t + 2) * kstep; const char* b2 = last ? nB : cB + (size_t)(t + 2) * kstep;
            const char* a3 = a2 + kstep; const char* b3 = b2 + kstep;
            if (last && has_next) S.a_ready(nxt);
            if constexpr (SP2) {
            PG8_LDB(B0, 0, 0); PG8_LDB(B1, 0, 1); PG8_SCHED; PG8_LDA(At, 0, 0); PG8_STAGE(PG8_SA(1, 1), a1 + hstep, voffA);
            PG8_WAIT_V(8); PG8_WAIT_L(0); PG8_BAR; PG8_MMA(0, 0, At, B0); PG8_MMA(0, 1, At, B1); PG8_BAR; PG8_SCHED;
            PG8_LDA(At, 0, 1); PG8_STAGE(PG8_SB(0, 0), b2, voffB); PG8_STAGE(PG8_SB(0, 1), b2 + hstep, voffB); PG8_STAGE(PG8_SA(0, 0), a2, voffA);
            PG8_WAIT_V(8); PG8_WAIT_L(0); PG8_BAR; PG8_MMA(1, 0, At, B0); PG8_MMA(1, 1, At, B1); PG8_BAR; PG8_SCHED;
            PG8_LDB(B0, 1, 0); PG8_LDB(B1, 1, 1); PG8_SCHED; PG8_LDA(At, 1, 0); PG8_STAGE(PG8_SA(0, 1), a2 + hstep, voffA);
            PG8_WAIT_V(8); PG8_WAIT_L(0); PG8_BAR; PG8_MMA(0, 0, At, B0); PG8_MMA(0, 1, At, B1); PG8_BAR; PG8_SCHED;
            PG8_LDA(At, 1, 1); PG8_STAGE(PG8_SB(1, 0), b3, voffB); PG8_STAGE(PG8_SB(1, 1), b3 + hstep, voffB); PG8_STAGE(PG8_SA(1, 0), a3, voffA);
            PG8_WAIT_V(8); PG8_WAIT_L(0); PG8_BAR; PG8_MMA(1, 0, At, B0); PG8_MMA(1, 1, At, B1); PG8_BAR; PG8_SCHED;
            } else {
            PG8_LDB(B0, 0, 0); PG8_SCHED; PG8_LDA(At, 0, 0); PG8_STAGE(PG8_SA(1, 1), a1 + hstep, voffA);
            PG8_WAIT_L(8); PG8_BAR; PG8_WAIT_L(0); PG8_MMA(0, 0, At, B0); PG8_BAR; PG8_SCHED;
            PG8_LDB(B1, 0, 1); PG8_STAGE(PG8_SB(0, 0), b2, voffB);
            PG8_BAR; PG8_WAIT_L(0); PG8_MMA(0, 1, At, B1); PG8_BAR;
            PG8_LDA(At, 0, 1); PG8_STAGE(PG8_SA(0, 0), a2, voffA);
            PG8_BAR; PG8_WAIT_L(0); PG8_MMA(1, 0, At, B0); PG8_BAR; PG8_SCHED;
            PG8_STAGE(PG8_SB(0, 1), b2 + hstep, voffB);
            PG8_WAIT_V(6); PG8_BAR; PG8_MMA(1, 1, At, B1); PG8_BAR;
            PG8_LDB(B0, 1, 0); PG8_SCHED; PG8_LDA(At, 1, 0); PG8_STAGE(PG8_SA(0, 1), a2 + hstep, voffA);
            PG8_WAIT_L(8); PG8_BAR; PG8_WAIT_L(0); PG8_MMA(0, 0, At, B0); PG8_BAR; PG8_SCHED;
            PG8_LDB(B1, 1, 1); PG8_STAGE(PG8_SB(1, 0), b3, voffB);
            PG8_BAR; PG8_WAIT_L(0); PG8_MMA(0, 1, At, B1); PG8_BAR;
            PG8_LDA(At, 1, 1); PG8_STAGE(PG8_SA(1, 0), a3, voffA);
            PG8_BAR; PG8_WAIT_L(0); PG8_MMA(1, 0, At, B0); PG8_BAR; PG8_SCHED;
            PG8_STAGE(PG8_SB(1, 1), b3 + hstep, voffB);
            PG8_WAIT_V(6); PG8_BAR; PG8_MMA(1, 1, At, B1); PG8_BAR;
            }
        }
        if constexpr (ALIGN_EPI) { if (wr == 0) PG8_BAR; }
        if constexpr (!Epi::AFTER_DRAIN) { E(acc, cur, wr, wc, fr, fq); S.done(cur); }
        if (!has_next) break;
#pragma unroll
        for (int a = 0; a < 2; ++a)
#pragma unroll
            for (int b = 0; b < 2; ++b)
#pragma unroll
                for (int m = 0; m < 4; ++m)
#pragma unroll
                    for (int n = 0; n < 2; ++n) acc[a][b][m][n] = (f32x4){0.f, 0.f, 0.f, 0.f};
        cur = nxt; cA = nA; cB = nB; ++ui;
        if constexpr (ALIGN_EPI) { if (wr == 1) PG8_BAR; }
    }
    PG8_WAIT_V(0);
    if constexpr (!ALIGN_EPI) { if (wr == 0) PG8_BAR; }
    PG8_BAR;
    if constexpr (Epi::AFTER_DRAIN) { E.fused(acc, cur, wr, wc, fr, fq, lds, wid, lane); S.done(cur); }
#undef PG8_SA
#undef PG8_SB
#undef PG8_STAGE
#undef PG8_LDA
#undef PG8_LDB
#undef PG8_MMA
#undef PG8_WAIT_V
#undef PG8_WAIT_L
#undef PG8_BAR
#undef PG8_SCHED
}
}
#ifndef PG8_SP2
#define PG8_SP2 true
#endif
#ifndef PG8_ALIGN
#define PG8_ALIGN true
#endif

constexpr int NWAVES = 8;
constexpr int BATCH = 16, SEQ = 4096, D = 1024, M = BATCH * SEQ, FF = 3584, NEXP = 8, DEPTH = 4, NH_SB = 16, NH_HG = 8;
constexpr int MODW = 6 * D;
constexpr float LN_EPS = 1e-5f, RMS_EPS = 1e-6f, ALPHA = 1.6817928305074290861f;
constexpr int MPAD = 2 * M + NEXP * 256;
#ifndef MK_ONE_LAUNCH
#define MK_ONE_LAUNCH 0
#endif
constexpr int N_PHASES = 2 + 16 * 2;

constexpr size_t MiB = 1u << 20;
constexpr size_t WS_CTL = 0, CTL_ZERO_BYTES = 1 * MiB;
constexpr size_t WS_MOD = 2 * MiB;
constexpr size_t WS_LB = WS_MOD + 1536 * 1024 + 65536;
constexpr size_t WS_ROUTE = 4 * MiB;
constexpr size_t WS_W = 8 * MiB;
constexpr size_t W_SB_QKV = 0, W_SB_O = 6 * MiB, W_SB_13 = 8 * MiB, W_SB_2 = 22 * MiB;
constexpr size_t W_HG_IN = 0, W_HG_O = 8 * MiB, W_HG_13 = 10 * MiB, W_HG_2 = 122 * MiB;
constexpr size_t WS_H = 192 * MiB;
constexpr size_t WS_Y = 320 * MiB;
constexpr size_t WS_BIG = 448 * MiB;
constexpr size_t B_Q = WS_BIG, B_K = WS_BIG + 128 * MiB, B_V = WS_BIG + 256 * MiB, B_INTER = WS_BIG + 384 * MiB;
constexpr size_t B_HQ = WS_BIG, B_HF = WS_BIG + 128 * MiB, B_HI = WS_BIG + 384 * MiB, B_HGT = WS_BIG + 512 * MiB, B_HO = WS_BIG + 640 * MiB;
constexpr size_t B_HS = WS_BIG, B_MINTER = WS_BIG + 272 * MiB, B_YS = WS_BIG;
constexpr size_t WS_END = B_MINTER + (size_t)MPAD * FF * 2;
static_assert((size_t)MPAD * D * 2 <= 272 * MiB && WS_END <= 1792 * MiB, "d_ws map");
constexpr int CW_TMO = 0, CW_CODE = 1, CW_BAR = 4096, CW_CNT = 16384;

constexpr int RING_OFF = 0, RING_BYTES = 131072;
constexpr int LDSCTL_OFF = RING_BYTES, MISC_OFF = LDSCTL_OFF + 320;
constexpr int LDS_BYTES = 147456;
#define GAS __attribute__((address_space(1)))
#define LAS __attribute__((address_space(3)))
typedef unsigned short bf16;
typedef unsigned v4u __attribute__((ext_vector_type(4)));
typedef float f32x4 __attribute__((ext_vector_type(4)));
typedef short bf16x8 __attribute__((ext_vector_type(8)));
typedef GAS unsigned gu32;
typedef GAS unsigned long long gu64;
#define RLX_AGENT __ATOMIC_RELAXED, __HIP_MEMORY_SCOPE_AGENT
#define LDS_WAIT() asm volatile("s_waitcnt lgkmcnt(0)" ::: "memory")
#define VM_WAIT() asm volatile("s_waitcnt vmcnt(0)" ::: "memory")
__device__ __forceinline__ unsigned long long rt() { return __builtin_amdgcn_s_memrealtime(); }
__device__ __forceinline__ unsigned f2bf(float f) { unsigned u = __builtin_bit_cast(unsigned, f); return (u + 0x7fffu + ((u >> 16) & 1u)) >> 16; }
__device__ __forceinline__ unsigned pk2(float lo, float hi) { return f2bf(lo) | (f2bf(hi) << 16); }

#define XB_TMO      128
#define XB_XCNT(j)  (256  + 64 * (j))
#define XB_XSUB(j)  (1280 + 64 * (j))
#define XB_XGEN(j)  (2304 + 64 * (j))
#define XB_TOP      3328
#define XB_TOPGEN   3392
#define XCD_BAR_WORDS 3456
#define XB_SPIN_CAP (1u << 18)

__device__ __forceinline__ unsigned xb_ld(unsigned* p)              { return __hip_atomic_load(p, __ATOMIC_RELAXED, __HIP_MEMORY_SCOPE_AGENT); }
__device__ __forceinline__ unsigned xb_add(unsigned* p, unsigned v) { return __hip_atomic_fetch_add(p, v, __ATOMIC_RELAXED, __HIP_MEMORY_SCOPE_AGENT); }
__device__ __forceinline__ unsigned xb_xcc_id() { return (unsigned)__builtin_amdgcn_s_getreg((3 << 11) | 20) & 0xFu; }
#define XB_SPIN(cond, bar) do { unsigned _sp = 0; while (cond) { __builtin_amdgcn_s_sleep(1); \
    if ((++_sp & 255u) == 0u) { if (xb_ld(&(bar)[XB_TMO])) break; if (_sp > XB_SPIN_CAP) { atomicAdd(&(bar)[XB_TMO], 1u); break; } } } } while (0)

struct XcdBarrier {
    unsigned* bar; unsigned x;
    volatile LAS unsigned* st;
};

__device__ __forceinline__ XcdBarrier xcd_barrier_post(unsigned* bar, volatile LAS unsigned* st) {
    XcdBarrier b; b.bar = bar; b.x = xb_xcc_id(); b.st = st;
    if (threadIdx.x == 0) (void)xb_add(&bar[XB_XCNT(b.x)], 1u);
    return b;
}
__device__ __forceinline__ void xcd_barrier_complete(unsigned* bar, unsigned x, unsigned& nloc, unsigned& nx) {
    const unsigned G = gridDim.x * gridDim.y * gridDim.z;
    unsigned sum, cnt, mine, sp = 0u;
    for (;;) {
        sum = 0u; cnt = 0u; mine = 0u;
#pragma unroll
        for (unsigned j = 0; j < 16; ++j) { const unsigned c = xb_ld(&bar[XB_XCNT(j)]); sum += c; cnt += (c > 0u) ? 1u : 0u; mine = (j == x) ? c : mine; }
        if (sum == G) break;
        __builtin_amdgcn_s_sleep(1);
        if ((++sp & 255u) == 0u) { if (xb_ld(&bar[XB_TMO])) break; if (sp > XB_SPIN_CAP) { atomicAdd(&bar[XB_TMO], 1u); break; } }
    }
    nloc = mine > 0u ? mine : 1u; nx = cnt > 0u ? cnt : 1u;
}

__device__ __forceinline__ void xcd_barrier(const XcdBarrier& b) {
    asm volatile("s_waitcnt vmcnt(0)" ::: "memory");
    __syncthreads();
    if (threadIdx.x == 0) {
        unsigned* bar = b.bar;
        __builtin_amdgcn_s_waitcnt(0);
        unsigned nloc = b.st[0], nx = b.st[1];
        if (nloc == 0u) { xcd_barrier_complete(bar, b.x, nloc, nx); b.st[0] = nloc; b.st[1] = nx; }
        const unsigned old = xb_add(&bar[XB_XSUB(b.x)], 1u);
        const unsigned gen = old / nloc;
        if (old + 1u == (gen + 1u) * nloc) {
            __builtin_amdgcn_fence(__ATOMIC_RELEASE, "agent");
            asm volatile("s_waitcnt vmcnt(0)" ::: "memory");
            const unsigned og = xb_add(&bar[XB_TOP], 1u);
            const unsigned tg = og / nx;
            if (og + 1u == (tg + 1u) * nx) xb_add(&bar[XB_TOPGEN], 1u);
            else XB_SPIN(xb_ld(&bar[XB_TOPGEN]) == tg, bar);
            __builtin_amdgcn_fence(__ATOMIC_ACQUIRE, "agent");
            xb_add(&bar[XB_XGEN(b.x)], 1u);
            asm volatile("s_waitcnt vmcnt(0)" ::: "memory");
        } else {
            XB_SPIN(xb_ld(&bar[XB_XGEN(b.x)]) == gen, bar);
            __builtin_amdgcn_fence(__ATOMIC_ACQUIRE, "agent");
            asm volatile("s_waitcnt vmcnt(0)" ::: "memory");
        }
    }
    __syncthreads();
}

typedef unsigned u32x2 __attribute__((ext_vector_type(2)));
struct Frame {
    LAS unsigned char* lds;
    volatile LAS unsigned* MISC;
    gu32* ctl;
    int tid, lane, wave, vcu, G;
};
__device__ __forceinline__ float wave_sum(float v) {
#pragma unroll
    for (int o = 1; o < 64; o <<= 1) v += __shfl_xor(v, o);
    return v;
}
__device__ __forceinline__ float bf_lo(unsigned w) { return __uint_as_float(w << 16); }
__device__ __forceinline__ float bf_hi(unsigned w) { return __uint_as_float(w & 0xffff0000u); }
__device__ __forceinline__ float sigmoid_f(float v) { return 1.0f / (1.0f + __expf(-v)); }

__device__ __forceinline__ void conv_item(const float* W, int K, int N, bf16* WT, int drow0, LAS float* scr, int k0, int n0, int lane) {
#pragma unroll 8
    for (int i = 0; i < 32; ++i) { const int kk = 2 * i + (lane >> 5); scr[kk * 33 + (lane & 31)] = W[(size_t)(k0 + kk) * N + n0 + (lane & 31)]; }
    LDS_WAIT(); asm volatile("" ::: "memory");
    const int c = lane & 7;
#pragma unroll
    for (int j = 0; j < 4; ++j) { const int n = (lane >> 3) + 8 * j; const LAS float* s = scr + (8 * c) * 33 + n;
        v4u o; o.x = pk2(s[0 * 33], s[1 * 33]); o.y = pk2(s[2 * 33], s[3 * 33]); o.z = pk2(s[4 * 33], s[5 * 33]); o.w = pk2(s[6 * 33], s[7 * 33]);
        *(GAS v4u*)(WT + (size_t)(drow0 + n) * K + k0 + 8 * c) = o; }
    LDS_WAIT(); asm volatile("" ::: "memory");
}
__device__ __forceinline__ int swiglu_row(int n0) { const int bj = n0 / FF, jj = n0 % FF; return 256 * (jj / 128) + 128 * bj + (jj % 128); }
__device__ __forceinline__ void conv_sb(Frame& F, const float* wqkv, const float* wo, const float* w13, const float* w2, unsigned char* wbuf) {
    LAS float* scr = (LAS float*)(F.lds + RING_OFF + F.wave * 16384);
    const int gw = F.vcu * NWAVES + F.wave, NGW = F.G * NWAVES;
    constexpr int I_QKV = 16 * 96, I_O = 16 * 32, I_13 = 16 * 224, I_2 = 56 * 32, NIT = I_QKV + I_O + I_13 + I_2;
    for (int it = gw; it < NIT; it += NGW) {
        int r = it;
        if (r < I_QKV) { conv_item(wqkv, D, 3 * D, (bf16*)(wbuf + W_SB_QKV), 32 * (r % 96), scr, 64 * (r / 96), 32 * (r % 96), F.lane); continue; } r -= I_QKV;
        if (r < I_O) { conv_item(wo, D, D, (bf16*)(wbuf + W_SB_O), 32 * (r % 32), scr, 64 * (r / 32), 32 * (r % 32), F.lane); continue; } r -= I_O;
        if (r < I_13) { conv_item(w13, D, 2 * FF, (bf16*)(wbuf + W_SB_13), swiglu_row(32 * (r % 224)), scr, 64 * (r / 224), 32 * (r % 224), F.lane); continue; } r -= I_13;
        conv_item(w2, FF, D, (bf16*)(wbuf + W_SB_2), 32 * (r % 32), scr, 64 * (r / 32), 32 * (r % 32), F.lane);
    }
}
__device__ __forceinline__ void conv_hg(Frame& F, const float* win, const float* wo, const float* m13, const float* m2, unsigned char* wbuf) {
    LAS float* scr = (LAS float*)(F.lds + RING_OFF + F.wave * 16384);
    const int gw = F.vcu * NWAVES + F.wave, NGW = F.G * NWAVES;
    constexpr int I_IN = 16 * 128, I_O = 16 * 32, I_13 = 16 * 224, I_2 = 56 * 32, NIT = I_IN + I_O + NEXP * (I_13 + I_2);
    for (int it = gw; it < NIT; it += NGW) {
        int r = it;
        if (r < I_IN) { conv_item(win, D, 4 * D, (bf16*)(wbuf + W_HG_IN), 32 * (r % 128), scr, 64 * (r / 128), 32 * (r % 128), F.lane); continue; } r -= I_IN;
        if (r < I_O) { conv_item(wo, D, D, (bf16*)(wbuf + W_HG_O), 32 * (r % 32), scr, 64 * (r / 32), 32 * (r % 32), F.lane); continue; } r -= I_O;
        if (r < NEXP * I_13) { const int e = r / I_13, r2 = r % I_13;
            conv_item(m13 + (size_t)e * D * 2 * FF, D, 2 * FF, (bf16*)(wbuf + W_HG_13) + (size_t)e * 2 * FF * D, swiglu_row(32 * (r2 % 224)), scr, 64 * (r2 / 224), 32 * (r2 % 224), F.lane); continue; } r -= NEXP * I_13;
        { const int e = r / I_2, r2 = r % I_2;
            conv_item(m2 + (size_t)e * FF * D, FF, D, (bf16*)(wbuf + W_HG_2) + (size_t)e * D * FF, 32 * (r2 % 32), scr, 64 * (r2 / 32), 32 * (r2 % 32), F.lane); }
    }
}

__device__ __forceinline__ void mod_phase(Frame& F, const float* c, const float* ada_w, const float* ada_b, const float* lbl, float* mod, float* lbv) {
    LAS float* condT = (LAS float*)(F.lds + RING_OFF);
    LAS float* part = (LAS float*)(F.lds + RING_OFF + 65536);
    for (int idx = F.tid; idx < BATCH * D; idx += NWAVES * 64) { const int b = idx >> 10, k = idx & 1023; const float v = c[idx]; condT[k * 16 + b] = v * sigmoid_f(v); }
    __syncthreads();
    for (int it = blockIdx.x; it < DEPTH * (MODW / 64); it += F.G) {
        const int l = it / (MODW / 64), nb = it % (MODW / 64), n = nb * 64 + F.lane;
        float acc[16];
#pragma unroll
        for (int b = 0; b < 16; ++b) acc[b] = 0.f;
        const float* wp = ada_w + ((size_t)l * D + 128 * F.wave) * MODW + n;
#pragma unroll 4
        for (int k = 0; k < 128; ++k) { const float wv = wp[(size_t)k * MODW]; const LAS f32x4* cd = (const LAS f32x4*)(condT + (128 * F.wave + k) * 16);
#pragma unroll
            for (int q = 0; q < 4; ++q) { const f32x4 cv = cd[q]; acc[4 * q + 0] += cv[0] * wv; acc[4 * q + 1] += cv[1] * wv; acc[4 * q + 2] += cv[2] * wv; acc[4 * q + 3] += cv[3] * wv; } }
#pragma unroll
        for (int b = 0; b < 16; ++b) part[(F.wave * 16 + b) * 64 + F.lane] = acc[b];
        __syncthreads();
#pragma unroll
        for (int r = 0; r < 2; ++r) { const int idx = F.tid + 512 * r, b = idx >> 6, nn = idx & 63; float s = ada_b[l * MODW + nb * 64 + nn];
#pragma unroll
            for (int w = 0; w < 8; ++w) s += part[(w * 16 + b) * 64 + nn];
            mod[((size_t)l * BATCH + b) * MODW + nb * 64 + nn] = s; }
        __syncthreads();
    }
    if ((int)blockIdx.x == F.G - 1) {
        for (int d = F.tid; d < D; d += NWAVES * 64) { const float g0 = lbl[d], g1 = lbl[D + d], g2 = lbl[2 * D + d], g3 = lbl[3 * D + d];
            const float mx = fmaxf(fmaxf(g0, g1), fmaxf(g2, g3)); const float e0 = __expf(g0 - mx), e1 = __expf(g1 - mx), e2 = __expf(g2 - mx), e3 = __expf(g3 - mx); const float inv = 1.0f / (e0 + e1 + e2 + e3);
            lbv[d] = e1 * inv; lbv[D + d] = (e1 + e2 + e3) * inv; }
    }
    __syncthreads();
}

__device__ __forceinline__ void modulate_phase(Frame& F, const float* x, const float* mod0, bf16* H) {
    const int gw = F.vcu * NWAVES + F.wave, NGW = F.G * NWAVES;
    for (int it = gw; it < M / 32; it += NGW) {
        const int row0 = it * 32, b = row0 / SEQ; const float* mb = mod0 + (size_t)b * MODW;
        f32x4 sh[4], sc[4];
#pragma unroll
        for (int j = 0; j < 4; ++j) { sh[j] = *(const f32x4*)(mb + 256 * j + 4 * F.lane); sc[j] = *(const f32x4*)(mb + D + 256 * j + 4 * F.lane) + 1.0f; }
        for (int r = 0; r < 32; ++r) { const size_t m = (size_t)(row0 + r);
#pragma unroll
            for (int j = 0; j < 4; ++j) { const f32x4 v = *(const GAS f32x4*)(x + m * D + 256 * j + 4 * F.lane) * sc[j] + sh[j];
                u32x2 w; w.x = pk2(v[0], v[1]); w.y = pk2(v[2], v[3]); *(GAS u32x2*)(H + m * D + 256 * j + 4 * F.lane) = w; } }
    }
}

template <bool MOE_Y, bool ROUTE, bool HAS_H>
__device__ __forceinline__ void ln_phase(Frame& F, const float* xin, float* xout, const bf16* Y, const float* gatev, const float* gam, const float* bet,
                                         const float* nsc, const float* nsh, bf16* H, const float* router, unsigned* route, gu32* cnt) {
    const int gw = F.vcu * NWAVES + F.wave, NGW = F.G * NWAVES;
    LAS float* rl = (LAS float*)(F.lds + RING_OFF);
    if (ROUTE) { for (int i = F.tid; i < D * NEXP; i += NWAVES * 64) rl[(i & 7) * D + (i >> 3)] = router[i]; __syncthreads(); }
    unsigned rbase[8];
    if (MOE_Y) { unsigned s = 0;
#pragma unroll
        for (int e = 0; e < 8; ++e) { rbase[e] = s; const unsigned ce = (unsigned)__builtin_amdgcn_readfirstlane(__hip_atomic_load(cnt + 64 * e, RLX_AGENT)); s += ((ce + 255u) >> 8) << 8; } }
    for (int it = gw; it < M / 32; it += NGW) {
        const int row0 = it * 32, b = row0 / SEQ;
        f32x4 gt[4], gm[4], bt[4], sc[4], sh[4];
#pragma unroll
        for (int j = 0; j < 4; ++j) { const int cc = 256 * j + 4 * F.lane; gt[j] = *(const GAS f32x4*)(gatev + (size_t)b * MODW + cc); gm[j] = *(const f32x4*)(gam + cc); bt[j] = *(const f32x4*)(bet + cc);
            if (HAS_H) { sc[j] = *(const GAS f32x4*)(nsc + (size_t)b * MODW + cc) + 1.0f; sh[j] = *(const GAS f32x4*)(nsh + (size_t)b * MODW + cc); } }
        unsigned my_e1 = 0, my_e2 = 0; float my_w1 = 0.f, my_w2 = 0.f;
        for (int r = 0; r < 32; ++r) { const size_t m = (size_t)(row0 + r);
            f32x4 v[4]; float s = 0.f;
            if (MOE_Y) {
                const v4u r0 = *(const GAS v4u*)(route + m * 8), r1 = *(const GAS v4u*)(route + m * 8 + 4);
                unsigned ba = 0, bb = 0;
#pragma unroll
                for (int e = 0; e < 8; ++e) { ba = (r0.x == (unsigned)e) ? rbase[e] : ba; bb = (r0.z == (unsigned)e) ? rbase[e] : bb; }
                const size_t ra = (size_t)(ba + r0.y), rb = (size_t)(bb + r0.w); const float wa = __uint_as_float(r1.x), wb = __uint_as_float(r1.y);
#pragma unroll
                for (int j = 0; j < 4; ++j) { const int cc = 256 * j + 4 * F.lane; const f32x4 xv = *(const GAS f32x4*)(xin + m * D + cc);
                    const u32x2 ya = *(const GAS u32x2*)(Y + ra * D + cc), yb = *(const GAS u32x2*)(Y + rb * D + cc);
                    f32x4 yv; yv[0] = wa * bf_lo(ya.x) + wb * bf_lo(yb.x); yv[1] = wa * bf_hi(ya.x) + wb * bf_hi(yb.x); yv[2] = wa * bf_lo(ya.y) + wb * bf_lo(yb.y); yv[3] = wa * bf_hi(ya.y) + wb * bf_hi(yb.y);
                    v[j] = xv * ALPHA + gt[j] * yv; s += (v[j][0] + v[j][1]) + (v[j][2] + v[j][3]); }
            } else {
#pragma unroll
                for (int j = 0; j < 4; ++j) { const int cc = 256 * j + 4 * F.lane; const f32x4 xv = *(const GAS f32x4*)(xin + m * D + cc); const u32x2 yw = *(const GAS u32x2*)(Y + m * D + cc);
                    f32x4 yv; yv[0] = bf_lo(yw.x); yv[1] = bf_hi(yw.x); yv[2] = bf_lo(yw.y); yv[3] = bf_hi(yw.y);
                    v[j] = xv * ALPHA + gt[j] * yv; s += (v[j][0] + v[j][1]) + (v[j][2] + v[j][3]); }
            }
            const float mean = wave_sum(s) * (1.0f / D); float s2 = 0.f;
#pragma unroll
            for (int j = 0; j < 4; ++j) { v[j] = v[j] - mean; s2 += (v[j][0] * v[j][0] + v[j][1] * v[j][1]) + (v[j][2] * v[j][2] + v[j][3] * v[j][3]); }
            const float rstd = 1.0f / sqrtf(wave_sum(s2) * (1.0f / D) + LN_EPS);
            float lg[8];
#pragma unroll
            for (int e = 0; e < 8; ++e) lg[e] = 0.f;
#pragma unroll
            for (int j = 0; j < 4; ++j) { const int cc = 256 * j + 4 * F.lane; const f32x4 xn = v[j] * rstd * gm[j] + bt[j]; *(GAS f32x4*)(xout + m * D + cc) = xn;
                if (HAS_H) { const f32x4 hv = xn * sc[j] + sh[j]; u32x2 w; w.x = pk2(hv[0], hv[1]); w.y = pk2(hv[2], hv[3]); *(GAS u32x2*)(H + m * D + cc) = w; v[j] = hv; } }
            if (ROUTE) {
#pragma unroll
                for (int j = 0; j < 4; ++j) { const int cc = 256 * j + 4 * F.lane;
#pragma unroll
                    for (int e = 0; e < 8; ++e) { const f32x4 rw = *(const LAS f32x4*)(rl + e * D + cc); lg[e] += (v[j][0] * rw[0] + v[j][1] * rw[1]) + (v[j][2] * rw[2] + v[j][3] * rw[3]); }
                    asm volatile("" ::: "memory"); }
            }
            if (ROUTE) {
#pragma unroll
                for (int e = 0; e < 8; ++e) lg[e] = wave_sum(lg[e]);
                int i1 = 0; float l1 = lg[0];
#pragma unroll
                for (int e = 1; e < 8; ++e) if (lg[e] > l1) { l1 = lg[e]; i1 = e; }
                int i2 = -1; float l2 = -INFINITY;
#pragma unroll
                for (int e = 0; e < 8; ++e) if (e != i1 && lg[e] > l2) { l2 = lg[e]; i2 = e; }
                const float w1 = 1.0f / (1.0f + __expf(l2 - l1)), w2 = 1.0f - w1;
                if (F.lane == r) { my_e1 = (unsigned)i1; my_e2 = (unsigned)i2; my_w1 = w1; my_w2 = w2; }
            }
        }
        if (ROUTE) {
            const bool act = F.lane < 32; unsigned p1 = 0, p2 = 0; const unsigned long long lt = (1ull << F.lane) - 1ull;
#pragma unroll
            for (int e = 0; e < 8; ++e) { const unsigned long long m1 = __ballot(act && my_e1 == (unsigned)e), m2 = __ballot(act && my_e2 == (unsigned)e);
                const unsigned n1 = (unsigned)__popcll(m1), n2 = (unsigned)__popcll(m2); unsigned base = 0;
                if (F.lane == 0 && (n1 + n2) != 0u) base = __hip_atomic_fetch_add(cnt + 64 * e, n1 + n2, RLX_AGENT);
                base = (unsigned)__builtin_amdgcn_readfirstlane(base);
                if (my_e1 == (unsigned)e) p1 = base + (unsigned)__popcll(m1 & lt);
                if (my_e2 == (unsigned)e) p2 = base + n1 + (unsigned)__popcll(m2 & lt); }
            if (act) { const size_t m = (size_t)(row0 + F.lane); v4u a; a.x = my_e1; a.y = p1; a.z = my_e2; a.w = p2; v4u bb; bb.x = __float_as_uint(my_w1); bb.y = __float_as_uint(my_w2); bb.z = 0u; bb.w = 0u;
                *(GAS v4u*)(route + m * 8) = a; *(GAS v4u*)(route + m * 8 + 4) = bb; }
        }
    }
    if (ROUTE) __syncthreads();
}

__device__ __forceinline__ void permute_phase(Frame& F, const bf16* H, const unsigned* route, gu32* cnt, bf16* HS) {
    const int gw = F.vcu * NWAVES + F.wave, NGW = F.G * NWAVES;
    unsigned rbase[8]; { unsigned s = 0;
#pragma unroll
        for (int e = 0; e < 8; ++e) { rbase[e] = s; const unsigned ce = (unsigned)__builtin_amdgcn_readfirstlane(__hip_atomic_load(cnt + 64 * e, RLX_AGENT)); s += ((ce + 255u) >> 8) << 8; } }
    for (int m = gw; m < M; m += NGW) {
        const v4u r0 = *(const GAS v4u*)(route + (size_t)m * 8);
        unsigned ba = 0, bb = 0;
#pragma unroll
        for (int e = 0; e < 8; ++e) { ba = (r0.x == (unsigned)e) ? rbase[e] : ba; bb = (r0.z == (unsigned)e) ? rbase[e] : bb; }
        const size_t ra = (size_t)(ba + r0.y), rb = (size_t)(bb + r0.w);
        const v4u h0 = *(const GAS v4u*)(H + (size_t)m * D + 8 * F.lane), h1 = *(const GAS v4u*)(H + (size_t)m * D + 512 + 8 * F.lane);
        *(GAS v4u*)(HS + ra * D + 8 * F.lane) = h0; *(GAS v4u*)(HS + ra * D + 512 + 8 * F.lane) = h1;
        *(GAS v4u*)(HS + rb * D + 8 * F.lane) = h0; *(GAS v4u*)(HS + rb * D + 512 + 8 * F.lane) = h1;
    }
}

__device__ __forceinline__ void hgate_phase(Frame& F, const float* O, const bf16* SG, const float* ng, bf16* H) {
    const int gw = F.vcu * NWAVES + F.wave, NGW = F.G * NWAVES;
    const f32x4 g4 = *(const f32x4*)(ng + ((4 * F.lane) & 127));
    for (int m = gw; m < M; m += NGW) {
#pragma unroll
        for (int j = 0; j < 4; ++j) { const int cc = 256 * j + 4 * F.lane; const f32x4 o = *(const GAS f32x4*)(O + (size_t)m * D + cc); const u32x2 gw2 = *(const GAS u32x2*)(SG + (size_t)m * D + cc);
            float q = (o[0] * o[0] + o[1] * o[1]) + (o[2] * o[2] + o[3] * o[3]);
#pragma unroll
            for (int s = 1; s < 32; s <<= 1) q += __shfl_xor(q, s);
            const float rs = 1.0f / sqrtf(q * (1.0f / 128.0f) + RMS_EPS);
            f32x4 r; r[0] = o[0] * rs * g4[0] * bf_lo(gw2.x); r[1] = o[1] * rs * g4[1] * bf_hi(gw2.x); r[2] = o[2] * rs * g4[2] * bf_lo(gw2.y); r[3] = o[3] * rs * g4[3] * bf_hi(gw2.y);
            u32x2 w; w.x = pk2(r[0], r[1]); w.y = pk2(r[2], r[3]); *(GAS u32x2*)(H + (size_t)m * D + cc) = w; }
    }
}

__device__ __forceinline__ void hgrn_phase(Frame& F, const bf16* Q, const float* Fg, const bf16* I, float* O) {
    LAS float* sq = (LAS float*)(F.lds + RING_OFF);
    LAS float* sf = sq + 4096;
    LAS float* sv = sf + 4096;
    LAS float* so = sv + 2048;
    const int tt = F.tid >> 4, d8 = (F.tid & 15) * 8, c4 = (F.tid & 15) * 4;
    for (int u = blockIdx.x; u < BATCH * NH_HG * 2; u += F.G) {
        const int b = u >> 4, h = (u >> 1) & 7, half = u & 1; const size_t row0 = (size_t)b * SEQ;
        float S[16];
#pragma unroll
        for (int j = 0; j < 16; ++j) S[j] = 0.f;
        const bf16* qp = Q + (row0 + tt) * D + h * 128 + d8; const float* fp = Fg + (row0 + tt) * D + h * 128 + d8; const bf16* ip = I + (row0 + tt) * D + h * 128 + half * 64 + c4;
        v4u rq = *(const GAS v4u*)qp; f32x4 rf0 = *(const GAS f32x4*)fp, rf1 = *(const GAS f32x4*)(fp + 4); u32x2 rv = *(const GAS u32x2*)ip;
        for (int ck = 0; ck < SEQ / 32; ++ck) {
            { LAS float* q8 = sq + tt * 128 + d8; q8[0] = bf_lo(rq.x); q8[1] = bf_hi(rq.x); q8[2] = bf_lo(rq.y); q8[3] = bf_hi(rq.y); q8[4] = bf_lo(rq.z); q8[5] = bf_hi(rq.z); q8[6] = bf_lo(rq.w); q8[7] = bf_hi(rq.w);
              *(LAS f32x4*)(sf + tt * 128 + d8) = rf0; *(LAS f32x4*)(sf + tt * 128 + d8 + 4) = rf1;
              LAS float* v4 = sv + tt * 64 + c4; v4[0] = bf_lo(rv.x); v4[1] = bf_hi(rv.x); v4[2] = bf_lo(rv.y); v4[3] = bf_hi(rv.y); }
            __syncthreads();
            if (ck + 1 < SEQ / 32) { const size_t adv = (size_t)(ck + 1) * 32 * D; rq = *(const GAS v4u*)(qp + adv); rf0 = *(const GAS f32x4*)(fp + adv); rf1 = *(const GAS f32x4*)(fp + adv + 4); rv = *(const GAS u32x2*)(ip + adv); }
            for (int t = 0; t < 32; ++t) {
                const float vt = sv[t * 64 + F.lane]; float op = 0.f;
#pragma unroll
                for (int j4 = 0; j4 < 4; ++j4) { const f32x4 f4 = *(const LAS f32x4*)(sf + t * 128 + 16 * F.wave + 4 * j4), q4 = *(const LAS f32x4*)(sq + t * 128 + 16 * F.wave + 4 * j4);
#pragma unroll
                    for (int i = 0; i < 4; ++i) { const float fj = f4[i]; S[4 * j4 + i] = fj * S[4 * j4 + i] + (1.0f - fj) * vt; op += q4[i] * S[4 * j4 + i]; } }
                so[(F.wave * 32 + t) * 64 + F.lane] = op;
            }
            __syncthreads();
#pragma unroll
            for (int r = 0; r < 4; ++r) { const int idx = F.tid + 512 * r, t = idx >> 6, v = idx & 63; float s = 0.f;
#pragma unroll
                for (int w = 0; w < 8; ++w) s += so[(w * 32 + t) * 64 + v];
                O[(row0 + (size_t)ck * 32 + t) * D + h * 128 + half * 64 + v] = s; }
        }
        __syncthreads();
    }
}

__device__ __forceinline__ void sbattn_phase(Frame& F, const bf16* Q, const bf16* K, const bf16* V, bf16* O) {
    LAS unsigned char* myl = F.lds + RING_OFF + F.wave * 16384;
    const int gw = F.vcu * NWAVES + F.wave, NGW = F.G * NWAVES;
    for (int task = gw; task < BATCH * NH_SB * (SEQ / 64); task += NGW) {
        const int qblk = task & 63, bh = task >> 6, b = bh >> 4, h = bh & 15; const size_t rowb = (size_t)b * SEQ; const int t = qblk * 64 + F.lane;
        float q[64], acc[64];
#pragma unroll
        for (int p = 0; p < 8; ++p) { const v4u w = *(const GAS v4u*)(Q + (rowb + t) * D + h * 64 + 8 * p);
            q[8 * p + 0] = bf_lo(w.x); q[8 * p + 1] = bf_hi(w.x); q[8 * p + 2] = bf_lo(w.y); q[8 * p + 3] = bf_hi(w.y); q[8 * p + 4] = bf_lo(w.z); q[8 * p + 5] = bf_hi(w.z); q[8 * p + 6] = bf_lo(w.w); q[8 * p + 7] = bf_hi(w.w); }
#pragma unroll
        for (int d = 0; d < 64; ++d) acc[d] = 0.f;
        float carry = 1.0f;
        for (int kt = qblk; kt >= 0; --kt) {
            asm volatile("s_waitcnt lgkmcnt(0)" ::: "memory");
#pragma unroll
            for (int i = 0; i < 8; ++i) { const int c = i * 64 + F.lane, key = c >> 3, part = c & 7; const size_t go = (rowb + (size_t)kt * 64 + key) * D + h * 64 + part * 8;
                *(LAS v4u*)(myl + c * 16) = *(const GAS v4u*)(K + go); *(LAS v4u*)(myl + 8192 + c * 16) = *(const GAS v4u*)(V + go); }
            asm volatile("s_waitcnt vmcnt(0) lgkmcnt(0)" ::: "memory");
            for (int sl = 63; sl >= 0; --sl) {
                const int s = kt * 64 + sl;
                float z0 = 0.f, z1 = 0.f;
#pragma unroll
                for (int p = 0; p < 8; ++p) { const v4u w = *(const LAS v4u*)(myl + sl * 128 + p * 16);
                    z0 += q[8 * p + 0] * bf_lo(w.x) + q[8 * p + 2] * bf_lo(w.y) + q[8 * p + 4] * bf_lo(w.z) + q[8 * p + 6] * bf_lo(w.w);
                    z1 += q[8 * p + 1] * bf_hi(w.x) + q[8 * p + 3] * bf_hi(w.y) + q[8 * p + 5] * bf_hi(w.z) + q[8 * p + 7] * bf_hi(w.w); }
                const float z = z0 + z1, e = __expf(-fabsf(z)), rr = 1.0f / (1.0f + e);
                const float beta = z >= 0.f ? rr : e * rr, omb = z >= 0.f ? e * rr : rr;
                const bool valid = s < t;
                const float a = valid ? beta * carry : 0.f; carry = valid ? carry * omb : carry;
#pragma unroll
                for (int p = 0; p < 8; ++p) { const v4u w = *(const LAS v4u*)(myl + 8192 + sl * 128 + p * 16);
                    acc[8 * p + 0] += a * bf_lo(w.x); acc[8 * p + 1] += a * bf_hi(w.x); acc[8 * p + 2] += a * bf_lo(w.y); acc[8 * p + 3] += a * bf_hi(w.y);
                    acc[8 * p + 4] += a * bf_lo(w.z); acc[8 * p + 5] += a * bf_hi(w.z); acc[8 * p + 6] += a * bf_lo(w.w); acc[8 * p + 7] += a * bf_hi(w.w); }
            }
            if (__all(carry < 1e-37f)) break;
        }
#pragma unroll
        for (int p = 0; p < 8; ++p) { v4u w; w.x = pk2(acc[8 * p + 0], acc[8 * p + 1]); w.y = pk2(acc[8 * p + 2], acc[8 * p + 3]); w.z = pk2(acc[8 * p + 4], acc[8 * p + 5]); w.w = pk2(acc[8 * p + 6], acc[8 * p + 7]);
            *(GAS v4u*)(O + (rowb + t) * D + h * 64 + 8 * p) = w; }
    }
}

#ifndef PHMASK
#define PHMASK 0x3ffff
#endif
#define ON(i) (((PHMASK) >> (i)) & 1)
struct Args { const float* in[19]; float* out; unsigned char* ws; int ph_lo, ph_hi, one, pad; };
__global__ void __launch_bounds__(NWAVES * 64, 2) trunk_fwd(Args args) {
    extern __shared__ __attribute__((aligned(16))) unsigned char lds[];
    Frame F;
    F.lds = (LAS unsigned char*)lds;
    F.MISC = (volatile LAS unsigned*)(F.lds + MISC_OFF);
    F.tid = threadIdx.x; F.lane = F.tid & 63; F.wave = __builtin_amdgcn_readfirstlane(F.tid >> 6);
    F.G = gridDim.x; { const int bx = blockIdx.x; F.vcu = (F.G % 8 == 0) ? (bx % 8) * (F.G / 8) + bx / 8 : bx; }
    unsigned char* ws = args.ws;
    F.ctl = (gu32*)(ws + WS_CTL);
    for (int u = F.tid; u < (LDS_BYTES - LDSCTL_OFF) / 4; u += NWAVES * 64) ((LAS unsigned*)(F.lds + LDSCTL_OFF))[u] = 0u;
    __syncthreads();
    const bool one = args.one != 0;
    XcdBarrier bar; bar.bar = (unsigned*)(F.ctl + CW_BAR); bar.x = 0; bar.st = nullptr;
    if (one) bar = xcd_barrier_post((unsigned*)(F.ctl + CW_BAR), F.MISC + 8);
    const int lo = args.ph_lo, hi = args.ph_hi;
#define IN(k) (lo <= (k) && (k) < hi)
#define ENTER() do { int t_ = threadIdx.x; asm volatile("" : "+v"(t_)); F.tid = t_; F.lane = t_ & 63; F.wave = __builtin_amdgcn_readfirstlane(t_ >> 6); asm volatile("" : "+s"(ws)); } while (0)
#define SEAM(k) do { if (IN((k) + 1)) xcd_barrier(bar); } while (0)
    const float* x_in = args.in[0]; const float* c_in = args.in[1]; const float* ada_w = args.in[2]; const float* ada_b = args.in[3];
    const float* ln1_g = args.in[4]; const float* ln1_b = args.in[5]; const float* ln2_g = args.in[6]; const float* ln2_b = args.in[7];
    const float* sb_w_qkv = args.in[8]; const float* sb_w_o = args.in[9]; const float* hg_w_in = args.in[10]; const float* hg_norm_g = args.in[11]; const float* hg_w_o = args.in[12];
    const float* hg_lb = args.in[13]; const float* ffn_w13 = args.in[14]; const float* ffn_w2 = args.in[15]; const float* moe_router = args.in[16]; const float* moe_w13 = args.in[17]; const float* moe_w2 = args.in[18];
    float* xres = args.out;
#define mod ((float*)(ws + WS_MOD))
#define lbv ((float*)(ws + WS_LB))
#define route ((unsigned*)(ws + WS_ROUTE))
#define wbuf (ws + WS_W)
#define Hb ((bf16*)(ws + WS_H))
#define Yb ((bf16*)(ws + WS_Y))

    if (IN(0)) { ENTER(); if constexpr (ON(0)) mod_phase(F, c_in, ada_w, ada_b, hg_lb, mod, lbv); if constexpr (ON(1)) conv_sb(F, sb_w_qkv, sb_w_o, ffn_w13, ffn_w2, wbuf); SEAM(0); }
    if (IN(1)) { ENTER(); if constexpr (ON(2)) modulate_phase(F, x_in, mod, Hb); SEAM(1); }

    for (int pair = 0; pair < 2; ++pair) {
        const int pb = 2 + 16 * pair, lS = 2 * pair, lH = 2 * pair + 1;
#define modS (mod + (size_t)lS * BATCH * MODW)
#define modH (mod + (size_t)lH * BATCH * MODW)
        if (IN(pb + 0)) { ENTER();
            pg8::Gemm g{Hb, (const bf16*)(wbuf + W_SB_QKV), M, 3 * D, D, 0}; pg8::StaticOrder S; S.init(M, 3 * D, F.G, (int)blockIdx.x);
            pg8::EpiBf16<0> E{(bf16*)(ws + B_Q), D, nullptr, D, (size_t)(B_K - B_Q) / 2, 0.125f};
            if constexpr (ON(3)) pg8::gemm_phase<pg8::EpiBf16<0>, pg8::StaticOrder, PG8_ALIGN, PG8_SP2>(F.lds + RING_OFF, g, S, E);
            SEAM(pb + 0); }
        if (IN(pb + 1)) { ENTER(); if constexpr (ON(4)) sbattn_phase(F, (const bf16*)(ws + B_Q), (const bf16*)(ws + B_K), (const bf16*)(ws + B_V), (bf16*)(ws + B_Q)); SEAM(pb + 1); }
        if (IN(pb + 2)) { ENTER();
            pg8::Gemm g{(const bf16*)(ws + B_Q), (const bf16*)(wbuf + W_SB_O), M, D, D, 0}; pg8::StaticOrder S; S.init(M, D, F.G, (int)blockIdx.x);
            pg8::EpiBf16<0> E{Yb, D, nullptr, 0, 0, 1.f};
            if constexpr (ON(5)) pg8::gemm_phase<pg8::EpiBf16<0>, pg8::StaticOrder, PG8_ALIGN, PG8_SP2>(F.lds + RING_OFF, g, S, E);
            SEAM(pb + 2); }
        if (IN(pb + 3)) { ENTER();
            if constexpr (ON(6)) ln_phase<false, false, true>(F, pair == 0 ? x_in : xres, xres, Yb, modS + 2 * D, ln1_g + lS * D, ln1_b + lS * D, modS + 4 * D, modS + 3 * D, Hb, nullptr, nullptr, nullptr);
            SEAM(pb + 3); }
        if (IN(pb + 4)) { ENTER();
            pg8::Gemm g{Hb, (const bf16*)(wbuf + W_SB_13), M, 2 * FF, D, 0}; pg8::StaticOrder S; S.init(M, 2 * FF, F.G, (int)blockIdx.x);
            pg8::EpiSwiGLU E{(bf16*)(ws + B_INTER), FF};
            if constexpr (ON(7)) pg8::gemm_phase<pg8::EpiSwiGLU, pg8::StaticOrder, PG8_ALIGN, PG8_SP2>(F.lds + RING_OFF, g, S, E);
            SEAM(pb + 4); }
        if (IN(pb + 5)) { ENTER();
            pg8::Gemm g{(const bf16*)(ws + B_INTER), (const bf16*)(wbuf + W_SB_2), M, D, FF, 0}; pg8::StaticOrder S; S.init(M, D, F.G, (int)blockIdx.x);
            pg8::EpiBf16<0> E{Yb, D, nullptr, 0, 0, 1.f};
            if constexpr (ON(8)) pg8::gemm_phase<pg8::EpiBf16<0>, pg8::StaticOrder, PG8_ALIGN, PG8_SP2>(F.lds + RING_OFF, g, S, E);
            SEAM(pb + 5); }
        if (IN(pb + 6)) { ENTER();
            if constexpr (ON(6)) ln_phase<false, false, true>(F, xres, xres, Yb, modS + 5 * D, ln2_g + lS * D, ln2_b + lS * D, modH + 1 * D, modH + 0 * D, Hb, nullptr, nullptr, nullptr);
            if constexpr (ON(9)) conv_hg(F, hg_w_in + (size_t)pair * D * 4 * D, hg_w_o + (size_t)pair * D * D, moe_w13 + (size_t)pair * NEXP * D * 2 * FF, moe_w2 + (size_t)pair * NEXP * FF * D, wbuf);
            SEAM(pb + 6); }
#define cnt ((gu32*)(ws + WS_CTL) + CW_CNT + pair * 8 * 64)
        if (IN(pb + 7)) { ENTER();
            pg8::Gemm g{Hb, (const bf16*)(wbuf + W_HG_IN), M, 4 * D, D, 0}; pg8::StaticOrder S; S.init(M, 4 * D, F.G, (int)blockIdx.x);
            static_assert(B_HF - B_HQ == pg8::EpiHgIn::OFF_F && B_HI - B_HQ == pg8::EpiHgIn::OFF_I && B_HGT - B_HQ == pg8::EpiHgIn::OFF_G, "EpiHgIn offsets");
            pg8::EpiHgIn E{ws + B_HQ, lbv + pair * D};
            if constexpr (ON(10)) pg8::gemm_phase<pg8::EpiHgIn, pg8::StaticOrder, PG8_ALIGN, PG8_SP2>(F.lds + RING_OFF, g, S, E);
            SEAM(pb + 7); }
        if (IN(pb + 8)) { ENTER(); if constexpr (ON(11)) hgrn_phase(F, (const bf16*)(ws + B_HQ), (const float*)(ws + B_HF), (const bf16*)(ws + B_HI), (float*)(ws + B_HO)); SEAM(pb + 8); }
        if (IN(pb + 9)) { ENTER(); if constexpr (ON(12)) hgate_phase(F, (const float*)(ws + B_HO), (const bf16*)(ws + B_HGT), hg_norm_g + pair * 128, Hb); SEAM(pb + 9); }
        if (IN(pb + 10)) { ENTER();
            pg8::Gemm g{Hb, (const bf16*)(wbuf + W_HG_O), M, D, D, 0}; pg8::StaticOrder S; S.init(M, D, F.G, (int)blockIdx.x);
            pg8::EpiBf16<0> E{Yb, D, nullptr, 0, 0, 1.f};
            if constexpr (ON(5)) pg8::gemm_phase<pg8::EpiBf16<0>, pg8::StaticOrder, PG8_ALIGN, PG8_SP2>(F.lds + RING_OFF, g, S, E);
            SEAM(pb + 10); }
        if (IN(pb + 11)) { ENTER();
            if constexpr (ON(13)) ln_phase<false, true, true>(F, xres, xres, Yb, modH + 2 * D, ln1_g + lH * D, ln1_b + lH * D, modH + 4 * D, modH + 3 * D, Hb, moe_router + (size_t)pair * D * NEXP, route, cnt);
            SEAM(pb + 11); }
        if (IN(pb + 12)) { ENTER(); if constexpr (ON(14)) permute_phase(F, Hb, route, cnt, (bf16*)(ws + B_HS)); SEAM(pb + 12); }
        if (IN(pb + 13)) { ENTER();
            unsigned cv[8];
#pragma unroll
            for (int e = 0; e < 8; ++e) cv[e] = (unsigned)__builtin_amdgcn_readfirstlane(__hip_atomic_load(cnt + 64 * e, RLX_AGENT));
            pg8::Gemm g{(const bf16*)(ws + B_HS), (const bf16*)(wbuf + W_HG_13), MPAD, 2 * FF, D, (size_t)2 * FF * D * 2}; pg8::GroupedOrder S; S.init(cv, 2 * FF, F.G, (int)blockIdx.x);
            pg8::EpiSwiGLU E{(bf16*)(ws + B_MINTER), FF};
            if constexpr (ON(15)) pg8::gemm_phase<pg8::EpiSwiGLU, pg8::GroupedOrder, PG8_ALIGN, PG8_SP2>(F.lds + RING_OFF, g, S, E);
            SEAM(pb + 13); }
        if (IN(pb + 14)) { ENTER();
            unsigned cv[8];
#pragma unroll
            for (int e = 0; e < 8; ++e) cv[e] = (unsigned)__builtin_amdgcn_readfirstlane(__hip_atomic_load(cnt + 64 * e, RLX_AGENT));
            pg8::Gemm g{(const bf16*)(ws + B_MINTER), (const bf16*)(wbuf + W_HG_2), MPAD, D, FF, (size_t)D * FF * 2}; pg8::GroupedOrder S; S.init(cv, D, F.G, (int)blockIdx.x);
            pg8::EpiBf16<0> E{(bf16*)(ws + B_YS), D, nullptr, 0, 0, 1.f};
            if constexpr (ON(16)) pg8::gemm_phase<pg8::EpiBf16<0>, pg8::GroupedOrder, PG8_ALIGN, PG8_SP2>(F.lds + RING_OFF, g, S, E);
            SEAM(pb + 14); }
        if (IN(pb + 15)) { ENTER();
            if (pair == 0) {
                const float* modN = mod + (size_t)(lH + 1) * BATCH * MODW;
                if constexpr (ON(17)) ln_phase<true, false, true>(F, xres, xres, (const bf16*)(ws + B_YS), modH + 5 * D, ln2_g + lH * D, ln2_b + lH * D, modN + 1 * D, modN + 0 * D, Hb, nullptr, route, cnt);
                if constexpr (ON(1)) conv_sb(F, sb_w_qkv + (size_t)D * 3 * D, sb_w_o + (size_t)D * D, ffn_w13 + (size_t)D * 2 * FF, ffn_w2 + (size_t)FF * D, wbuf);
                SEAM(pb + 15);
            } else {
                if constexpr (ON(17)) ln_phase<true, false, false>(F, xres, xres, (const bf16*)(ws + B_YS), modH + 5 * D, ln2_g + lH * D, ln2_b + lH * D, nullptr, nullptr, nullptr, nullptr, route, cnt);
            } }
    }
#undef IN
#undef SEAM
#undef mod
#undef lbv
#undef route
#undef wbuf
#undef Hb
#undef Yb
#undef modS
#undef modH
#undef cnt
}

extern "C" void kernel_launch(void* const* d_in, const int* in_sizes, int n_in, void* d_out, int out_size, void* d_ws, size_t ws_size, hipStream_t stream) {
    static int grid = 0;
    if (grid == 0) {
        if (n_in != 19 || in_sizes[0] != M * D || out_size != M * D || ws_size < WS_END) { fprintf(stderr, "kernel_launch: unexpected shapes (n_in %d, in0 %d, out %d, ws %zu < %zu)\n", n_in, n_in > 0 ? in_sizes[0] : -1, out_size, ws_size, (size_t)WS_END); grid = -1; return; }
        int dev = 0, cus = 0, per_cu = 0;
        if (hipGetDevice(&dev) != hipSuccess || hipDeviceGetAttribute(&cus, hipDeviceAttributeMultiprocessorCount, dev) != hipSuccess) { grid = -1; return; }
        if (hipFuncSetAttribute((const void*)trunk_fwd, hipFuncAttributeMaxDynamicSharedMemorySize, LDS_BYTES) != hipSuccess) { fprintf(stderr, "kernel_launch: hipFuncSetAttribute failed\n"); grid = -1; return; }
        if (hipOccupancyMaxActiveBlocksPerMultiprocessor(&per_cu, (const void*)trunk_fwd, NWAVES * 64, LDS_BYTES) != hipSuccess || per_cu < 1) fprintf(stderr, "kernel_launch: note: occupancy query reports %d\n", per_cu);
        (void)hipGetLastError();
        grid = cus;
    }
    if (grid < 0) return;
    if (hipMemsetAsync((char*)d_ws + WS_CTL, 0, CTL_ZERO_BYTES, stream) != hipSuccess) return;
    Args a{};
    for (int i = 0; i < 19; ++i) a.in[i] = (const float*)d_in[i];
    a.out = (float*)d_out; a.ws = (unsigned char*)d_ws; a.pad = 0;
#if MK_ONE_LAUNCH
    a.ph_lo = 0; a.ph_hi = N_PHASES; a.one = 1;
    hipLaunchKernelGGL(trunk_fwd, dim3(grid), dim3(NWAVES * 64), LDS_BYTES, stream, a);
#else
    for (int p = 0; p < N_PHASES; ++p) { a.ph_lo = p; a.ph_hi = p + 1; a.one = 0;
        hipLaunchKernelGGL(trunk_fwd, dim3(grid), dim3(NWAVES * 64), LDS_BYTES, stream, a); }
#endif
}
```

```cpp
#include <hip/hip_runtime.h>
#include <cstdio>
#include <cstdint>
#include <cmath>
#define XBF16 1
namespace pg8 {
#define PG8_LAS __attribute__((address_space(3)))
typedef unsigned short bf16_t;
typedef short bf16x8 __attribute__((ext_vector_type(8)));
typedef float f32x4 __attribute__((ext_vector_type(4)));
typedef unsigned u32x4 __attribute__((ext_vector_type(4)));
constexpr int BM = 256, BK = 64, HALF = 128, HTB = HALF * BK * 2  , STAGE_BYTES = 8 * HTB, NXCD = 8, WGM = 4;

__host__ __device__ __forceinline__ int lds_byte(int r, int c) { const int st = (r >> 4) * 2 + (c >> 5), rr = r & 15, cc = c & 31, ob = rr * 64 + cc * 2; return st * 1024 + (ob ^ (((ob >> 9) & 1) << 5)); }
__host__ __device__ __forceinline__ void stage_rc(int b, int& R, int& C) { const int st = b / 1024, sb = b % 1024, swz = sb ^ (((sb >> 9) & 1) << 5); R = (st >> 1) * 16 + swz / 64; C = (st & 1) * 32 + (swz % 64) / 2; }
__host__ __device__ __forceinline__ int perm32(int rho) { const int n = rho >> 4, i = rho & 15; return 8 * (i >> 2) + 4 * n + (i & 3); }

struct Unit { int pm, pn, eb, ga; };
struct Gemm { const bf16_t* A; const bf16_t* Bt; int M, N, K; size_t estride; int ld = 0; int apair = 0; };

struct StaticOrder {
    int nM, nN, nwg, G, c, rev, wgm;
    __host__ __device__ void init(int M, int N, int G_, int c_, int rev_ = 0, int wgm_ = WGM) { nM = M / BM; nN = N / BM; nwg = nM * nN; G = G_; c = c_; rev = rev_; wgm = wgm_; }
    __host__ __device__ bool next(int i, Unit& u) const {
        const long L = (long)i * G + c; if (L >= nwg) return false;
        int wgid = (int)L; { const int q = nwg / NXCD, r = nwg % NXCD, xcd = wgid % NXCD; int off = wgid / NXCD; if (rev && r == 0) off = q - 1 - off; wgid = (xcd < r ? xcd * (q + 1) : r * (q + 1) + (xcd - r) * q) + off; }
        const int nig = wgm * nN, gid = wgid / nig, fm = gid * wgm, gsz = (nM - fm) < wgm ? (nM - fm) : wgm;
        u.pm = fm + ((wgid % nig) % gsz); u.pn = (wgid % nig) / gsz; u.eb = 0; return true;
    }
    __device__ __forceinline__ void a_ready(const Unit&) const {}
    __device__ __forceinline__ void done(const Unit&) const {}
};

typedef float cvt_f32x2 __attribute__((ext_vector_type(2))); typedef __bf16 cvt_bf16x2 __attribute__((ext_vector_type(2)));
__device__ __forceinline__ unsigned cvt_pk_bf16(float lo, float hi) { const cvt_f32x2 v = {lo, hi}; return __builtin_bit_cast(unsigned, __builtin_convertvector(v, cvt_bf16x2)); }
typedef float f32x2 __attribute__((ext_vector_type(2)));
__device__ __forceinline__ f32x2 gelu_pk(f32x2 v) {
    const f32x2 av = __builtin_elementwise_abs(v), d = av * 0.2316418882f + 1.0f;
    f32x2 t; t.x = __builtin_amdgcn_rcpf(d.x); t.y = __builtin_amdgcn_rcpf(d.y);
    f32x2 q = t * 0.5307027145f + (-0.7265760135f); q = q * t + 0.7107068705f; q = q * t + (-0.142248368f); q = q * t + 0.127414796f; q = q * t;
    const f32x2 s = (v * v) * (-0.72134752044f);
    f32x2 e; e.x = __builtin_amdgcn_exp2f(s.x); e.y = __builtin_amdgcn_exp2f(s.y);
    const f32x2 m = v * (q * e), r = v - m;
    f32x2 o; o.x = v.x < 0.f ? m.x : r.x; o.y = v.y < 0.f ? m.y : r.y; return o;
}

#ifndef EPI_NT
#define EPI_NT 0
#endif
#if EPI_NT
#define EPI_STORE16(p, v) __builtin_nontemporal_store((v), (__attribute__((address_space(1))) u32x4*)(p))
#define EPI_STOREF4(p, v) __builtin_nontemporal_store((v), (__attribute__((address_space(1))) f32x4*)(p))
#else
#define EPI_STORE16(p, v) (*(__attribute__((address_space(1))) u32x4*)(p) = (v))
#define EPI_STOREF4(p, v) (*(__attribute__((address_space(1))) f32x4*)(p) = (v))
#endif
template <int ACT  > struct EpiBf16 {
    static constexpr bool PERM = true, AFTER_DRAIN = false; static constexpr int NSTORES = 16; static_assert(ACT == 0 || ACT == 1, "EpiBf16: ACT is 0 (none) or 1 (gelu_pk)");
    bf16_t* O; int ldc; const float* bias; int split_cols; size_t split_stride; float scale0;
    __device__ __forceinline__ void operator()(const f32x4 (&acc)[2][2][4][2], const Unit& u, int wr, int wc, int fr, int fq) const {
        const int row0 = u.pm * BM + wr * 64 + fr; int colt = u.pn * BM; bf16_t* base = O;
        float sc = 1.f; if (split_cols) { const int t = colt / split_cols; base += (size_t)t * split_stride; colt -= t * split_cols; if (t == 0) sc = scale0; }
        const bool scaled = (sc != 1.f);
        const int col0 = colt + wc * 32 + 8 * fq, bcol0 = u.pn * BM + wc * 32 + 8 * fq;
        f32x4 bv[2][2];
#pragma unroll
        for (int bj = 0; bj < 2; ++bj)
#pragma unroll
            for (int n = 0; n < 2; ++n) bv[bj][n] = bias ? *(const f32x4*)(bias + bcol0 + bj * HALF + 4 * n) : (f32x4){0.f, 0.f, 0.f, 0.f};
#pragma unroll
        for (int ai = 0; ai < 2; ++ai)
#pragma unroll
            for (int m = 0; m < 4; ++m) { bf16_t* rowp = base + (size_t)(row0 + ai * HALF + m * 16) * ldc + col0;
#pragma unroll
                for (int bj = 0; bj < 2; ++bj) { f32x4 v0 = acc[ai][bj][m][0], v1 = acc[ai][bj][m][1]; if (bias) { v0 = v0 + bv[bj][0]; v1 = v1 + bv[bj][1]; }
                    if (ACT == 1) { f32x2 a = gelu_pk((f32x2){v0[0], v0[1]}), b = gelu_pk((f32x2){v0[2], v0[3]}), c = gelu_pk((f32x2){v1[0], v1[1]}), d = gelu_pk((f32x2){v1[2], v1[3]});
                        v0 = (f32x4){a.x, a.y, b.x, b.y}; v1 = (f32x4){c.x, c.y, d.x, d.y}; }
                    if (scaled) { v0 = v0 * sc; v1 = v1 * sc; } u32x4 w; w.x = cvt_pk_bf16(v0[0], v0[1]); w.y = cvt_pk_bf16(v0[2], v0[3]); w.z = cvt_pk_bf16(v1[0], v1[1]); w.w = cvt_pk_bf16(v1[2], v1[3]);
                    EPI_STORE16(rowp + bj * HALF, w); } }
    }
};
#ifndef EPI_BIG_NT
#define EPI_BIG_NT 1
#endif
#if EPI_BIG_NT
#define EPI_BIG16(p, v) __builtin_nontemporal_store((v), (__attribute__((address_space(1))) u32x4*)(p))
#define EPI_BIGF4(p, v) __builtin_nontemporal_store((v), (__attribute__((address_space(1))) f32x4*)(p))
#else
#define EPI_BIG16(p, v) EPI_STORE16(p, v)
#define EPI_BIGF4(p, v) EPI_STOREF4(p, v)
#endif
__device__ __forceinline__ float fast_sigmoid(float v) { return __builtin_amdgcn_rcpf(1.0f + __builtin_amdgcn_exp2f(-1.4426950408889634f * v)); }
__device__ __forceinline__ float fast_silu(float v) { return v * fast_sigmoid(v); }
__device__ __forceinline__ unsigned swiglu_pk(f32x2 a, f32x2 b) { const f32x2 t = a * (-1.4426950408889634f); f32x2 e; e.x = __builtin_amdgcn_exp2f(t.x); e.y = __builtin_amdgcn_exp2f(t.y); const f32x2 d = e + 1.0f; f32x2 r; r.x = __builtin_amdgcn_rcpf(d.x); r.y = __builtin_amdgcn_rcpf(d.y); const f32x2 s = (a * r) * b; return cvt_pk_bf16(s.x, s.y); }
#ifndef INTER_PAIR
#define INTER_PAIR 1
#endif
struct EpiSwiGLU {
    static constexpr bool PERM = true, AFTER_DRAIN = false; static constexpr int NSTORES = 8;
    bf16_t* O; int ldc;
    __device__ __forceinline__ void operator()(const f32x4 (&acc)[2][2][4][2], const Unit& u, int wr, int wc, int fr, int fq) const {
        const int row0 = u.pm * BM + wr * 64 + fr, col0 = u.pn * HALF + wc * 32 + 8 * fq;
#pragma unroll
        for (int ai = 0; ai < 2; ++ai)
#pragma unroll
            for (int m = 0; m < 4; ++m) {
#if INTER_PAIR
                const int row_ = row0 + ai * HALF + m * 16; bf16_t* rowp = O + (size_t)(row_ >> 1) * 2 * ldc + (col0 >> 5) * 64 + (row_ & 1) * 32 + (col0 & 31);
#else
                bf16_t* rowp = O + (size_t)(row0 + ai * HALF + m * 16) * ldc + col0;
#endif
                const f32x4 a0 = acc[ai][0][m][0], a1 = acc[ai][0][m][1], b0 = acc[ai][1][m][0], b1 = acc[ai][1][m][1];
                u32x4 w; w.x = swiglu_pk((f32x2){a0[0], a0[1]}, (f32x2){b0[0], b0[1]}); w.y = swiglu_pk((f32x2){a0[2], a0[3]}, (f32x2){b0[2], b0[3]});
                w.z = swiglu_pk((f32x2){a1[0], a1[1]}, (f32x2){b1[0], b1[1]}); w.w = swiglu_pk((f32x2){a1[2], a1[3]}, (f32x2){b1[2], b1[3]});
                EPI_BIG16(rowp, w); }
    }
};
template <int ND> struct EpiSwiGLUD {
    static constexpr bool PERM = true, AFTER_DRAIN = false; static constexpr int NSTORES = 8 - ND, DEFER = ND; static_assert(INTER_PAIR && ND >= 1 && ND <= 8, "");
    bf16_t* O; int ldc; void* dummy;
    __device__ __forceinline__ void pack(const f32x4 (&acc)[2][2][4][2], const Unit& u, int wr, int wc, int fr, int fq, u32x4 (&dq)[ND], char*& dbase, unsigned& dld) const {
        const int row0 = u.pm * BM + wr * 64 + fr, col0 = u.pn * HALF + wc * 32 + 8 * fq;
        bf16_t* p0 = O + (size_t)(row0 >> 1) * 2 * ldc + (col0 >> 5) * 64 + (row0 & 1) * 32 + (col0 & 31);
#pragma unroll
        for (int ai = 0; ai < 2; ++ai)
#pragma unroll
            for (int m = 0; m < 4; ++m) { const f32x4 a0 = acc[ai][0][m][0], a1 = acc[ai][0][m][1], b0 = acc[ai][1][m][0], b1 = acc[ai][1][m][1];
                u32x4 w; w.x = swiglu_pk((f32x2){a0[0], a0[1]}, (f32x2){b0[0], b0[1]}); w.y = swiglu_pk((f32x2){a0[2], a0[3]}, (f32x2){b0[2], b0[3]});
                w.z = swiglu_pk((f32x2){a1[0], a1[1]}, (f32x2){b1[0], b1[1]}); w.w = swiglu_pk((f32x2){a1[2], a1[3]}, (f32x2){b1[2], b1[3]});
                if (ai * 4 + m < 8 - ND) EPI_BIG16(p0 + (size_t)(ai * HALF + m * 16) * ldc, w); else dq[ai * 4 + m - (8 - ND)] = w; }
        dbase = (char*)p0; dld = (unsigned)ldc * 2u;
    }
    __device__ __forceinline__ void operator()(const f32x4 (&)[2][2][4][2], const Unit&, int, int, int, int) const {}
};
__device__ __forceinline__ u32x4 ror8_dpp(u32x4 v) { u32x4 r;
    r.x = (unsigned)__builtin_amdgcn_update_dpp(0, (int)v.x, 0x128, 0xf, 0xf, false); r.y = (unsigned)__builtin_amdgcn_update_dpp(0, (int)v.y, 0x128, 0xf, 0xf, false);
    r.z = (unsigned)__builtin_amdgcn_update_dpp(0, (int)v.z, 0x128, 0xf, 0xf, false); r.w = (unsigned)__builtin_amdgcn_update_dpp(0, (int)v.w, 0x128, 0xf, 0xf, false); return r; }
#define EPI_WIDE_PAIR(rowbase_ptr  , ldc_, w0_, w1_, lo_) do { \
        u32x4 snd_; snd_.x = (lo_) ? (w1_).x : (w0_).x; snd_.y = (lo_) ? (w1_).y : (w0_).y; snd_.z = (lo_) ? (w1_).z : (w0_).z; snd_.w = (lo_) ? (w1_).w : (w0_).w; const u32x4 rcv_ = ror8_dpp(snd_); \
        u32x4 da_, db_; da_.x = (lo_) ? (w0_).x : rcv_.x; da_.y = (lo_) ? (w0_).y : rcv_.y; da_.z = (lo_) ? (w0_).z : rcv_.z; da_.w = (lo_) ? (w0_).w : rcv_.w; \
        db_.x = (lo_) ? rcv_.x : (w1_).x; db_.y = (lo_) ? rcv_.y : (w1_).y; db_.z = (lo_) ? rcv_.z : (w1_).z; db_.w = (lo_) ? rcv_.w : (w1_).w; \
        EPI_BIG16((rowbase_ptr), da_); EPI_BIG16((rowbase_ptr) + (size_t)8 * (ldc_), db_); } while (0)
struct EpiBf16W {
    static constexpr bool PERM = true, AFTER_DRAIN = false, ADJ = true; static constexpr int NSTORES = 16;
    bf16_t* O; int ldc; int split_cols; size_t split_stride; float scale0;
    __device__ __forceinline__ void operator()(const f32x4 (&acc)[2][2][4][2], const Unit& u, int wr, int wc, int fr, int fq) const {
        int colt = u.pn * BM; bf16_t* base = O; float sc = 1.f; if (split_cols) { const int t = colt / split_cols; base += (size_t)t * split_stride; colt -= t * split_cols; if (t == 0) sc = scale0; }
        const bool scaled = (sc != 1.f), lo = fr < 8;
        bf16_t* p0 = base + (size_t)(u.pm * BM + wr * 64 + (fr & 7)) * ldc + colt + wc * 64 + (lo ? 0 : 32) + 8 * fq;
#pragma unroll
        for (int ai = 0; ai < 2; ++ai)
#pragma unroll
            for (int m = 0; m < 4; ++m) { u32x4 w[2];
#pragma unroll
                for (int bj = 0; bj < 2; ++bj) { f32x4 v0 = acc[ai][bj][m][0], v1 = acc[ai][bj][m][1]; if (scaled) { v0 = v0 * sc; v1 = v1 * sc; }
                    w[bj].x = cvt_pk_bf16(v0[0], v0[1]); w[bj].y = cvt_pk_bf16(v0[2], v0[3]); w[bj].z = cvt_pk_bf16(v1[0], v1[1]); w[bj].w = cvt_pk_bf16(v1[2], v1[3]); }
                EPI_WIDE_PAIR(p0 + (size_t)(ai * HALF + m * 16) * ldc, ldc, w[0], w[1], lo); }
    }
};
#ifndef HG_KBF
#define HG_KBF 1
#endif
#ifndef HG_WIDE
#define HG_WIDE 1
#endif
struct EpiHgIn {
    static constexpr bool PERM = true, AFTER_DRAIN = false, ADJ = (HG_KBF != 0) && (HG_WIDE != 0); static constexpr int NSTORES = 16;
    unsigned char* base0; const float* lb;
    static constexpr size_t OFF_F = (size_t)128 << 20, OFF_I = (size_t)384 << 20, OFF_G = (size_t)512 << 20;
    __device__ __forceinline__ void operator()(const f32x4 (&acc)[2][2][4][2], const Unit& u, int wr, int wc, int fr, int fq) const {
        const int sec = u.pn >> 2, row0 = u.pm * BM + wr * 64 + fr, col0 = (u.pn & 3) * BM + wc * 32 + 8 * fq;
        if (sec == 1 && !HG_KBF) {
#pragma unroll
            for (int bj = 0; bj < 2; ++bj)
#pragma unroll
                for (int n = 0; n < 2; ++n) { const f32x4 l = *(const f32x4*)(lb + col0 + bj * HALF + 4 * n);
#pragma unroll
                    for (int ai = 0; ai < 2; ++ai)
#pragma unroll
                        for (int m = 0; m < 4; ++m) { float* rowp = (float*)(base0 + OFF_F) + (size_t)(row0 + ai * HALF + m * 16) * 1024 + col0; const f32x4 v = acc[ai][bj][m][n]; f32x4 o;
#pragma unroll
                            for (int i = 0; i < 4; ++i) o[i] = l[i] + (1.0f - l[i]) * fast_sigmoid(v[i]);
                            EPI_BIGF4(rowp + bj * HALF + 4 * n, o); } }
        } else if (ADJ) {
            bf16_t* base = (bf16_t*)(base0 + (sec == 0 ? (size_t)0 : (sec == 1 ? OFF_F : (sec == 2 ? OFF_I : OFF_G)))); const bool act = (sec == 3), key = (sec == 1), lo = fr < 8;
            const int cw = (u.pn & 3) * BM + wc * 64 + 8 * fq;
            bf16_t* p0 = base + (size_t)(u.pm * BM + wr * 64 + (fr & 7)) * 1024 + (u.pn & 3) * BM + wc * 64 + (lo ? 0 : 32) + 8 * fq;
#pragma unroll
            for (int ai = 0; ai < 2; ++ai)
#pragma unroll
                for (int m = 0; m < 4; ++m) { u32x4 w[2];
#pragma unroll
                    for (int bj = 0; bj < 2; ++bj) { f32x4 v0 = acc[ai][bj][m][0], v1 = acc[ai][bj][m][1];
                        if (key) { const f32x4 l0 = *(const f32x4*)(lb + cw + bj * 32), l1 = *(const f32x4*)(lb + cw + bj * 32 + 4);
#pragma unroll
                            for (int i = 0; i < 4; ++i) { v0[i] = (1.0f - l0[i]) * fast_sigmoid(-v0[i]); v1[i] = (1.0f - l1[i]) * fast_sigmoid(-v1[i]); } }
                        if (act) {
#pragma unroll
                            for (int i = 0; i < 4; ++i) { v0[i] = fast_silu(v0[i]); v1[i] = fast_silu(v1[i]); } }
                        w[bj].x = cvt_pk_bf16(v0[0], v0[1]); w[bj].y = cvt_pk_bf16(v0[2], v0[3]); w[bj].z = cvt_pk_bf16(v1[0], v1[1]); w[bj].w = cvt_pk_bf16(v1[2], v1[3]); }
                    EPI_WIDE_PAIR(p0 + (size_t)(ai * HALF + m * 16) * 1024, 1024, w[0], w[1], lo); }
        } else {
            bf16_t* base = (bf16_t*)(base0 + (sec == 0 ? (size_t)0 : (sec == 1 ? OFF_F : (sec == 2 ? OFF_I : OFF_G)))); const bool act = (sec == 3), key = HG_KBF && (sec == 1);
#pragma unroll
            for (int ai = 0; ai < 2; ++ai)
#pragma unroll
                for (int m = 0; m < 4; ++m) { bf16_t* rowp = base + (size_t)(row0 + ai * HALF + m * 16) * 1024 + col0;
#pragma unroll
                    for (int bj = 0; bj < 2; ++bj) { f32x4 v0 = acc[ai][bj][m][0], v1 = acc[ai][bj][m][1];
                        if (key) { const f32x4 l0 = *(const f32x4*)(lb + col0 + bj * HALF), l1 = *(const f32x4*)(lb + col0 + bj * HALF + 4);
#pragma unroll
                            for (int i = 0; i < 4; ++i) { v0[i] = (1.0f - l0[i]) * fast_sigmoid(-v0[i]); v1[i] = (1.0f - l1[i]) * fast_sigmoid(-v1[i]); } }
                        if (act) {
#pragma unroll
                            for (int i = 0; i < 4; ++i) { v0[i] = fast_silu(v0[i]); v1[i] = fast_silu(v1[i]); } }
                        u32x4 w; w.x = cvt_pk_bf16(v0[0], v0[1]); w.y = cvt_pk_bf16(v0[2], v0[3]); w.z = cvt_pk_bf16(v1[0], v1[1]); w.w = cvt_pk_bf16(v1[2], v1[3]);
                        EPI_BIG16(rowp + bj * HALF, w); } }
        }
    }
};
#ifndef MOE_WGM
#define MOE_WGM 4
#endif
struct GroupedOrder {
    int nM, nN, nwg, G, c, lim; int tb[9];
    __device__ __forceinline__ void init(const unsigned (&cnt)[8], int N, int G_, int c_) {
        int s = 0;
#pragma unroll
        for (int e = 0; e < 8; ++e) { tb[e] = s; s += (int)((cnt[e] + 255u) >> 8); }
        tb[8] = s; nM = s; nN = N / BM; nwg = nM * nN; G = G_; c = c_; lim = nwg; }
    __device__ __forceinline__ bool next(int i, Unit& u) const {
        const long L = (long)i * G + c; if (L >= lim) return false;
        unit_of((int)L, u); return true; }
    __device__ __forceinline__ bool unit_of(int L, Unit& u) const {
        int wgid = L; { const int q = nwg / NXCD, r = nwg % NXCD, xcd = wgid % NXCD, off = wgid / NXCD; wgid = (xcd < r ? xcd * (q + 1) : r * (q + 1) + (xcd - r) * q) + off; }
        const int nig = MOE_WGM * nN, gid = wgid / nig, fm = gid * MOE_WGM, gsz = (nM - fm) < MOE_WGM ? (nM - fm) : MOE_WGM;
        u.pm = fm + ((wgid % nig) % gsz); u.pn = (wgid % nig) / gsz;
        int e = 0;
#pragma unroll
        for (int j = 1; j < 8; ++j) e += (u.pm >= tb[j]) ? 1 : 0;
        u.eb = e; return true;
    }
    __device__ __forceinline__ void a_ready(const Unit&) const {}
    __device__ __forceinline__ void done(const Unit&) const {}
};
struct TailOrder {
    static constexpr bool CUSTOM = true; GroupedOrder S; int first, ntail, KS, kslice, c;
    __device__ __forceinline__ bool next(int i, Unit& u) const {
        if (i != 0 || c >= ntail * KS) return false;
        Unit r; S.unit_of(first + c % ntail, r); u.pm = c; u.pn = 0; u.eb = r.eb; u.ga = r.pm | (r.pn << 20); return true; }
    __device__ __forceinline__ const char* abase(const Gemm& g, const Unit& u) const { return (const char*)g.A + ((size_t)(u.ga & 0xfffff) * BM * g.ld + (size_t)(u.pm / ntail) * kslice) * 2; }
    __device__ __forceinline__ const char* bbase(const Gemm& g, const Unit& u) const { return (const char*)g.Bt + (size_t)u.eb * g.estride + ((size_t)(u.ga >> 20) * BM * g.ld + (size_t)(u.pm / ntail) * kslice) * 2; }
    __device__ __forceinline__ void a_ready(const Unit&) const {}
    __device__ __forceinline__ void done(const Unit&) const {}
};

struct GatherOrder : GroupedOrder {
    static constexpr bool GATHER = true; const unsigned* tab; int tab_stride;
    __device__ __forceinline__ bool next(int i, Unit& u) const {
        if (!GroupedOrder::next(i, u)) return false;
        int first = 0;
#pragma unroll
        for (int j = 1; j < 8; ++j) first = (u.pm >= tb[j]) ? tb[j] : first;
        u.ga = u.eb * tab_stride + (u.pm - first) * BM; return true; }
};

struct TwoSpeedOrder {
    int x, j, nN, upx, R0; const unsigned* ready; unsigned need; unsigned* tmo; mutable int alld;
    __device__ __forceinline__ void init(int N, int c, int R0_, const unsigned* ready_, unsigned need_, unsigned* tmo_) { x = c & 7; j = c >> 3; nN = N / BM; upx = 32 * nN; R0 = R0_; ready = ready_; need = need_; tmo = tmo_; alld = 0; }
    __device__ __forceinline__ bool next(int i, Unit& u) const {
        int idx; if (!(j & 1)) idx = (i < R0) ? 16 * i + (j >> 1) : 16 * R0 + 32 * (i - R0) + j; else idx = 16 * R0 + 32 * i + j;
        if (idx >= upx) return false;
        const int g = idx / (4 * nN), r = idx % (4 * nN); u.pm = 32 * x + 4 * g + (r & 3); u.pn = r >> 2; u.eb = 0; return true;
    }
    __device__ __forceinline__ void a_ready(const Unit& u) const {
        if (alld) return;
        const unsigned* w = ready + 16 * (u.pm >> 2); const unsigned long long t0 = __builtin_amdgcn_s_memrealtime(); unsigned polls = 0;
        while ((unsigned)__builtin_amdgcn_readfirstlane(__hip_atomic_load(w, __ATOMIC_RELAXED, __HIP_MEMORY_SCOPE_AGENT)) < need) {
            if ((++polls & 255u) == 0u && __builtin_amdgcn_readfirstlane(__hip_atomic_load(tmo, __ATOMIC_RELAXED, __HIP_MEMORY_SCOPE_AGENT)) != 0u) break;
            if (__builtin_amdgcn_s_memrealtime() - t0 > 2000000ull) { if ((threadIdx.x & 63) == 0) { unsigned expect = 0u; __hip_atomic_compare_exchange_strong(tmo + 1, &expect, 0x680u | (unsigned)(u.pm & 0xff), __ATOMIC_RELAXED, __ATOMIC_RELAXED, __HIP_MEMORY_SCOPE_AGENT); __hip_atomic_store(tmo, 1u, __ATOMIC_RELAXED, __HIP_MEMORY_SCOPE_AGENT); } break; }
            __builtin_amdgcn_s_sleep(2); }
        if ((unsigned)__builtin_amdgcn_readfirstlane(__hip_atomic_load(ready + 16 * (8 * x + 7), __ATOMIC_RELAXED, __HIP_MEMORY_SCOPE_AGENT)) >= need) alld = 1;
        __builtin_amdgcn_fence(__ATOMIC_ACQUIRE, "agent");
        asm volatile("s_waitcnt vmcnt(0)" ::: "memory");
    }
    __device__ __forceinline__ void done(const Unit&) const {}
};
struct PanelStats {
    unsigned* xbuf;
    unsigned* cnt;
    unsigned* tmo;
    int ntn; float eps;
    unsigned code;
    __device__ __forceinline__ bool run(const f32x4 (&v)[2][2][4][2], const Unit& u, int wr, int wc, int fr, int fq, PG8_LAS unsigned char* lds, int wid, int lane) const {
        typedef float f32x2v __attribute__((ext_vector_type(2)));
        PG8_LAS f32x2v* P = (PG8_LAS f32x2v*)lds;
        PG8_LAS f32x2v* S = (PG8_LAS f32x2v*)(lds + 8192);
        PG8_LAS unsigned* flag = (PG8_LAS unsigned*)(lds + 8192 + 2048);
#pragma unroll
        for (int ai = 0; ai < 2; ++ai)
#pragma unroll
            for (int m = 0; m < 4; ++m) {
                float s = 0.f;
#pragma unroll
                for (int bj = 0; bj < 2; ++bj)
#pragma unroll
                    for (int n = 0; n < 2; ++n) { const f32x4 x = v[ai][bj][m][n]; s += (x[0] + x[1]) + (x[2] + x[3]); }
                s += __shfl_xor(s, 16); s += __shfl_xor(s, 32);
                const float mw = s * (1.0f / 64.0f); float q = 0.f;
#pragma unroll
                for (int bj = 0; bj < 2; ++bj)
#pragma unroll
                    for (int n = 0; n < 2; ++n) { const f32x4 d = v[ai][bj][m][n] - mw; q += (d[0] * d[0] + d[1] * d[1]) + (d[2] * d[2] + d[3] * d[3]); }
                q += __shfl_xor(q, 16); q += __shfl_xor(q, 32);
                if (fq == 0) P[(ai * HALF + wr * 64 + m * 16 + fr) * 4 + wc] = (f32x2v){mw, q};
            }
        asm volatile("s_waitcnt lgkmcnt(0)" ::: "memory"); __builtin_amdgcn_s_barrier(); asm volatile("" ::: "memory");
#if defined(BROKEN_EXCHANGE_NO_WAIT)
#warning BROKEN CONTROL BUILD: the row-statistics exchange does not wait; results are wrong by design
        if (blockIdx.x >= 64) { const long long t0_ = clock64(); while (clock64() - t0_ < 60000) __builtin_amdgcn_s_sleep(8); }
#endif
        const int row = wid * 32 + (lane & 31);
        if (lane < 32) {
            const f32x2v a = P[row * 4 + 0], b = P[row * 4 + 1], c = P[row * 4 + 2], d = P[row * 4 + 3];
            const float mt = (a.x + b.x + c.x + d.x) * 0.25f;
            const float da = a.x - mt, db = b.x - mt, dc = c.x - mt, dd = d.x - mt;
            const float m2 = (a.y + b.y) + (c.y + d.y) + 64.0f * ((da * da + db * db) + (dc * dc + dd * dd));
            unsigned long long* slot = (unsigned long long*)xbuf + ((size_t)(u.pm * BM + row) * 4 + u.pn);
            __hip_atomic_store(slot, ((unsigned long long)__float_as_uint(m2) << 32) | __float_as_uint(mt), __ATOMIC_RELAXED, __HIP_MEMORY_SCOPE_AGENT);
        }
        asm volatile("s_waitcnt vmcnt(0)" ::: "memory");
        if (lane == 0) __hip_atomic_fetch_add(cnt + 64 * u.pm, 1u, __ATOMIC_RELAXED, __HIP_MEMORY_SCOPE_AGENT);
        if (wid == 0) {
            bool dead = false; const unsigned long long t0 = __builtin_amdgcn_s_memrealtime(); const unsigned want = 8u * (unsigned)ntn;
            for (;;) {
#if defined(BROKEN_EXCHANGE_NO_WAIT)
                break;
#endif
                if ((unsigned)__builtin_amdgcn_readfirstlane(__hip_atomic_load(cnt + 64 * u.pm, __ATOMIC_RELAXED, __HIP_MEMORY_SCOPE_AGENT)) >= want) break;
                if (__builtin_amdgcn_s_memrealtime() - t0 > 2000000ull) {
                    if (lane == 0) { unsigned expect = 0u; __hip_atomic_compare_exchange_strong(tmo + 1, &expect, code | (unsigned)(u.pm & 0xff), __ATOMIC_RELAXED, __ATOMIC_RELAXED, __HIP_MEMORY_SCOPE_AGENT);
                                     __hip_atomic_store(tmo, 1u, __ATOMIC_RELAXED, __HIP_MEMORY_SCOPE_AGENT); }
                    dead = true; break; }
                __builtin_amdgcn_s_sleep(2);
            }
            __builtin_amdgcn_fence(__ATOMIC_ACQUIRE, "agent");
            if (lane == 0) flag[0] = dead ? 1u : 0u;
        }
        asm volatile("s_waitcnt vmcnt(0) lgkmcnt(0)" ::: "memory"); __builtin_amdgcn_s_barrier(); asm volatile("" ::: "memory");
        const bool bad = flag[0] != 0u;
        if (lane < 32) {
            const unsigned long long* slot = (const unsigned long long*)xbuf + (size_t)(u.pm * BM + row) * 4; float mt[4], m2[4]; float ms = 0.f;
#pragma unroll
            for (int t = 0; t < 4; ++t) { if (t < ntn) { const unsigned long long w = __hip_atomic_load(slot + t, __ATOMIC_RELAXED, __HIP_MEMORY_SCOPE_AGENT); mt[t] = __uint_as_float((unsigned)w); m2[t] = __uint_as_float((unsigned)(w >> 32)); } else { mt[t] = 0.f; m2[t] = 0.f; } ms += mt[t]; }
            const float mean = ms / (float)ntn; float q = 0.f;
#pragma unroll
            for (int t = 0; t < 4; ++t) if (t < ntn) { const float dm = mt[t] - mean; q += m2[t] + 256.0f * dm * dm; }
            S[row] = (f32x2v){mean, 1.0f / sqrtf(q / (256.0f * (float)ntn) + eps)};
        }
        asm volatile("s_waitcnt lgkmcnt(0)" ::: "memory"); __builtin_amdgcn_s_barrier(); asm volatile("" ::: "memory");
        return bad;
    }
};
struct SliceOrder {
    StaticOrder S; int slice;
    __device__ __forceinline__ bool next(int i, Unit& u) const { return i == 0 ? S.next(slice, u) : false; }
    __device__ __forceinline__ void a_ready(const Unit&) const {}
    __device__ __forceinline__ void done(const Unit&) const {}
};
struct EpiLnMod {
    static constexpr bool PERM = false, AFTER_DRAIN = true; static constexpr int NSTORES = 0;
    const float* xin; float* xout; bf16_t* hout; const float* gate; const float* gam; const float* bet; const float* nsc; const float* nsh; PanelStats st; unsigned poison;
    __device__ __forceinline__ void fused(f32x4 (&acc)[2][2][4][2], const Unit& u, int wr, int wc, int fr, int fq, PG8_LAS unsigned char* lds, int wid, int lane) const {
        typedef float f32x2v __attribute__((ext_vector_type(2))); typedef unsigned u32x2v __attribute__((ext_vector_type(2)));
#define PG8_GAS __attribute__((address_space(1)))
        const PG8_LAS f32x2v* S = (const PG8_LAS f32x2v*)(lds + 8192);
        typedef unsigned u32x4b __attribute__((__vector_size__(16))); typedef unsigned u32x2b __attribute__((__vector_size__(8)));
        const size_t tbase = (size_t)(u.pm * BM) * 1024 + (size_t)(u.pn * BM); const int bofs = ((u.pm * BM) >> 12) * 6144 + u.pn * BM;
        const float* xu = xin + tbase; float* ou = xout + tbase; bf16_t* hu = hout + tbase;
        asm volatile("" : "+s"(xu), "+s"(ou), "+s"(hu));
        const float* gu = gate + bofs; const float* scu = nsc + bofs; const float* shu = nsh + bofs; const float* gmu = gam + u.pn * BM; const float* btu = bet + u.pn * BM;
        const unsigned lo = (unsigned)((wr * 64 + fr) * 1024 + wc * 32 + 4 * fq), lc = (unsigned)(wc * 32 + 4 * fq);
        f32x4 gv[2][2];
#pragma unroll
        for (int bj = 0; bj < 2; ++bj)
#pragma unroll
            for (int n = 0; n < 2; ++n) gv[bj][n] = *(const PG8_GAS f32x4*)(gu + (lc + (unsigned)(bj * HALF + n * 16)));
#pragma unroll
        for (int ai = 0; ai < 2; ++ai)
#pragma unroll
            for (int m = 0; m < 4; m += 2) { f32x4 xv[2][2][2];
#pragma unroll
                for (int mm = 0; mm < 2; ++mm)
#pragma unroll
                    for (int bj = 0; bj < 2; ++bj)
#pragma unroll
                        for (int n = 0; n < 2; ++n) xv[mm][bj][n] = *(const PG8_GAS f32x4*)(xu + (lo + (unsigned)((ai * HALF + (m + mm) * 16) * 1024 + bj * HALF + n * 16)));
#pragma unroll
                for (int mm = 0; mm < 2; ++mm)
#pragma unroll
                    for (int bj = 0; bj < 2; ++bj)
#pragma unroll
                        for (int n = 0; n < 2; ++n) acc[ai][bj][m + mm][n] = xv[mm][bj][n] * 1.6817928305074290861f + gv[bj][n] * acc[ai][bj][m + mm][n];
#pragma unroll
                for (int mm = 0; mm < 2; ++mm) asm volatile("" : "+v"(acc[ai][0][m + mm][0]), "+v"(acc[ai][0][m + mm][1]), "+v"(acc[ai][1][m + mm][0]), "+v"(acc[ai][1][m + mm][1]));
                asm volatile("" ::: "memory"); }
        const bool bad = st.run(acc, u, wr, wc, fr, fq, lds, wid, lane) || poison != 0u;
        const float qnan = __builtin_nanf("");
#pragma unroll
        for (int bj = 0; bj < 2; ++bj)
#pragma unroll
            for (int n = 0; n < 2; ++n) { const unsigned cc = lc + (unsigned)(bj * HALF + n * 16);
                const f32x4 gm = *(const PG8_GAS f32x4*)(gmu + cc), bt = *(const PG8_GAS f32x4*)(btu + cc), sc = *(const PG8_GAS f32x4*)(scu + cc) + 1.0f, sh = *(const PG8_GAS f32x4*)(shu + cc);
#pragma unroll
                for (int ai = 0; ai < 2; ++ai)
#pragma unroll
                    for (int m = 0; m < 4; ++m) { const int r = ai * HALF + wr * 64 + m * 16 + fr; const f32x2v sr = S[r]; const int so = (ai * HALF + m * 16) * 1024 + bj * HALF + n * 16;
                        f32x4 xn = (acc[ai][bj][m][n] - sr.x) * sr.y * gm + bt; if (bad) xn = (f32x4){qnan, qnan, qnan, qnan};
                        *(PG8_GAS f32x4*)(ou + (lo + (unsigned)so)) = xn;
                        const f32x4 hv = xn * sc + sh; u32x2v w; w.x = cvt_pk_bf16(hv[0], hv[1]); w.y = cvt_pk_bf16(hv[2], hv[3]);
                        *(PG8_GAS u32x2v*)(hu + (lo + (unsigned)so)) = w; }
                asm volatile("" ::: "memory"); }
#undef PG8_GAS
    }
};
template <class E, class = void> struct epi_defer { static constexpr int value = 0; };
template <class E> struct epi_defer<E, decltype((void)E::DEFER)> { static constexpr int value = E::DEFER; };
#ifndef W_PAIR
#define W_PAIR 1
#endif
template <class E, class = void> struct epi_adj { static constexpr bool value = false; };
template <class E> struct epi_adj<E, decltype((void)E::ADJ)> { static constexpr bool value = E::ADJ; };
template <class S, class = void> struct sched_custom { static constexpr bool value = false; };
template <class S> struct sched_custom<S, decltype((void)S::CUSTOM)> { static constexpr bool value = S::CUSTOM; };
template <class S, class = void> struct sched_gather { static constexpr bool value = false; };
template <class S> struct sched_gather<S, decltype((void)S::GATHER)> { static constexpr bool value = S::GATHER; };
template <class Epi, class Sched, bool ALIGN_EPI = false, bool SP2 = false>
__device__ __forceinline__ void gemm_phase(PG8_LAS unsigned char* lds, const Gemm g, const Sched& S, const Epi& E) {
    int tid_ = threadIdx.x; asm volatile("" : "+v"(tid_));
    const int tid = tid_, wid = __builtin_amdgcn_readfirstlane(tid >> 6), lane = tid & 63, wr = wid >> 2, wc = wid & 3, fr = lane & 15, fq = lane >> 4;
    const int K = g.K, nt = K / BK, LD = g.ld ? g.ld : g.K;
    constexpr bool CUSTOM = sched_custom<Sched>::value;
    constexpr bool GATHER = sched_gather<Sched>::value; static_assert(!GATHER || SP2, "the gathered A panel is wired into the SP2 loop only");
    unsigned cvA0[2], cvA1[2], sA0[2], sA1[2], gcol[2], grow[2], gni[4];
    unsigned voffA[2], voffB[2];
#pragma unroll
    for (int i = 0; i < 2; ++i) { int R, C; stage_rc(tid * 16 + i * 8192, R, C); const int Rb = epi_adj<Epi>::value ? ((R >> 5) * 64 + perm32(R & 31)) : (Epi::PERM ? ((R & ~31) + perm32(R & 31)) : R);
        voffA[i] = g.apair ? (unsigned)((R >> 1) * 2 * LD + (C >> 5) * 64 + (R & 1) * 32 + (C & 31)) * 2u : (unsigned)(R * LD + C) * 2u; voffB[i] = W_PAIR ? (unsigned)((Rb >> 1) * 2 * LD + (C >> 5) * 64 + (Rb & 1) * 32 + (C & 31)) * 2u : (unsigned)(Rb * LD + C) * 2u; gcol[i] = (unsigned)C * 2u; grow[i] = (unsigned)R; }
    const size_t kstepB = W_PAIR ? (size_t)(BK * 4) : (size_t)(BK * 2);
    const size_t kstepA = g.apair ? (size_t)(BK * 4) : (size_t)(BK * 2);
    const size_t kstep = (size_t)(BK * 2);
    const size_t hstep = (size_t)HALF * LD * 2;
    const size_t hstepB = epi_adj<Epi>::value ? (size_t)32 * LD * 2 : hstep;
    const size_t tstep = 2 * hstep;
    const unsigned ldsw = (unsigned)wid * 1024u;
    const int aoff = lds_byte(wr * 64 + fr, fq * 8), boff = lds_byte(wc * 32 + fr, fq * 8);
#define PG8_SA(b, h) (((b) * 2 + (h)) * HTB)
#define PG8_SB(b, h) ((4 + (b) * 2 + (h)) * HTB)
#define PG8_STAGE(bufoff, gbase, voff) do { _Pragma("unroll") for (int _i = 0; _i < 2; ++_i) \
        __builtin_amdgcn_global_load_lds((const unsigned*)((const char*)(gbase) + (voff)[_i]), (PG8_LAS unsigned*)(lds + (bufoff) + ldsw + _i * 8192), 16, 0, 0); } while (0)
#define PG8_GOFF(idx, i) (((idx) < (unsigned)(g.M - 1) ? (idx) : (unsigned)(g.M - 1)) * (unsigned)(LD * 2) + gcol[i])
#define PG8_GLOAD(uga) do { const __attribute__((address_space(1))) unsigned* tp_ = (const __attribute__((address_space(1))) unsigned*)(S.tab + (uga)); asm volatile("" : "+s"(tp_)); \
        gni[0] = tp_[grow[0]]; gni[1] = tp_[grow[1]]; gni[2] = tp_[grow[0] + 128u]; gni[3] = tp_[grow[1] + 128u]; } while (0)
#define PG8_GLOAD_ASM(uga) do { const unsigned* tp_ = S.tab + (uga); \
        asm volatile("global_load_dword %0, %4, %6\n\tglobal_load_dword %1, %5, %6\n\tglobal_load_dword %2, %4, %6 offset:512\n\tglobal_load_dword %3, %5, %6 offset:512" \
            : "=&v"(gni[0]), "=&v"(gni[1]), "=&v"(gni[2]), "=&v"(gni[3]) : "v"(grow[0] * 4u), "v"(grow[1] * 4u), "s"(tp_) : "memory"); } while (0)
#define PG8_STAGE_A(bufoff, base, half, SEL) do { if constexpr (GATHER) { if constexpr ((SEL) != 0) { if constexpr ((half) != 0) PG8_STAGE(bufoff, base, sA1); else PG8_STAGE(bufoff, base, sA0); } \
            else { if constexpr ((half) != 0) PG8_STAGE(bufoff, base, cvA1); else PG8_STAGE(bufoff, base, cvA0); } } else { PG8_STAGE(bufoff, (base) + (half) * hstep, voffA); } } while (0)
#define PG8_LDA(dst, b, h) do { _Pragma("unroll") for (int m = 0; m < 4; ++m) _Pragma("unroll") for (int k = 0; k < 2; ++k) dst[m][k] = *(const PG8_LAS bf16x8*)(lds + PG8_SA(b, h) + aoff + m * 2048 + k * 1024); } while (0)
#define PG8_LDB(dst, b, h) do { _Pragma("unroll") for (int n = 0; n < 2; ++n) _Pragma("unroll") for (int k = 0; k < 2; ++k) dst[n][k] = *(const PG8_LAS bf16x8*)(lds + PG8_SB(b, h) + boff + n * 2048 + k * 1024); } while (0)
#define PG8_MMA(ai, bj, At, Bt) do { __builtin_amdgcn_s_setprio(1); _Pragma("unroll") for (int m = 0; m < 4; ++m) _Pragma("unroll") for (int n = 0; n < 2; ++n) _Pragma("unroll") for (int k = 0; k < 2; ++k) \
        acc[ai][bj][m][n] = __builtin_amdgcn_mfma_f32_16x16x32_bf16(Bt[n][k], At[m][k], acc[ai][bj][m][n], 0, 0, 0); __builtin_amdgcn_s_setprio(0); } while (0)
#ifndef PG8_RELAX_ASM
#define PG8_RELAX_ASM 1
#endif
#define PG8_WAIT_V(n) asm volatile("s_waitcnt vmcnt(" #n ")" ::: "memory")
#define PG8_WAIT_L(n) asm volatile("s_waitcnt lgkmcnt(" #n ")" ::: "memory")
#if PG8_RELAX_ASM
#define PG8_WAIT_VR() do { if constexpr (Epi::NSTORES == 16) asm volatile("s_cmp_lg_u32 %0, 0\n\ts_cbranch_scc1 1f\n\ts_waitcnt vmcnt(8)\n\ts_branch 2f\n1:\n\ts_waitcnt vmcnt(24)\n2:" :: "s"(relax) : "scc", "memory"); \
        else if constexpr (Epi::NSTORES == 8) asm volatile("s_cmp_lg_u32 %0, 0\n\ts_cbranch_scc1 1f\n\ts_waitcnt vmcnt(8)\n\ts_branch 2f\n1:\n\ts_waitcnt vmcnt(16)\n2:" :: "s"(relax) : "scc", "memory"); \
        else asm volatile("s_waitcnt vmcnt(8)" ::: "memory"); } while (0)
#else
#define PG8_WAIT_VR() PG8_WAIT_V(8)
#endif
#if PG8_RELAX_ASM
#define PG8_WAIT_VG() do { if constexpr (Epi::NSTORES == 8) asm volatile("s_cmp_lg_u32 %0, 0\n\ts_cbranch_scc1 1f\n\ts_waitcnt vmcnt(12)\n\ts_branch 2f\n1:\n\ts_waitcnt vmcnt(20)\n2:" :: "s"(relax) : "scc", "memory"); \
        else asm volatile("s_waitcnt vmcnt(12)" ::: "memory"); } while (0)
#else
#define PG8_WAIT_VG() PG8_WAIT_V(12)
#endif
#define PG8_BAR __builtin_amdgcn_s_barrier()
#define PG8_SCHED __builtin_amdgcn_sched_barrier(0)
    Unit cur, nxt; int ui = 0;
    constexpr int DEFER = epi_defer<Epi>::value;
    u32x4 dq[DEFER > 0 ? DEFER : 1]; char* dbase = nullptr; unsigned dld = 0u;
    if constexpr (DEFER > 0) {
#pragma unroll
        for (int k = 0; k < DEFER; ++k) dq[k] = (u32x4){0u, 0u, 0u, 0u};
        dbase = (char*)E.dummy + ((size_t)blockIdx.x * 512 + (size_t)tid) * 16; }
#define PG8_DOFF(k) ((size_t)((unsigned)((((k) >> 2) * HALF + ((k) & 3) * 16)) * dld))
#define PG8_DMIN(a, b) ((a) < (b) ? (a) : (b))
#define PG8_DSTORE() do { *(__attribute__((address_space(1))) u32x4*)(dbase + PG8_DOFF((8 - DEFER) + PG8_DMIN(t >> 1, DEFER - 1))) = dq[0]; \
        _Pragma("unroll") for (int k = 0; k + 1 < DEFER; ++k) dq[k] = dq[k + 1]; } while (0)
#if defined(PG8_STAGGER_TICKS) && PG8_STAGGER_TICKS > 0
    {
        const unsigned long long t0_ = __builtin_amdgcn_s_memrealtime(); const unsigned long long dt_ = (unsigned long long)((blockIdx.x >> 3) & 7u) * (unsigned long long)(PG8_STAGGER_TICKS);
        while (__builtin_amdgcn_s_memrealtime() - t0_ < dt_) __builtin_amdgcn_s_sleep(4); }
#endif
#ifdef PROBE_KK
#define PG8_NEXT(i, u) S.next((i) >> 1, (u))
#else
#define PG8_NEXT(i, u) S.next((i), (u))
#endif
    if (!PG8_NEXT(0, cur)) return;
    f32x4 acc[2][2][4][2];
#pragma unroll
    for (int a = 0; a < 2; ++a)
#pragma unroll
        for (int b = 0; b < 2; ++b)
#pragma unroll
            for (int m = 0; m < 4; ++m)
#pragma unroll
                for (int n = 0; n < 2; ++n) acc[a][b][m][n] = (f32x4){0.f, 0.f, 0.f, 0.f};
    bf16x8 At[4][2], B0[2][2], B1[2][2];
    const char* cA; const char* cB;
    if constexpr (CUSTOM) { cA = S.abase(g, cur); cB = S.bbase(g, cur); }
    else { cA = (const char*)g.A + (GATHER ? (size_t)0 : (size_t)cur.pm * tstep); cB = (const char*)g.Bt + (size_t)cur.eb * g.estride + (size_t)cur.pn * tstep; }
    S.a_ready(cur);
    if constexpr (GATHER) { PG8_GLOAD(cur.ga);
#pragma unroll
        for (int i = 0; i < 2; ++i) { cvA0[i] = PG8_GOFF(gni[i], i); cvA1[i] = PG8_GOFF(gni[2 + i], i); sA0[i] = cvA0[i]; sA1[i] = cvA1[i]; } }
    if constexpr (SP2) {
        PG8_STAGE(PG8_SB(0, 0), cB, voffB); PG8_STAGE(PG8_SB(0, 1), cB + hstepB, voffB); PG8_STAGE_A(PG8_SA(0, 0), cA, 0, 0); PG8_STAGE_A(PG8_SA(0, 1), cA, 1, 0);
        if (wr == 1) PG8_BAR;
        PG8_WAIT_V(2); PG8_BAR;
        PG8_STAGE(PG8_SB(1, 0), cB + kstepB, voffB); PG8_STAGE_A(PG8_SA(1, 0), cA + kstepA, 0, 0); PG8_STAGE(PG8_SB(1, 1), cB + hstepB + kstepB, voffB);
        PG8_WAIT_V(6); PG8_BAR;
    } else {
        PG8_STAGE(PG8_SB(0, 0), cB, voffB); PG8_STAGE(PG8_SA(0, 0), cA, voffA); PG8_STAGE(PG8_SB(0, 1), cB + hstepB, voffB); PG8_STAGE(PG8_SA(0, 1), cA + hstep, voffA);
        if (wr == 1) PG8_BAR;
        PG8_WAIT_V(4); PG8_BAR;
        PG8_STAGE(PG8_SB(1, 0), cB + kstepB, voffB); PG8_STAGE(PG8_SA(1, 0), cA + kstepA, voffA); PG8_STAGE(PG8_SB(1, 1), cB + hstepB + kstepB, voffB);
        PG8_WAIT_V(6); PG8_BAR;
    }
    for (;;) {
        const bool has_next = PG8_NEXT(ui + 1, nxt);
        const int gan = has_next ? nxt.ga : cur.ga;
        const char* nA; const char* nB;
        if constexpr (CUSTOM) { nA = has_next ? S.abase(g, nxt) : cA; nB = has_next ? S.bbase(g, nxt) : cB; }
        else { nA = (has_next && !GATHER) ? (const char*)g.A + (size_t)nxt.pm * tstep : cA; nB = has_next ? (const char*)g.Bt + (size_t)nxt.eb * g.estride + (size_t)nxt.pn * tstep : cB; }
        for (int t = 0; t < nt; t += 2) {
            const bool last = (t == nt - 2);
#ifndef PG8_RELAX
#define PG8_RELAX 1
#endif
            const int relax = __builtin_amdgcn_readfirstlane((PG8_RELAX && SP2 && Epi::NSTORES > 0 && t == 0 && ui > 0) ? 1 : 0);
            const char* a1 = cA + (size_t)(t + 1) * kstepA;
            const char* a2 = last ? nA : cA + (size_t)(t + 2) * kstepA; const char* b2 = last ? nB : cB + (size_t)(t + 2) * kstepB;
            const char* a3 = a2 + kstepA; const char* b3 = b2 + kstepB;
            if (last && has_next) S.a_ready(nxt);
            if constexpr (GATHER) { const unsigned lm = last ? ~0u : 0u;
#pragma unroll
                for (int i = 0; i < 2; ++i) { const unsigned n0 = PG8_GOFF(gni[i], i), n1 = PG8_GOFF(gni[2 + i], i); sA0[i] = cvA0[i] ^ ((cvA0[i] ^ n0) & lm); sA1[i] = cvA1[i] ^ ((cvA1[i] ^ n1) & lm); } }
            if constexpr (SP2) {
            PG8_LDB(B0, 0, 0); PG8_LDB(B1, 0, 1); PG8_SCHED; PG8_LDA(At, 0, 0); PG8_STAGE_A(PG8_SA(1, 1), a1, 1, 0);
            if constexpr (GATHER && DEFER > 0) { PG8_GLOAD_ASM(gan); PG8_DSTORE(); PG8_WAIT_V(13); }
            else if constexpr (GATHER) { PG8_GLOAD_ASM(gan); PG8_WAIT_VG(); }
            else if constexpr (DEFER > 0) { PG8_DSTORE(); PG8_WAIT_V(9); }
            else { PG8_WAIT_VR(); }
            PG8_WAIT_L(0); PG8_BAR; PG8_MMA(0, 0, At, B0); PG8_MMA(0, 1, At, B1); PG8_BAR; PG8_SCHED;
            PG8_LDA(At, 0, 1); PG8_STAGE(PG8_SB(0, 0), b2, voffB); PG8_STAGE(PG8_SB(0, 1), b2 + hstepB, voffB); PG8_STAGE_A(PG8_SA(0, 0), a2, 0, 1);
            if constexpr (GATHER && DEFER > 0) { PG8_WAIT_V(13); } else if constexpr (GATHER) { PG8_WAIT_VG(); } else if constexpr (DEFER > 0) { PG8_WAIT_V(9); } else { PG8_WAIT_VR(); }
            PG8_WAIT_L(0); PG8_BAR; PG8_MMA(1, 0, At, B0); PG8_MMA(1, 1, At, B1); PG8_BAR; PG8_SCHED;
            PG8_LDB(B0, 1, 0); PG8_LDB(B1, 1, 1); PG8_SCHED; PG8_LDA(At, 1, 0); PG8_STAGE_A(PG8_SA(0, 1), a2, 1, 1);
            PG8_WAIT_V(8); PG8_WAIT_L(0); PG8_BAR; PG8_MMA(0, 0, At, B0); PG8_MMA(0, 1, At, B1); PG8_BAR; PG8_SCHED;
            PG8_LDA(At, 1, 1); PG8_STAGE(PG8_SB(1, 0), b3, voffB); PG8_STAGE(PG8_SB(1, 1), b3 + hstepB, voffB); PG8_STAGE_A(PG8_SA(1, 0), a3, 0, 1);
            PG8_WAIT_V(8); PG8_WAIT_L(0); PG8_BAR; PG8_MMA(1, 0, At, B0); PG8_MMA(1, 1, At, B1); PG8_BAR; PG8_SCHED;
            } else {
            PG8_LDB(B0, 0, 0); PG8_SCHED; PG8_LDA(At, 0, 0); PG8_STAGE(PG8_SA(1, 1), a1 + hstep, voffA);
            PG8_WAIT_L(8); PG8_BAR; PG8_WAIT_L(0); PG8_MMA(0, 0, At, B0); PG8_BAR; PG8_SCHED;
            PG8_LDB(B1, 0, 1); PG8_STAGE(PG8_SB(0, 0), b2, voffB);
            PG8_BAR; PG8_WAIT_L(0); PG8_MMA(0, 1, At, B1); PG8_BAR;
            PG8_LDA(At, 0, 1); PG8_STAGE(PG8_SA(0, 0), a2, voffA);
            PG8_BAR; PG8_WAIT_L(0); PG8_MMA(1, 0, At, B0); PG8_BAR; PG8_SCHED;
            PG8_STAGE(PG8_SB(0, 1), b2 + hstepB, voffB);
            PG8_WAIT_V(6); PG8_BAR; PG8_MMA(1, 1, At, B1); PG8_BAR;
            PG8_LDB(B0, 1, 0); PG8_SCHED; PG8_LDA(At, 1, 0); PG8_STAGE(PG8_SA(0, 1), a2 + hstep, voffA);
            PG8_WAIT_L(8); PG8_BAR; PG8_WAIT_L(0); PG8_MMA(0, 0, At, B0); PG8_BAR; PG8_SCHED;
            PG8_LDB(B1, 1, 1); PG8_STAGE(PG8_SB(1, 0), b3, voffB);
            PG8_BAR; PG8_WAIT_L(0); PG8_MMA(0, 1, At, B1); PG8_BAR;
            PG8_LDA(At, 1, 1); PG8_STAGE(PG8_SA(1, 0), a3, voffA);
            PG8_BAR; PG8_WAIT_L(0); PG8_MMA(1, 0, At, B0); PG8_BAR; PG8_SCHED;
            PG8_STAGE(PG8_SB(1, 1), b3 + hstepB, voffB);
            PG8_WAIT_V(6); PG8_BAR; PG8_MMA(1, 1, At, B1); PG8_BAR;
            }
        }
        if constexpr (ALIGN_EPI) { if (wr == 0) PG8_BAR; }
#ifdef PROBE_KK
        if (ui & 1)
#endif
        if constexpr (!Epi::AFTER_DRAIN) { if constexpr (DEFER > 0) E.pack(acc, cur, wr, wc, fr, fq, dq, dbase, dld); else E(acc, cur, wr, wc, fr, fq);
#ifdef PROBE_EPI2
            asm volatile("" ::: "memory"); E(acc, cur, wr, wc, fr, fq);
#endif
            S.done(cur); }
        if (!has_next) break;
#pragma unroll
        for (int a = 0; a < 2; ++a)
#pragma unroll
            for (int b = 0; b < 2; ++b)
#pragma unroll
                for (int m = 0; m < 4; ++m)
#pragma unroll
                    for (int n = 0; n < 2; ++n) acc[a][b][m][n] = (f32x4){0.f, 0.f, 0.f, 0.f};
        cur = nxt; cA = nA; cB = nB; ++ui;
        if constexpr (GATHER) {
#pragma unroll
            for (int i = 0; i < 2; ++i) { cvA0[i] = PG8_GOFF(gni[i], i); cvA1[i] = PG8_GOFF(gni[2 + i], i); } }
        if constexpr (ALIGN_EPI) { if (wr == 1) PG8_BAR; }
    }
    if constexpr (DEFER > 0) {
#pragma unroll
        for (int k = 0; k < DEFER; ++k) *(__attribute__((address_space(1))) u32x4*)(dbase + PG8_DOFF((8 - DEFER) + k)) = dq[k]; }
    PG8_WAIT_V(0);
    if constexpr (!ALIGN_EPI) { if (wr == 0) PG8_BAR; }
    PG8_BAR;
    if constexpr (Epi::AFTER_DRAIN) { E.fused(acc, cur, wr, wc, fr, fq, lds, wid, lane); S.done(cur); }
#undef PG8_NEXT
#undef PG8_DOFF
#undef PG8_DMIN
#undef PG8_DSTORE
#undef PG8_GOFF
#undef PG8_GLOAD
#undef PG8_GLOAD_ASM
#undef PG8_STAGE_A
#undef PG8_SA
#undef PG8_SB
#undef PG8_STAGE
#undef PG8_LDA
#undef PG8_LDB
#undef PG8_MMA
#undef PG8_WAIT_V
#undef PG8_WAIT_L
#undef PG8_WAIT_VR
#undef PG8_WAIT_VG
#undef PG8_BAR
#undef PG8_SCHED
}
}
#ifndef PG8_SP2
#define PG8_SP2 true
#endif
#ifndef PG8_ALIGN
#define PG8_ALIGN true
#endif

constexpr int NWAVES = 8;
constexpr int BATCH = 16, SEQ = 4096, D = 1024, M = BATCH * SEQ, FF = 3584, NEXP = 8, DEPTH = 4, NH_SB = 16, NH_HG = 8;
constexpr int MODW = 6 * D;
constexpr float LN_EPS = 1e-5f, RMS_EPS = 1e-6f, ALPHA = 1.6817928305074290861f;
constexpr int MPAD = 2 * M + NEXP * 256;
#ifndef MK_ONE_LAUNCH
#define MK_ONE_LAUNCH 1
#endif
constexpr int N_PHASES = 2 + 16 * 2;

constexpr size_t MiB = 1u << 20;
constexpr size_t WS_CTL = 0, CTL_ZERO_BYTES = 1 * MiB;
constexpr size_t WS_MOD = 2 * MiB;
constexpr size_t WS_LB = WS_MOD + 1536 * 1024 + 65536;
constexpr size_t WS_ROUTE = 4 * MiB;
constexpr size_t WS_XBF = 1659 * MiB;
constexpr size_t WS_XB = 6 * MiB;
constexpr size_t WS_W = 8 * MiB;
constexpr size_t W_SB_QKV = 0, W_SB_O = 6 * MiB, W_SB_13 = 8 * MiB, W_SB_2 = 22 * MiB;
constexpr size_t W_HG_IN = 0, W_HG_O = 8 * MiB, W_HG_13 = 10 * MiB, W_HG_2 = 122 * MiB;
constexpr size_t WS_WSB = 1630 * MiB;
constexpr size_t WS_H = 192 * MiB;
constexpr size_t WS_Y = 320 * MiB;
constexpr size_t WS_BIG = 448 * MiB;
constexpr size_t B_Q = WS_BIG, B_K = WS_BIG + 128 * MiB, B_V = WS_BIG + 256 * MiB, B_INTER = WS_BIG + 384 * MiB;
constexpr size_t B_HQ = WS_BIG, B_HF = WS_BIG + 128 * MiB, B_HI = WS_BIG + 384 * MiB, B_HGT = WS_BIG + 512 * MiB, B_HO = WS_BIG + 640 * MiB;
constexpr size_t B_HS = WS_BIG, B_MINTER = WS_BIG + 272 * MiB, B_YS = WS_BIG;
constexpr size_t WS_END = B_MINTER + (size_t)MPAD * FF * 2;
static_assert((size_t)MPAD * D * 2 <= 272 * MiB && WS_END <= WS_WSB && WS_WSB + 29 * MiB <= WS_XBF && WS_XBF + 128 * MiB <= 1792 * MiB, "d_ws map");
constexpr int CW_TMO = 0, CW_CODE = 1, CW_BAR = 4096, CW_CNT = 16384, CW_SEAM = 32768, SEAM_BANK = 256 * 64, CW_RDY = 140000, RDY_BANK = 1024;

static_assert((CW_SEAM + 6 * SEAM_BANK) <= CW_RDY && (CW_RDY + 16 * RDY_BANK) * 4 <= (int)CTL_ZERO_BYTES, "CTL words inside the memset region");

constexpr int RING_OFF = 0, RING_BYTES = 131072;
constexpr int LDSCTL_OFF = RING_BYTES, MISC_OFF = LDSCTL_OFF + 320;
constexpr int LDS_BYTES = 147456;
#define GAS __attribute__((address_space(1)))
#define LAS __attribute__((address_space(3)))
typedef unsigned short bf16;
typedef unsigned v4u __attribute__((ext_vector_type(4)));
typedef float f32x4 __attribute__((ext_vector_type(4)));
typedef short bf16x8 __attribute__((ext_vector_type(8)));
typedef GAS unsigned gu32;
typedef GAS unsigned long long gu64;
#define RLX_AGENT __ATOMIC_RELAXED, __HIP_MEMORY_SCOPE_AGENT
#define LDS_WAIT() asm volatile("s_waitcnt lgkmcnt(0)" ::: "memory")
#define VM_WAIT() asm volatile("s_waitcnt vmcnt(0)" ::: "memory")
__device__ __forceinline__ unsigned long long rt() { return __builtin_amdgcn_s_memrealtime(); }
__device__ __forceinline__ unsigned f2bf(float f) { unsigned u = __builtin_bit_cast(unsigned, f); return (u + 0x7fffu + ((u >> 16) & 1u)) >> 16; }
typedef float pk2_f32x2 __attribute__((ext_vector_type(2))); typedef __bf16 pk2_bf16x2 __attribute__((ext_vector_type(2)));
__device__ __forceinline__ unsigned pk2(float lo, float hi) { const pk2_f32x2 v = {lo, hi}; return __builtin_bit_cast(unsigned, __builtin_convertvector(v, pk2_bf16x2)); }

#define XB_TMO      128
#define XB_XCNT(j)  (256  + 64 * (j))
#define XB_XSUB(j)  (1280 + 64 * (j))
#define XB_XGEN(j)  (2304 + 64 * (j))
#define XB_TOP      3328
#define XB_TOPGEN   3392
#define XCD_BAR_WORDS 3456
#define XB_SPIN_CAP (1u << 18)

__device__ __forceinline__ unsigned xb_ld(unsigned* p)              { return __hip_atomic_load(p, __ATOMIC_RELAXED, __HIP_MEMORY_SCOPE_AGENT); }
__device__ __forceinline__ unsigned xb_add(unsigned* p, unsigned v) { return __hip_atomic_fetch_add(p, v, __ATOMIC_RELAXED, __HIP_MEMORY_SCOPE_AGENT); }
__device__ __forceinline__ unsigned xb_xcc_id() { return (unsigned)__builtin_amdgcn_s_getreg((3 << 11) | 20) & 0xFu; }
#define XB_SPIN(cond, bar) do { unsigned _sp = 0; while (cond) { __builtin_amdgcn_s_sleep(1); \
    if ((++_sp & 255u) == 0u) { if (xb_ld(&(bar)[XB_TMO])) break; if (_sp > XB_SPIN_CAP) { atomicAdd(&(bar)[XB_TMO], 1u); break; } } } } while (0)

struct XcdBarrier {
    unsigned* bar; unsigned x;
    volatile LAS unsigned* st;
};

__device__ __forceinline__ XcdBarrier xcd_barrier_post(unsigned* bar, volatile LAS unsigned* st) {
    XcdBarrier b; b.bar = bar; b.x = xb_xcc_id(); b.st = st;
    if (threadIdx.x == 0) (void)xb_add(&bar[XB_XCNT(b.x)], 1u);
    return b;
}
__device__ __forceinline__ void xcd_barrier_complete(unsigned* bar, unsigned x, unsigned& nloc, unsigned& nx) {
    const unsigned G = gridDim.x * gridDim.y * gridDim.z;
    unsigned sum, cnt, mine, sp = 0u;
    for (;;) {
        sum = 0u; cnt = 0u; mine = 0u;
#pragma unroll
        for (unsigned j = 0; j < 16; ++j) { const unsigned c = xb_ld(&bar[XB_XCNT(j)]); sum += c; cnt += (c > 0u) ? 1u : 0u; mine = (j == x) ? c : mine; }
        if (sum == G) break;
        __builtin_amdgcn_s_sleep(1);
        if ((++sp & 255u) == 0u) { if (xb_ld(&bar[XB_TMO])) break; if (sp > XB_SPIN_CAP) { atomicAdd(&bar[XB_TMO], 1u); break; } }
    }
    nloc = mine > 0u ? mine : 1u; nx = cnt > 0u ? cnt : 1u;
}

__device__ __forceinline__ void xcd_barrier(const XcdBarrier& b) {
    asm volatile("s_waitcnt vmcnt(0)" ::: "memory");
    __syncthreads();
    if (threadIdx.x == 0) {
        unsigned* bar = b.bar;
        __builtin_amdgcn_s_waitcnt(0);
        unsigned nloc = b.st[0], nx = b.st[1];
        if (nloc == 0u) { xcd_barrier_complete(bar, b.x, nloc, nx); b.st[0] = nloc; b.st[1] = nx; }
        const unsigned old = xb_add(&bar[XB_XSUB(b.x)], 1u);
        const unsigned gen = old / nloc;
        if (old + 1u == (gen + 1u) * nloc) {
            __builtin_amdgcn_fence(__ATOMIC_RELEASE, "agent");
            asm volatile("s_waitcnt vmcnt(0)" ::: "memory");
            const unsigned og = xb_add(&bar[XB_TOP], 1u);
            const unsigned tg = og / nx;
            if (og + 1u == (tg + 1u) * nx) xb_add(&bar[XB_TOPGEN], 1u);
            else XB_SPIN(xb_ld(&bar[XB_TOPGEN]) == tg, bar);
            __builtin_amdgcn_fence(__ATOMIC_ACQUIRE, "agent");
            xb_add(&bar[XB_XGEN(b.x)], 1u);
            asm volatile("s_waitcnt vmcnt(0)" ::: "memory");
        } else {
            XB_SPIN(xb_ld(&bar[XB_XGEN(b.x)]) == gen, bar);
            __builtin_amdgcn_fence(__ATOMIC_ACQUIRE, "agent");
            asm volatile("s_waitcnt vmcnt(0)" ::: "memory");
        }
    }
    __syncthreads();
}

typedef unsigned u32x2 __attribute__((ext_vector_type(2)));
struct Frame {
    LAS unsigned char* lds;
    volatile LAS unsigned* MISC;
    gu32* ctl;
    int tid, lane, wave, vcu, G;
};
__device__ __forceinline__ float shx(float v, int o, int lane) { return __int_as_float(__builtin_amdgcn_ds_bpermute((lane ^ o) << 2, __float_as_int(v))); }
__device__ __forceinline__ float wave_sum(float v, int lane) {
#pragma unroll
    for (int o = 1; o < 64; o <<= 1) v += shx(v, o, lane);
    return v;
}
__device__ __forceinline__ float bf_lo(unsigned w) { return __uint_as_float(w << 16); }
__device__ __forceinline__ float bf_hi(unsigned w) { return __uint_as_float(w & 0xffff0000u); }
__device__ __forceinline__ f32x4 ln_unpack4(u32x2 w) { f32x4 r; r[0] = bf_lo(w.x); r[1] = bf_hi(w.x); r[2] = bf_lo(w.y); r[3] = bf_hi(w.y); return r; }
__device__ __forceinline__ float sigmoid_f(float v) { return 1.0f / (1.0f + __expf(-v)); }

#ifndef CONV_ST_NT
#define CONV_ST_NT 0
#endif
__device__ __forceinline__ void conv_item(const float* W, int K, int N, bf16* WT, int drow0, LAS float* scr, int k0, int n0, int lane) {
    float wv[32];
#pragma unroll
    for (int i = 0; i < 32; ++i) wv[i] = __builtin_nontemporal_load((const GAS float*)(W + (size_t)(k0 + 2 * i + (lane >> 5)) * N + n0 + (lane & 31)));
#pragma unroll
    for (int i = 0; i < 32; ++i) scr[(2 * i + (lane >> 5)) * 33 + (lane & 31)] = wv[i];
    LDS_WAIT(); asm volatile("" ::: "memory");
    const int c = lane & 7;
#pragma unroll
    for (int j = 0; j < 4; ++j) { const int n = (lane >> 3) + 8 * j; const LAS float* s = scr + (8 * c) * 33 + n;
        v4u o; o.x = pk2(s[0 * 33], s[1 * 33]); o.y = pk2(s[2 * 33], s[3 * 33]); o.z = pk2(s[4 * 33], s[5 * 33]); o.w = pk2(s[6 * 33], s[7 * 33]);
        const int row_ = drow0 + n;
#if W_PAIR
        if (CONV_ST_NT) __builtin_nontemporal_store(o, (GAS v4u*)(WT + (size_t)(row_ >> 1) * 2 * K + ((k0 + 8 * c) >> 5) * 64 + (row_ & 1) * 32 + ((8 * c) & 31))); else
        *(GAS v4u*)(WT + (size_t)(row_ >> 1) * 2 * K + ((k0 + 8 * c) >> 5) * 64 + (row_ & 1) * 32 + ((8 * c) & 31)) = o; }
#else
        *(GAS v4u*)(WT + (size_t)row_ * K + k0 + 8 * c) = o; }
#endif
    LDS_WAIT(); asm volatile("" ::: "memory");
}
__device__ __forceinline__ int swiglu_row(int n0) { const int bj = n0 / FF, jj = n0 % FF; return 256 * (jj / 128) + 128 * bj + (jj % 128); }
__device__ __forceinline__ void conv_sb(Frame& F, const float* wqkv, const float* wo, const float* w13, const float* w2, unsigned char* wbuf) {
    LAS float* scr = (LAS float*)(F.lds + RING_OFF + F.wave * 16384);
    const int gw = F.vcu * NWAVES + F.wave, NGW = F.G * NWAVES;
    constexpr int I_QKV = 16 * 96, I_O = 16 * 32, I_13 = 16 * 224, I_2 = 56 * 32, NIT = I_QKV + I_O + I_13 + I_2;
    for (int it = gw; it < NIT; it += NGW) {
        int r = it;
        if (r < I_QKV) { conv_item(wqkv, D, 3 * D, (bf16*)(wbuf + W_SB_QKV), 32 * (r % 96), scr, 64 * (r / 96), 32 * (r % 96), F.lane); continue; } r -= I_QKV;
        if (r < I_O) { conv_item(wo, D, D, (bf16*)(wbuf + W_SB_O), 32 * (r % 32), scr, 64 * (r / 32), 32 * (r % 32), F.lane); continue; } r -= I_O;
        if (r < I_13) { conv_item(w13, D, 2 * FF, (bf16*)(wbuf + W_SB_13), swiglu_row(32 * (r % 224)), scr, 64 * (r / 224), 32 * (r % 224), F.lane); continue; } r -= I_13;
        conv_item(w2, FF, D, (bf16*)(wbuf + W_SB_2), 32 * (r % 32), scr, 64 * (r / 32), 32 * (r % 32), F.lane);
    }
}
struct ConvHg { const float* win; const float* wo; const float* m13; const float* m2; unsigned char* wbuf; };
__device__ __forceinline__ void conv_hg_items(Frame& F, const ConvHg& J, LAS float* scr, int k0, int k1) {
    const int gw = F.vcu * NWAVES + F.wave, NGW = F.G * NWAVES;
    constexpr int I_IN = 16 * 128, I_O = 16 * 32, I_13 = 16 * 224, I_2 = 56 * 32, NIT = I_IN + I_O + NEXP * (I_13 + I_2);
    for (int k = k0; k < k1; ++k) {
        int r = gw + k * NGW; if (r >= NIT) break;
        if (r < I_IN) { conv_item(J.win, D, 4 * D, (bf16*)(J.wbuf + W_HG_IN), 32 * (r % 128), scr, 64 * (r / 128), 32 * (r % 128), F.lane); continue; } r -= I_IN;
        if (r < I_O) { conv_item(J.wo, D, D, (bf16*)(J.wbuf + W_HG_O), 32 * (r % 32), scr, 64 * (r / 32), 32 * (r % 32), F.lane); continue; } r -= I_O;
        if (r < NEXP * I_13) { const int e = r / I_13, r2 = r % I_13;
            conv_item(J.m13 + (size_t)e * D * 2 * FF, D, 2 * FF, (bf16*)(J.wbuf + W_HG_13) + (size_t)e * 2 * FF * D, swiglu_row(32 * (r2 % 224)), scr, 64 * (r2 / 224), 32 * (r2 % 224), F.lane); continue; } r -= NEXP * I_13;
        { const int e = r / I_2, r2 = r % I_2;
            conv_item(J.m2 + (size_t)e * FF * D, FF, D, (bf16*)(J.wbuf + W_HG_2) + (size_t)e * D * FF, 32 * (r2 % 32), scr, 64 * (r2 / 32), 32 * (r2 % 32), F.lane); }
    }
}
constexpr int CONV_HG_K = (16 * 128 + 16 * 32 + NEXP * (16 * 224 + 56 * 32) + 2047) / 2048 + 1;

__device__ __forceinline__ void mod_phase(Frame& F, const float* c, const float* ada_w, const float* ada_b, const float* lbl, float* mod, float* lbv) {
    LAS float* condT = (LAS float*)(F.lds + RING_OFF);
    LAS float* part = (LAS float*)(F.lds + RING_OFF + 65536);
    for (int idx = F.tid; idx < BATCH * D; idx += NWAVES * 64) { const int b = idx >> 10, k = idx & 1023; const float v = c[idx]; condT[k * 16 + b] = v * sigmoid_f(v); }
    __syncthreads();
    for (int it = blockIdx.x; it < DEPTH * (MODW / 64); it += F.G) {
        const int l = it / (MODW / 64), nb = it % (MODW / 64), n = nb * 64 + F.lane;
        float acc[16];
#pragma unroll
        for (int b = 0; b < 16; ++b) acc[b] = 0.f;
        const float* wp = ada_w + ((size_t)l * D + 128 * F.wave) * MODW + n;
#pragma unroll 4
        for (int k = 0; k < 128; ++k) { const float wv = wp[(size_t)k * MODW]; const LAS f32x4* cd = (const LAS f32x4*)(condT + (128 * F.wave + k) * 16);
#pragma unroll
            for (int q = 0; q < 4; ++q) { const f32x4 cv = cd[q]; acc[4 * q + 0] += cv[0] * wv; acc[4 * q + 1] += cv[1] * wv; acc[4 * q + 2] += cv[2] * wv; acc[4 * q + 3] += cv[3] * wv; } }
#pragma unroll
        for (int b = 0; b < 16; ++b) part[(F.wave * 16 + b) * 64 + F.lane] = acc[b];
        __syncthreads();
#pragma unroll
        for (int r = 0; r < 2; ++r) { const int idx = F.tid + 512 * r, b = idx >> 6, nn = idx & 63; float s = ada_b[l * MODW + nb * 64 + nn];
#pragma unroll
            for (int w = 0; w < 8; ++w) s += part[(w * 16 + b) * 64 + nn];
            mod[((size_t)l * BATCH + b) * MODW + nb * 64 + nn] = s; }
        __syncthreads();
    }
    if ((int)blockIdx.x == F.G - 1) {
        for (int d = F.tid; d < D; d += NWAVES * 64) { const float g0 = lbl[d], g1 = lbl[D + d], g2 = lbl[2 * D + d], g3 = lbl[3 * D + d];
            const float mx = fmaxf(fmaxf(g0, g1), fmaxf(g2, g3)); const float e0 = __expf(g0 - mx), e1 = __expf(g1 - mx), e2 = __expf(g2 - mx), e3 = __expf(g3 - mx); const float inv = 1.0f / (e0 + e1 + e2 + e3);
            lbv[d] = e1 * inv; lbv[D + d] = (e1 + e2 + e3) * inv; }
    }
    __syncthreads();
}

__device__ __forceinline__ void modulate_phase(Frame& F, const float* x, const float* mod0, bf16* H) {
    const int gw = F.vcu * NWAVES + F.wave, NGW = F.G * NWAVES;
    for (int it = gw; it < M / 32; it += NGW) {
        const int row0 = it * 32, b = row0 / SEQ; const float* mb = mod0 + (size_t)b * MODW;
        f32x4 sh[4], sc[4];
#pragma unroll
        for (int j = 0; j < 4; ++j) { sh[j] = *(const f32x4*)(mb + 256 * j + 4 * F.lane); sc[j] = *(const f32x4*)(mb + D + 256 * j + 4 * F.lane) + 1.0f; }
        for (int r = 0; r < 32; ++r) { const size_t m = (size_t)(row0 + r);
#pragma unroll
            for (int j = 0; j < 4; ++j) { const f32x4 v = __builtin_nontemporal_load((const GAS f32x4*)(x + m * D + 256 * j + 4 * F.lane)) * sc[j] + sh[j];
                u32x2 w; w.x = pk2(v[0], v[1]); w.y = pk2(v[2], v[3]); *(GAS u32x2*)(H + m * D + 256 * j + 4 * F.lane) = w; } }
    }
}

#ifndef LN_PD
#define LN_PD 4
#endif
#ifndef LN_PD_B
#define LN_PD_B 4
#endif
#ifndef LN_PD_MOE_LAST
#define LN_PD_MOE_LAST 2
#endif
#ifndef LN_PD_MOE
#define LN_PD_MOE 2
#endif
#ifndef LN_PD_ROUTE
#define LN_PD_ROUTE 2
#endif
template <bool MOE_Y, bool ROUTE, bool HAS_H, bool RO = false, bool XIB = false, bool XOB = false, bool QP = false>
__device__ __forceinline__ void ln_phase(Frame& F, const float* xin, float* xout, const bf16* Y, const float* gatev, const float* gam, const float* bet,
                                         const float* nsc, const float* nsh, bf16* H, const float* router, unsigned* route, gu32* cnt, unsigned* rtab = nullptr) {
    const int gw = F.vcu * NWAVES + F.wave, NGW = F.G * NWAVES;
    LAS float* rl = (LAS float*)(F.lds + RING_OFF);
    if (ROUTE) { for (int i = F.tid; i < D * NEXP; i += NWAVES * 64) rl[(i & 7) * D + (i >> 3)] = router[i]; __syncthreads(); }
    unsigned rbase[8];
    if (MOE_Y) { unsigned s = 0;
#pragma unroll
        for (int e = 0; e < 8; ++e) { rbase[e] = s; const unsigned ce = (unsigned)__builtin_amdgcn_readfirstlane(__hip_atomic_load(cnt + 64 * e, RLX_AGENT)); s += ((ce + 255u) >> 8) << 8; } }
    constexpr int NR = QP ? 8 : 32;
    for (int it = QP ? ((F.vcu & 1) ? 0 : 8) : gw; it < (QP ? 8 : M / 32); it += (QP ? 1 : NGW)) {
        const int row0 = QP ? ((F.vcu >> 5) * 8192 + it * 1024 + 2 * (((F.vcu & 31) >> 1) * NWAVES + F.wave)) : it * 32, b = row0 / SEQ;
#define LN_ROW(rr) (QP ? (row0 + 256 * ((rr) >> 1) + ((rr) & 1)) : (row0 + (rr)))
        f32x4 gt[4], gm[4], bt[4], sc[4], sh[4];
#pragma unroll
        for (int j = 0; j < 4; ++j) { const int cc = 256 * j + 4 * F.lane; if (!RO) { gt[j] = *(const GAS f32x4*)(gatev + (size_t)b * MODW + cc); gm[j] = *(const f32x4*)(gam + cc); bt[j] = *(const f32x4*)(bet + cc); }
            if (HAS_H) { sc[j] = *(const GAS f32x4*)(nsc + (size_t)b * MODW + cc) + 1.0f; sh[j] = *(const GAS f32x4*)(nsh + (size_t)b * MODW + cc); } }
        unsigned my_e1 = 0, my_e2 = 0; float my_w1 = 0.f, my_w2 = 0.f;
        v4u rt0 = {0u, 0u, 0u, 0u}, rt1 = {0u, 0u, 0u, 0u};
        if (MOE_Y) { const size_t mr = (size_t)LN_ROW(F.lane & 31); rt0 = *(const GAS v4u*)(route + mr * 8); rt1 = *(const GAS v4u*)(route + mr * 8 + 4); }
        constexpr int PD = ROUTE ? LN_PD_ROUTE : (MOE_Y ? (HAS_H ? LN_PD_MOE : LN_PD_MOE_LAST) : (XIB ? LN_PD_B : LN_PD));
        f32x4 nx[PD][4]; u32x2 nxb[PD][4], nya[PD][4], nyb[PD][4]; float nwa[PD], nwb[PD];
#ifndef LN_NT
#define LN_NT 1
#endif
#ifndef H_ST_NT
#define H_ST_NT 0
#endif
#ifndef LN_Y_NT
#define LN_Y_NT 1
#endif
#ifndef LN_XB_ST_NT
#define LN_XB_ST_NT 1
#endif
#ifndef LN_XB_NT
#define LN_XB_NT 1
#endif
#if LN_NT
#define LN_LD4(p_) __builtin_nontemporal_load((const GAS f32x4*)(p_))
#define LN_LD2(p_) (LN_Y_NT ? __builtin_nontemporal_load((const GAS u32x2*)(p_)) : *(const GAS u32x2*)(p_))
#define LN_ST4(p_, v_) __builtin_nontemporal_store((v_), (GAS f32x4*)(p_))
#else
#define LN_LD4(p_) (*(const GAS f32x4*)(p_))
#define LN_LD2(p_) (*(const GAS u32x2*)(p_))
#define LN_ST4(p_, v_) (*(GAS f32x4*)(p_) = (v_))
#endif
#define LN_XLOAD(S_, j_, mm_, cc_) do { if (XIB) nxb[S_][j_] = LN_XB_NT ? __builtin_nontemporal_load((const GAS u32x2*)((const bf16*)xin + (mm_) * D + (cc_))) : *(const GAS u32x2*)((const bf16*)xin + (mm_) * D + (cc_)); else nx[S_][j_] = LN_LD4(xin + (mm_) * D + (cc_)); } while (0)
#define LN_LOAD(rr, S_) do { const size_t m_ = (size_t)LN_ROW(rr); \
            if (MOE_Y) { const unsigned e1_ = (unsigned)__builtin_amdgcn_readlane((int)rt0.x, (rr)), p1_ = (unsigned)__builtin_amdgcn_readlane((int)rt0.y, (rr)), e2_ = (unsigned)__builtin_amdgcn_readlane((int)rt0.z, (rr)), p2_ = (unsigned)__builtin_amdgcn_readlane((int)rt0.w, (rr)); \
                nwa[S_] = __uint_as_float((unsigned)__builtin_amdgcn_readlane((int)rt1.x, (rr))); nwb[S_] = __uint_as_float((unsigned)__builtin_amdgcn_readlane((int)rt1.y, (rr))); \
                unsigned ba_ = 0, bb_ = 0; \
                _Pragma("unroll") for (int e = 0; e < 8; ++e) { ba_ = (e1_ == (unsigned)e) ? rbase[e] : ba_; bb_ = (e2_ == (unsigned)e) ? rbase[e] : bb_; } \
                const size_t ra_ = (size_t)(ba_ + p1_), rb_ = (size_t)(bb_ + p2_); \
                _Pragma("unroll") for (int j = 0; j < 4; ++j) { const int cc = 256 * j + 4 * F.lane; LN_XLOAD(S_, j, m_, cc); nya[S_][j] = LN_LD2(Y + ra_ * D + cc); nyb[S_][j] = LN_LD2(Y + rb_ * D + cc); } \
            } else { \
                _Pragma("unroll") for (int j = 0; j < 4; ++j) { const int cc = 256 * j + 4 * F.lane; LN_XLOAD(S_, j, m_, cc); if (!RO) nya[S_][j] = LN_LD2(Y + m_ * D + cc); } } } while (0)
        if (MOE_Y) { nwa[0] = 0.f; nwb[0] = 0.f; }
#pragma unroll
        for (int s_ = 0; s_ < PD; ++s_) LN_LOAD(s_, s_);
        for (int r2 = 0; r2 < NR; r2 += PD)
#pragma unroll
        for (int s_ = 0; s_ < PD; ++s_) { const int r = r2 + s_; const size_t m = (size_t)LN_ROW(r);
            f32x4 v[4]; float s = 0.f;
            {   f32x4 cx[4]; u32x2 cya[4], cyb[4]; const float wa = MOE_Y ? nwa[s_] : 0.f, wb = MOE_Y ? nwb[s_] : 0.f;
#pragma unroll
                for (int j = 0; j < 4; ++j) { cx[j] = XIB ? ln_unpack4(nxb[s_][j]) : nx[s_][j]; if (!RO) cya[j] = nya[s_][j]; if (MOE_Y) cyb[j] = nyb[s_][j]; }
                if (r + PD < NR) LN_LOAD(r + PD, s_);
#pragma unroll
                for (int j = 0; j < 4; ++j) { f32x4 yv;
                    if (MOE_Y) { yv[0] = wa * bf_lo(cya[j].x) + wb * bf_lo(cyb[j].x); yv[1] = wa * bf_hi(cya[j].x) + wb * bf_hi(cyb[j].x); yv[2] = wa * bf_lo(cya[j].y) + wb * bf_lo(cyb[j].y); yv[3] = wa * bf_hi(cya[j].y) + wb * bf_hi(cyb[j].y); }
                    else if (!RO) { yv[0] = bf_lo(cya[j].x); yv[1] = bf_hi(cya[j].x); yv[2] = bf_lo(cya[j].y); yv[3] = bf_hi(cya[j].y); }
                    if (RO) v[j] = cx[j]; else { v[j] = cx[j] * ALPHA + gt[j] * yv; s += (v[j][0] + v[j][1]) + (v[j][2] + v[j][3]); } }
            }
            float rstd = 1.0f;
            if (!RO) { const float mean = wave_sum(s, F.lane) * (1.0f / D); float s2 = 0.f;
#pragma unroll
                for (int j = 0; j < 4; ++j) { v[j] = v[j] - mean; s2 += (v[j][0] * v[j][0] + v[j][1] * v[j][1]) + (v[j][2] * v[j][2] + v[j][3] * v[j][3]); }
                rstd = 1.0f / sqrtf(wave_sum(s2, F.lane) * (1.0f / D) + LN_EPS); }
            float lg[8];
#pragma unroll
            for (int e = 0; e < 8; ++e) lg[e] = 0.f;
#pragma unroll
            for (int j = 0; j < 4; ++j) { const int cc = 256 * j + 4 * F.lane; const f32x4 xn = RO ? v[j] : v[j] * rstd * gm[j] + bt[j]; if (!RO) { if (XOB) { u32x2 wx; wx.x = pk2(xn[0], xn[1]); wx.y = pk2(xn[2], xn[3]); if (LN_XB_ST_NT) __builtin_nontemporal_store(wx, (GAS u32x2*)((bf16*)xout + m * D + cc)); else *(GAS u32x2*)((bf16*)xout + m * D + cc) = wx; } else LN_ST4(xout + m * D + cc, xn); }
                if (HAS_H) { const f32x4 hv = xn * sc[j] + sh[j]; if (!RO) { u32x2 w; w.x = pk2(hv[0], hv[1]); w.y = pk2(hv[2], hv[3]);
                    if (QP) __hip_atomic_store((gu64*)(H + m * D + cc), (unsigned long long)w.x | ((unsigned long long)w.y << 32), RLX_AGENT);
                    else if (H_ST_NT) __builtin_nontemporal_store(w, (GAS u32x2*)(H + m * D + cc)); else *(GAS u32x2*)(H + m * D + cc) = w; } v[j] = hv; } }
            if (ROUTE) {
#pragma unroll
                for (int j = 0; j < 4; ++j) { const int cc = 256 * j + 4 * F.lane;
#pragma unroll
                    for (int e = 0; e < 8; ++e) { const f32x4 rw = *(const LAS f32x4*)(rl + e * D + cc); lg[e] += (v[j][0] * rw[0] + v[j][1] * rw[1]) + (v[j][2] * rw[2] + v[j][3] * rw[3]); }
                    asm volatile("" ::: "memory"); }
            }
            if (ROUTE) {
#pragma unroll
                for (int e = 0; e < 8; ++e) lg[e] = wave_sum(lg[e], F.lane);
                int i1 = 0; float l1 = lg[0];
#pragma unroll
                for (int e = 1; e < 8; ++e) if (lg[e] > l1) { l1 = lg[e]; i1 = e; }
                int i2 = -1; float l2 = -INFINITY;
#pragma unroll
                for (int e = 0; e < 8; ++e) if (e != i1 && lg[e] > l2) { l2 = lg[e]; i2 = e; }
                const float w1 = 1.0f / (1.0f + __expf(l2 - l1)), w2 = 1.0f - w1;
                if (F.lane == r) { my_e1 = (unsigned)i1; my_e2 = (unsigned)i2; my_w1 = w1; my_w2 = w2; }
            }
        }
        if (QP) { asm volatile("s_waitcnt vmcnt(0)" ::: "memory"); if (F.lane == 0) __hip_atomic_fetch_add(cnt + 16 * (8 * (F.vcu >> 5) + it), 1u, RLX_AGENT); }
        if (ROUTE) {
            const bool act = F.lane < 32; unsigned p1 = 0, p2 = 0; const unsigned long long lt = (1ull << F.lane) - 1ull;
#pragma unroll
            for (int e = 0; e < 8; ++e) { const unsigned long long m1 = __ballot(act && my_e1 == (unsigned)e), m2 = __ballot(act && my_e2 == (unsigned)e);
                const unsigned n1 = (unsigned)__popcll(m1), n2 = (unsigned)__popcll(m2); unsigned base = 0;
                if (F.lane == 0 && (n1 + n2) != 0u) base = __hip_atomic_fetch_add(cnt + 64 * e, n1 + n2, RLX_AGENT);
                base = (unsigned)__builtin_amdgcn_readfirstlane(base);
                if (my_e1 == (unsigned)e) p1 = base + (unsigned)__popcll(m1 & lt);
                if (my_e2 == (unsigned)e) p2 = base + n1 + (unsigned)__popcll(m2 & lt); }
            if (act) { const size_t m = (size_t)LN_ROW(F.lane); v4u a; a.x = my_e1; a.y = p1; a.z = my_e2; a.w = p2; v4u bb; bb.x = __float_as_uint(my_w1); bb.y = __float_as_uint(my_w2); bb.z = 0u; bb.w = 0u;
                *(GAS v4u*)(route + m * 8) = a; *(GAS v4u*)(route + m * 8 + 4) = bb;
                if (rtab != nullptr) { *(GAS unsigned*)(rtab + (size_t)my_e1 * M + p1) = (unsigned)m; *(GAS unsigned*)(rtab + (size_t)my_e2 * M + p2) = (unsigned)m; } }
        }
    }
    if (ROUTE) __syncthreads();
#undef LN_LOAD
#undef LN_XLOAD
#undef LN_LD4
#undef LN_LD2
#undef LN_ST4
#undef LN_ROW
}

__device__ __forceinline__ void moe_tail_reduce(Frame& F, const pg8::GroupedOrder& S, int first, int ntail, int KS, const bf16* PB, bf16* YS) {
    const int gw = F.vcu * NWAVES + F.wave, NGW = F.G * NWAVES;
    for (int it = gw; it < ntail * 256; it += NGW) { const int t = it >> 8, r = it & 255; pg8::Unit u; S.unit_of(first + t, u);
        float a0 = 0.f, a1 = 0.f, a2 = 0.f, a3 = 0.f;
        for (int s = 0; s < KS; ++s) { const u32x2 w = *(const GAS u32x2*)(PB + ((size_t)(s * ntail + t) * 256 + r) * 256 + 4 * F.lane); a0 += bf_lo(w.x); a1 += bf_hi(w.x); a2 += bf_lo(w.y); a3 += bf_hi(w.y); }
        u32x2 o; o.x = pk2(a0, a1); o.y = pk2(a2, a3); *(GAS u32x2*)(YS + ((size_t)u.pm * 256 + r) * D + u.pn * 256 + 4 * F.lane) = o; }
}

__device__ __forceinline__ void permute_phase(Frame& F, const bf16* H, const unsigned* route, gu32* cnt, bf16* HS) {
    const int gw = F.vcu * NWAVES + F.wave, NGW = F.G * NWAVES;
    unsigned rbase[8]; { unsigned s = 0;
#pragma unroll
        for (int e = 0; e < 8; ++e) { rbase[e] = s; const unsigned ce = (unsigned)__builtin_amdgcn_readfirstlane(__hip_atomic_load(cnt + 64 * e, RLX_AGENT)); s += ((ce + 255u) >> 8) << 8; } }
    for (int m0 = gw; m0 < M; m0 += 4 * NGW) {
        v4u rr[4], h0[4], h1[4]; size_t ra[4], rb[4];
#pragma unroll
        for (int k = 0; k < 4; ++k) { const int m = m0 + k * NGW; if (m < M) rr[k] = *(const GAS v4u*)(route + (size_t)m * 8); }
#pragma unroll
        for (int k = 0; k < 4; ++k) { const int m = m0 + k * NGW; if (m < M) { h0[k] = __builtin_nontemporal_load((const GAS v4u*)(H + (size_t)m * D + 8 * F.lane)); h1[k] = __builtin_nontemporal_load((const GAS v4u*)(H + (size_t)m * D + 512 + 8 * F.lane)); } }
#pragma unroll
        for (int k = 0; k < 4; ++k) { unsigned ba = 0, bb = 0;
#pragma unroll
            for (int e = 0; e < 8; ++e) { ba = (rr[k].x == (unsigned)e) ? rbase[e] : ba; bb = (rr[k].z == (unsigned)e) ? rbase[e] : bb; }
            ra[k] = (size_t)(ba + rr[k].y); rb[k] = (size_t)(bb + rr[k].w); }
#pragma unroll
        for (int k = 0; k < 4; ++k) { const int m = m0 + k * NGW; if (m < M) {
            *(GAS v4u*)(HS + ra[k] * D + 8 * F.lane) = h0[k]; *(GAS v4u*)(HS + ra[k] * D + 512 + 8 * F.lane) = h1[k];
            *(GAS v4u*)(HS + rb[k] * D + 8 * F.lane) = h0[k]; *(GAS v4u*)(HS + rb[k] * D + 512 + 8 * F.lane) = h1[k]; } }
    }
}

__device__ __forceinline__ void hgate_phase(Frame& F, const float* O, const bf16* SG, const float* ng, bf16* H) {
    const int gw = F.vcu * NWAVES + F.wave, NGW = F.G * NWAVES;
    const f32x4 g4 = *(const f32x4*)(ng + ((4 * F.lane) & 127));
    for (int m0 = gw; m0 < M; m0 += 2 * NGW) {
        f32x4 ov[2][4]; u32x2 gv[2][4];
#pragma unroll
        for (int k = 0; k < 2; ++k) { const int m = m0 + k * NGW; if (m < M) {
#pragma unroll
            for (int j = 0; j < 4; ++j) { const int cc = 256 * j + 4 * F.lane; ov[k][j] = *(const GAS f32x4*)(O + (size_t)m * D + cc); gv[k][j] = *(const GAS u32x2*)(SG + (size_t)m * D + cc); } } }
#pragma unroll
        for (int k = 0; k < 2; ++k) { const int m = m0 + k * NGW; if (m < M) {
#pragma unroll
            for (int j = 0; j < 4; ++j) { const int cc = 256 * j + 4 * F.lane; const f32x4 o = ov[k][j]; const u32x2 gw2 = gv[k][j];
                float q = (o[0] * o[0] + o[1] * o[1]) + (o[2] * o[2] + o[3] * o[3]);
#pragma unroll
                for (int s2 = 1; s2 < 32; s2 <<= 1) q += shx(q, s2, F.lane);
                const float rs = 1.0f / sqrtf(q * (1.0f / 128.0f) + RMS_EPS);
                f32x4 r; r[0] = o[0] * rs * g4[0] * bf_lo(gw2.x); r[1] = o[1] * rs * g4[1] * bf_hi(gw2.x); r[2] = o[2] * rs * g4[2] * bf_lo(gw2.y); r[3] = o[3] * rs * g4[3] * bf_hi(gw2.y);
                u32x2 w; w.x = pk2(r[0], r[1]); w.y = pk2(r[2], r[3]); *(GAS u32x2*)(H + (size_t)m * D + cc) = w; } } }
    }
}

__device__ __forceinline__ void hgrn_phase(Frame& F, const bf16* Q, const float* Fg, const bf16* I, float* O) {
    LAS float* sq = (LAS float*)(F.lds + RING_OFF);
    LAS float* sf = sq + 4096;
    LAS float* sv = sf + 4096;
    LAS float* so = sv + 2048;
    const int tt = F.tid >> 4, d8 = (F.tid & 15) * 8, c4 = (F.tid & 15) * 4;
    for (int u = blockIdx.x; u < BATCH * NH_HG * 2; u += F.G) {
        const int b = u >> 4, h = (u >> 1) & 7, half = u & 1; const size_t row0 = (size_t)b * SEQ;
        float S[16];
#pragma unroll
        for (int j = 0; j < 16; ++j) S[j] = 0.f;
        const bf16* qp = Q + (row0 + tt) * D + h * 128 + d8; const float* fp = Fg + (row0 + tt) * D + h * 128 + d8; const bf16* ip = I + (row0 + tt) * D + h * 128 + half * 64 + c4;
        v4u rq = *(const GAS v4u*)qp; f32x4 rf0 = *(const GAS f32x4*)fp, rf1 = *(const GAS f32x4*)(fp + 4); u32x2 rv = *(const GAS u32x2*)ip;
        for (int ck = 0; ck < SEQ / 32; ++ck) {
            { LAS float* q8 = sq + tt * 128 + d8; q8[0] = bf_lo(rq.x); q8[1] = bf_hi(rq.x); q8[2] = bf_lo(rq.y); q8[3] = bf_hi(rq.y); q8[4] = bf_lo(rq.z); q8[5] = bf_hi(rq.z); q8[6] = bf_lo(rq.w); q8[7] = bf_hi(rq.w);
              *(LAS f32x4*)(sf + tt * 128 + d8) = rf0; *(LAS f32x4*)(sf + tt * 128 + d8 + 4) = rf1;
              LAS float* v4 = sv + tt * 64 + c4; v4[0] = bf_lo(rv.x); v4[1] = bf_hi(rv.x); v4[2] = bf_lo(rv.y); v4[3] = bf_hi(rv.y); }
            __syncthreads();
            if (ck + 1 < SEQ / 32) { const size_t adv = (size_t)(ck + 1) * 32 * D; rq = *(const GAS v4u*)(qp + adv); rf0 = *(const GAS f32x4*)(fp + adv); rf1 = *(const GAS f32x4*)(fp + adv + 4); rv = *(const GAS u32x2*)(ip + adv); }
            for (int t = 0; t < 32; ++t) {
                const float vt = sv[t * 64 + F.lane]; float op = 0.f;
#pragma unroll
                for (int j4 = 0; j4 < 4; ++j4) { const f32x4 f4 = *(const LAS f32x4*)(sf + t * 128 + 16 * F.wave + 4 * j4), q4 = *(const LAS f32x4*)(sq + t * 128 + 16 * F.wave + 4 * j4);
#pragma unroll
                    for (int i = 0; i < 4; ++i) { const float fj = f4[i]; S[4 * j4 + i] = fj * S[4 * j4 + i] + (1.0f - fj) * vt; op += q4[i] * S[4 * j4 + i]; } }
                so[(F.wave * 32 + t) * 64 + F.lane] = op;
            }
            __syncthreads();
#pragma unroll
            for (int r = 0; r < 4; ++r) { const int idx = F.tid + 512 * r, t = idx >> 6, v = idx & 63; float s = 0.f;
#pragma unroll
                for (int w = 0; w < 8; ++w) s += so[(w * 32 + t) * 64 + v];
                O[(row0 + (size_t)ck * 32 + t) * D + h * 128 + half * 64 + v] = s; }
        }
        __syncthreads();
    }
}

__device__ __forceinline__ void sbattn_phase(Frame& F, const bf16* Q, const bf16* K, const bf16* V, bf16* O) {
    LAS unsigned char* myl = F.lds + RING_OFF + F.wave * 16384;
    const int gw = F.vcu * NWAVES + F.wave, NGW = F.G * NWAVES;
    for (int task = gw; task < BATCH * NH_SB * (SEQ / 64); task += NGW) {
        const int qblk = task & 63, bh = task >> 6, b = bh >> 4, h = bh & 15; const size_t rowb = (size_t)b * SEQ; const int t = qblk * 64 + F.lane;
        float q[64], acc[64];
#pragma unroll
        for (int p = 0; p < 8; ++p) { const v4u w = *(const GAS v4u*)(Q + (rowb + t) * D + h * 64 + 8 * p);
            q[8 * p + 0] = bf_lo(w.x); q[8 * p + 1] = bf_hi(w.x); q[8 * p + 2] = bf_lo(w.y); q[8 * p + 3] = bf_hi(w.y); q[8 * p + 4] = bf_lo(w.z); q[8 * p + 5] = bf_hi(w.z); q[8 * p + 6] = bf_lo(w.w); q[8 * p + 7] = bf_hi(w.w); }
#pragma unroll
        for (int d = 0; d < 64; ++d) acc[d] = 0.f;
        float carry = 1.0f;
        for (int kt = qblk; kt >= 0; --kt) {
            asm volatile("s_waitcnt lgkmcnt(0)" ::: "memory");
#pragma unroll
            for (int i = 0; i < 8; ++i) { const int c = i * 64 + F.lane, key = c >> 3, part = c & 7; const size_t go = (rowb + (size_t)kt * 64 + key) * D + h * 64 + part * 8;
                *(LAS v4u*)(myl + c * 16) = *(const GAS v4u*)(K + go); *(LAS v4u*)(myl + 8192 + c * 16) = *(const GAS v4u*)(V + go); }
            asm volatile("s_waitcnt vmcnt(0) lgkmcnt(0)" ::: "memory");
            for (int sl = 63; sl >= 0; --sl) {
                const int s = kt * 64 + sl;
                float z0 = 0.f, z1 = 0.f;
#pragma unroll
                for (int p = 0; p < 8; ++p) { const v4u w = *(const LAS v4u*)(myl + sl * 128 + p * 16);
                    z0 += q[8 * p + 0] * bf_lo(w.x) + q[8 * p + 2] * bf_lo(w.y) + q[8 * p + 4] * bf_lo(w.z) + q[8 * p + 6] * bf_lo(w.w);
                    z1 += q[8 * p + 1] * bf_hi(w.x) + q[8 * p + 3] * bf_hi(w.y) + q[8 * p + 5] * bf_hi(w.z) + q[8 * p + 7] * bf_hi(w.w); }
                const float z = z0 + z1, e = __expf(-fabsf(z)), rr = 1.0f / (1.0f + e);
                const float beta = z >= 0.f ? rr : e * rr, omb = z >= 0.f ? e * rr : rr;
                const bool valid = s < t;
                const float a = valid ? beta * carry : 0.f; carry = valid ? carry * omb : carry;
#pragma unroll
                for (int p = 0; p < 8; ++p) { const v4u w = *(const LAS v4u*)(myl + 8192 + sl * 128 + p * 16);
                    acc[8 * p + 0] += a * bf_lo(w.x); acc[8 * p + 1] += a * bf_hi(w.x); acc[8 * p + 2] += a * bf_lo(w.y); acc[8 * p + 3] += a * bf_hi(w.y);
                    acc[8 * p + 4] += a * bf_lo(w.z); acc[8 * p + 5] += a * bf_hi(w.z); acc[8 * p + 6] += a * bf_lo(w.w); acc[8 * p + 7] += a * bf_hi(w.w); }
            }
            if (__all(carry < 1e-37f)) break;
        }
#pragma unroll
        for (int p = 0; p < 8; ++p) { v4u w; w.x = pk2(acc[8 * p + 0], acc[8 * p + 1]); w.y = pk2(acc[8 * p + 2], acc[8 * p + 3]); w.z = pk2(acc[8 * p + 4], acc[8 * p + 5]); w.w = pk2(acc[8 * p + 6], acc[8 * p + 7]);
            *(GAS v4u*)(O + (rowb + t) * D + h * 64 + 8 * p) = w; }
    }
}

#ifndef SB_SETPRIO
#define SB_SETPRIO 1
#endif
#if SB_SETPRIO
#define SB_PRIO(x) __builtin_amdgcn_s_setprio(x)
#else
#define SB_PRIO(x) do {} while (0)
#endif
#ifndef SB_Q_NT
#define SB_Q_NT 0
#endif
#ifndef SB_O_NT
#define SB_O_NT 0
#endif
#ifndef SB_STOP
#define SB_STOP 1e-9f
#endif
typedef float f32x16 __attribute__((ext_vector_type(16)));
typedef short s16x4v __attribute__((ext_vector_type(4)));
__device__ __forceinline__ void sb_weights(const f32x16& z, float& carry, bool diag, int kb, int t, int hi, bf16x8& p0, bf16x8& p1) {
    float be[16], om[16];
#pragma unroll
    for (int r = 0; r < 16; ++r) {
        const float e = __builtin_amdgcn_exp2f(fminf(-1.4426950408889634f * z[r], 126.0f)); const float rr = __builtin_amdgcn_rcpf(1.0f + e); be[r] = rr; om[r] = e * rr; }
    if (diag) {
#pragma unroll
        for (int r = 0; r < 16; ++r) { const int key = kb + (r & 7) + 8 * hi + 16 * (r >> 3); const bool valid = key < t; be[r] = valid ? be[r] : 0.f; om[r] = valid ? om[r] : 1.f; } }
    float s1 = 1.f, s0 = 1.f;
#pragma unroll
    for (int r = 15; r >= 8; --r) { const float o = om[r]; om[r] = s1; s1 *= o; }
#pragma unroll
    for (int r = 7; r >= 0; --r) { const float o = om[r]; om[r] = s0; s0 *= o; }
    const auto x1 = __builtin_amdgcn_permlane32_swap(__float_as_uint(s1), __float_as_uint(s1), false, false);
    const auto x0 = __builtin_amdgcn_permlane32_swap(__float_as_uint(s0), __float_as_uint(s0), false, false);
    const float P1lo = __uint_as_float(x1[0]), P1hi = __uint_as_float(x1[1]), P0lo = __uint_as_float(x0[0]), P0hi = __uint_as_float(x0[1]);
    const float f1 = hi ? carry : carry * P1hi; const float c2 = carry * P1hi * P1lo; const float f0 = hi ? c2 : c2 * P0hi;
    carry = c2 * P0hi * P0lo;
    unsigned w[8];
#pragma unroll
    for (int i = 0; i < 4; ++i) { w[i] = pk2(be[2 * i] * om[2 * i] * f0, be[2 * i + 1] * om[2 * i + 1] * f0); w[4 + i] = pk2(be[8 + 2 * i] * om[8 + 2 * i] * f1, be[9 + 2 * i] * om[9 + 2 * i] * f1); }
    v4u a; a.x = w[0]; a.y = w[1]; a.z = w[2]; a.w = w[3]; v4u b; b.x = w[4]; b.y = w[5]; b.z = w[6]; b.w = w[7];
    p0 = __builtin_bit_cast(bf16x8, a); p1 = __builtin_bit_cast(bf16x8, b);
}
__device__ __forceinline__ void sbattn2_phase(Frame& F, const bf16* Q, const bf16* K, const bf16* V, bf16* O) {
    const int lane = F.lane, q = lane & 31, hi = lane >> 5;
    LAS unsigned char* vb = F.lds + RING_OFF + F.wave * 8192;
    const int g = lane >> 4, q_ = (lane & 15) >> 2, p_ = lane & 3;
    const int troff = (8 * (g >> 1) + q_) * 128 + (16 * (g & 1) + 4 * p_) * 2;
    const int pi_q = (q & 3) | (((q >> 3) & 1) << 2) | (((q >> 2) & 1) << 3) | (q & 16);
    const unsigned qoff = (unsigned)(q * D + hi * 8);
    const unsigned koff = (unsigned)(pi_q * D + hi * 8), voff = (unsigned)((lane >> 3) * D + (lane & 7) * 8);
    for (int u = blockIdx.x; u < BATCH * NH_SB * 8; u += F.G) {
        const int bh = u >> 3, chunk = u & 7, b = bh >> 4, h = bh & 15; const int q0 = chunk * 512 + F.wave * 64; const size_t rowb = (size_t)b * SEQ;
        const bf16* Qu = Q + (rowb + q0) * D + h * 64; asm volatile("" : "+s"(Qu));
        bf16x8 qa[4], qb[4];
#pragma unroll
        for (int d0 = 0; d0 < 4; ++d0) { if (SB_Q_NT) { qa[d0] = __builtin_nontemporal_load((const GAS bf16x8*)(Qu + (qoff + d0 * 16))); qb[d0] = __builtin_nontemporal_load((const GAS bf16x8*)(Qu + (qoff + 32 * D + d0 * 16))); }
            else { qa[d0] = *(const GAS bf16x8*)(Qu + (qoff + d0 * 16)); qb[d0] = *(const GAS bf16x8*)(Qu + (qoff + 32 * D + d0 * 16)); } }
        f32x16 oa[2], ob[2];
#pragma unroll
        for (int r = 0; r < 16; ++r) { oa[0][r] = 0.f; oa[1][r] = 0.f; ob[0][r] = 0.f; ob[1][r] = 0.f; }
        float ca = 1.f, cb = 1.f; const int jtop = (q0 >> 5) + 1;
        bf16x8 kn[4];
        { const bf16* Ku = K + (rowb + 32 * jtop) * D + h * 64; const bf16* Vu = V + (rowb + 32 * jtop) * D + h * 64; asm volatile("" : "+s"(Ku), "+s"(Vu));
#pragma unroll
          for (int d0 = 0; d0 < 4; ++d0) kn[d0] = *(const GAS bf16x8*)(Ku + (koff + d0 * 16));
#pragma unroll
          for (int i = 0; i < 4; ++i) __builtin_amdgcn_global_load_lds((const GAS unsigned*)(Vu + (voff + i * 8 * D)), (LAS unsigned*)(vb + (jtop & 1) * 4096 + i * 1024), 16, 0, 0); }
        for (int j = jtop; j >= 0; --j) {
            const int kb = 32 * j;
            asm volatile("s_waitcnt vmcnt(0)" ::: "memory");
            const unsigned vaddr = (unsigned)(uintptr_t)(vb + (j & 1) * 4096 + troff);
            bf16x8 pa0, pa1, pb0, pb1;
            { f32x16 sa;
#pragma unroll
              for (int r = 0; r < 16; ++r) sa[r] = 0.f;
              SB_PRIO(1);
#pragma unroll
              for (int d0 = 0; d0 < 4; ++d0) sa = __builtin_amdgcn_mfma_f32_32x32x16_bf16(kn[d0], qa[d0], sa, 0, 0, 0);
              SB_PRIO(0);
              sb_weights(sa, ca, j >= jtop - 1, kb, q0 + q, hi, pa0, pa1); }
            { f32x16 sb;
#pragma unroll
              for (int r = 0; r < 16; ++r) sb[r] = 0.f;
              SB_PRIO(1);
#pragma unroll
              for (int d0 = 0; d0 < 4; ++d0) sb = __builtin_amdgcn_mfma_f32_32x32x16_bf16(kn[d0], qb[d0], sb, 0, 0, 0);
              SB_PRIO(0);
              if (j > 0) { const bf16* Ku = K + (rowb + kb - 32) * D + h * 64; const bf16* Vu = V + (rowb + kb - 32) * D + h * 64; asm volatile("" : "+s"(Ku), "+s"(Vu));
#pragma unroll
                  for (int d0 = 0; d0 < 4; ++d0) kn[d0] = *(const GAS bf16x8*)(Ku + (koff + d0 * 16));
#pragma unroll
                  for (int i = 0; i < 4; ++i) __builtin_amdgcn_global_load_lds((const GAS unsigned*)(Vu + (voff + i * 8 * D)), (LAS unsigned*)(vb + ((j - 1) & 1) * 4096 + i * 1024), 16, 0, 0); }
              sb_weights(sb, cb, j >= jtop, kb, q0 + 32 + q, hi, pb0, pb1); }
            s16x4v vl[2][2], vu[2][2];
#pragma unroll
            for (int dh = 0; dh < 2; ++dh)
#pragma unroll
                for (int m = 0; m < 2; ++m) {
                    asm volatile("ds_read_b64_tr_b16 %0, %1 offset:%c2" : "=&v"(vl[dh][m]) : "v"(vaddr), "i"(m * 2048 + dh * 64) : "memory");
                    asm volatile("ds_read_b64_tr_b16 %0, %1 offset:%c2" : "=&v"(vu[dh][m]) : "v"(vaddr), "i"(m * 2048 + 512 + dh * 64) : "memory"); }
            asm volatile("s_waitcnt lgkmcnt(0)" ::: "memory"); __builtin_amdgcn_sched_barrier(0);
            SB_PRIO(1);
#pragma unroll
            for (int dh = 0; dh < 2; ++dh)
#pragma unroll
                for (int m = 0; m < 2; ++m) {
                    const bf16x8 vf = (bf16x8){vl[dh][m][0], vl[dh][m][1], vl[dh][m][2], vl[dh][m][3], vu[dh][m][0], vu[dh][m][1], vu[dh][m][2], vu[dh][m][3]};
                    oa[dh] = __builtin_amdgcn_mfma_f32_32x32x16_bf16(vf, m ? pa1 : pa0, oa[dh], 0, 0, 0);
                    ob[dh] = __builtin_amdgcn_mfma_f32_32x32x16_bf16(vf, m ? pb1 : pb0, ob[dh], 0, 0, 0); }
            SB_PRIO(0);
            if (__all(ca < SB_STOP && cb < SB_STOP)) break;
        }
        {   LAS unsigned char* ost = F.lds + RING_OFF + 65536 + F.wave * 8192;
#pragma unroll
            for (int dh = 0; dh < 2; ++dh)
#pragma unroll
                for (int r4 = 0; r4 < 4; ++r4) { u32x2 wa, wb; wa.x = pk2(oa[dh][4 * r4], oa[dh][4 * r4 + 1]); wa.y = pk2(oa[dh][4 * r4 + 2], oa[dh][4 * r4 + 3]); wb.x = pk2(ob[dh][4 * r4], ob[dh][4 * r4 + 1]); wb.y = pk2(ob[dh][4 * r4 + 2], ob[dh][4 * r4 + 3]);
                    const int pc = 4 * dh + r4, ra = q, rb_ = q + 32;
                    *(LAS u32x2*)(ost + ra * 128 + 16 * (pc ^ ((ra >> 1) & 7)) + 8 * hi) = wa; *(LAS u32x2*)(ost + rb_ * 128 + 16 * (pc ^ ((rb_ >> 1) & 7)) + 8 * hi) = wb; }
            bf16* Ou = O + (rowb + q0) * D + h * 64; asm volatile("" : "+s"(Ou));
#pragma unroll
            for (int i = 0; i < 8; ++i) { const int r = 8 * i + (lane >> 3), pc = lane & 7; const v4u w = *(const LAS v4u*)(ost + r * 128 + 16 * (pc ^ ((r >> 1) & 7)));
                if (SB_O_NT) __builtin_nontemporal_store(w, (GAS v4u*)(Ou + (unsigned)(r * D + 8 * pc))); else *(GAS v4u*)(Ou + (unsigned)(r * D + 8 * pc)) = w; }
        }
    }
}

__device__ __forceinline__ void hgrn2_phase(Frame& F, const bf16* Q, const float* Fg, const bf16* I, float* O) {
    constexpr int RS = 272, VS = 144;
    LAS unsigned char* L = F.lds + RING_OFF;
    LAS float* TOT = (LAS float*)L;
    LAS float* CUM = (LAS float*)(L + 2048);
    LAS unsigned char* QE = L + 18432; LAS unsigned char* KE = QE + 8704; LAS unsigned char* QD = KE + 8704; LAS unsigned char* KD = QD + 8704;
    LAS unsigned char* VV = L + 53248;
    LAS float* EREF = (LAS float*)(L + 57856); LAS float* EER = EREF + 128; LAS float* EEND = EER + 128;
    LAS float* OP = (LAS float*)(L + 59392);
    const int tid = F.tid, lane = F.lane, w = F.wave, dt = w >> 1, vt = w & 1;
    const int dA = tid & 127, qtr = tid >> 7, tB = tid >> 4, d8 = (tid & 15) * 8, c4 = (tid & 15) * 4;
    const int c = lane & 31, hi = lane >> 5, g = lane >> 4, q_ = (lane & 15) >> 2, p_ = lane & 3;
    const int rowfrag = c * RS + (32 * dt + 8 * hi) * 2, qdfrag = c * RS + (32 * dt + 4 * hi) * 2;
    const int trk = (8 * hi + q_) * RS + (32 * dt + 16 * (g & 1) + 4 * p_) * 2;
    const int trv = (8 * hi + q_) * VS + (32 * vt + 16 * (g & 1) + 4 * p_) * 2, trvp = (4 * hi + q_) * VS + (32 * vt + 16 * (g & 1) + 4 * p_) * 2;
    for (int u = blockIdx.x; u < BATCH * NH_HG * 2; u += F.G) {
        const int b = u >> 4, h = (u >> 1) & 7, half = u & 1; const size_t row0 = (size_t)b * SEQ;
        f32x16 S;
#pragma unroll
        for (int r = 0; r < 16; ++r) S[r] = 0.f;
        const float* fA = Fg + (row0 + 8 * qtr) * D + h * 128 + dA;
        const bf16* qB = Q + (row0 + tB) * D + h * 128 + d8; const float* fB = Fg + (row0 + tB) * D + h * 128 + d8; const bf16* vB = I + (row0 + tB) * D + h * 128 + half * 64 + c4;
        float fa[8];
#pragma unroll
        for (int i = 0; i < 8; ++i) fa[i] = *(const GAS float*)(fA + (size_t)i * D);
        v4u rq = *(const GAS v4u*)qB; f32x4 rf0 = *(const GAS f32x4*)fB, rf1 = *(const GAS f32x4*)(fB + 4); u32x2 rv = *(const GAS u32x2*)vB;
        for (int ck = 0; ck < SEQ / 32; ++ck) {
            float cl[8]; { float run = 0.f;
#pragma unroll
                for (int i = 0; i < 8; ++i) { run += __builtin_amdgcn_logf(fa[i]); cl[i] = run; }
                TOT[qtr * 128 + dA] = run; }
            __syncthreads();
            { const float T0 = TOT[dA], T1 = TOT[128 + dA], T2 = TOT[256 + dA], T3 = TOT[384 + dA];
              const float off = (qtr > 0 ? T0 : 0.f) + (qtr > 1 ? T1 : 0.f) + (qtr > 2 ? T2 : 0.f);
#pragma unroll
              for (int i = 0; i < 8; ++i) CUM[(8 * qtr + i) * 128 + dA] = off + cl[i];
              const float ref = T0 + T1, end = (T0 + T1) + (T2 + T3);
              if (qtr == 0) EREF[dA] = __builtin_amdgcn_exp2f(ref); else if (qtr == 1) EER[dA] = __builtin_amdgcn_exp2f(end - ref); else if (qtr == 2) EEND[dA] = __builtin_amdgcn_exp2f(end); }
            __syncthreads();
            { const f32x4 cu0 = *(const LAS f32x4*)(CUM + tB * 128 + d8), cu1 = *(const LAS f32x4*)(CUM + tB * 128 + d8 + 4);
              const f32x4 r0 = *(const LAS f32x4*)(TOT + d8) + *(const LAS f32x4*)(TOT + 128 + d8), r1 = *(const LAS f32x4*)(TOT + d8 + 4) + *(const LAS f32x4*)(TOT + 128 + d8 + 4);
              const f32x4 er0 = *(const LAS f32x4*)(EREF + d8), er1 = *(const LAS f32x4*)(EREF + d8 + 4), ee0 = *(const LAS f32x4*)(EER + d8), ee1 = *(const LAS f32x4*)(EER + d8 + 4);
              float qv[8] = {bf_lo(rq.x), bf_hi(rq.x), bf_lo(rq.y), bf_hi(rq.y), bf_lo(rq.z), bf_hi(rq.z), bf_lo(rq.w), bf_hi(rq.w)};
              float qe[8], ke[8], qd[8], kd[8];
#pragma unroll
              for (int e = 0; e < 8; ++e) { const float cu = e < 4 ? cu0[e & 3] : cu1[e & 3], rf = e < 4 ? r0[e & 3] : r1[e & 3], fv = e < 4 ? rf0[e & 3] : rf1[e & 3];
                  const float a = __builtin_amdgcn_exp2f(cu - rf), ai = __builtin_amdgcn_rcpf(a), kv = 1.0f - fv;
                  qe[e] = qv[e] * a; ke[e] = kv * ai; qd[e] = qe[e] * (e < 4 ? er0[e & 3] : er1[e & 3]); kd[e] = ke[e] * (e < 4 ? ee0[e & 3] : ee1[e & 3]); }
              v4u o; const int ro = tB * RS + d8 * 2;
              o.x = pk2(qe[0], qe[1]); o.y = pk2(qe[2], qe[3]); o.z = pk2(qe[4], qe[5]); o.w = pk2(qe[6], qe[7]); *(LAS v4u*)(QE + ro) = o;
              o.x = pk2(ke[0], ke[1]); o.y = pk2(ke[2], ke[3]); o.z = pk2(ke[4], ke[5]); o.w = pk2(ke[6], ke[7]); *(LAS v4u*)(KE + ro) = o;
              o.x = pk2(qd[0], qd[1]); o.y = pk2(qd[2], qd[3]); o.z = pk2(qd[4], qd[5]); o.w = pk2(qd[6], qd[7]); *(LAS v4u*)(QD + ro) = o;
              o.x = pk2(kd[0], kd[1]); o.y = pk2(kd[2], kd[3]); o.z = pk2(kd[4], kd[5]); o.w = pk2(kd[6], kd[7]); *(LAS v4u*)(KD + ro) = o;
              *(LAS u32x2*)(VV + tB * VS + c4 * 2) = rv; }
            if (ck + 1 < SEQ / 32) { const size_t adv = (size_t)(ck + 1) * 32 * D;
#pragma unroll
                for (int i = 0; i < 8; ++i) fa[i] = *(const GAS float*)(fA + adv + (size_t)i * D);
                rq = *(const GAS v4u*)(qB + adv); rf0 = *(const GAS f32x4*)(fB + adv); rf1 = *(const GAS f32x4*)(fB + adv + 4); rv = *(const GAS u32x2*)(vB + adv); }
            __syncthreads();
            { f32x16 sc;
#pragma unroll
              for (int r = 0; r < 16; ++r) sc[r] = 0.f;
#pragma unroll
              for (int m = 0; m < 2; ++m) { const bf16x8 ka = *(const LAS bf16x8*)(KE + rowfrag + m * 32), qb = *(const LAS bf16x8*)(QE + rowfrag + m * 32);
                  sc = __builtin_amdgcn_mfma_f32_32x32x16_bf16(ka, qb, sc, 0, 0, 0); }
              unsigned pw[8];
#pragma unroll
              for (int i = 0; i < 8; ++i) { const int r0_ = 2 * i, r1_ = 2 * i + 1; const int s0_ = (r0_ & 3) + 8 * (r0_ >> 2) + 4 * hi, s1_ = (r1_ & 3) + 8 * (r1_ >> 2) + 4 * hi;
                  pw[i] = pk2(s0_ <= c ? sc[r0_] : 0.f, s1_ <= c ? sc[r1_] : 0.f); }
              f32x16 o;
#pragma unroll
              for (int r = 0; r < 16; ++r) o[r] = 0.f;
#pragma unroll
              for (int m = 0; m < 2; ++m) {
                  v4u pa; pa.x = pw[4 * m]; pa.y = pw[4 * m + 1]; pa.z = pw[4 * m + 2]; pa.w = pw[4 * m + 3];
                  const s16x4v v0 = __builtin_bit_cast(s16x4v, __builtin_amdgcn_ds_read_tr16_b64_v4i16((LAS s16x4v*)(VV + trvp + m * 16 * VS)));
                  const s16x4v v1 = __builtin_bit_cast(s16x4v, __builtin_amdgcn_ds_read_tr16_b64_v4i16((LAS s16x4v*)(VV + trvp + m * 16 * VS + 8 * VS)));
                  o = __builtin_amdgcn_mfma_f32_32x32x16_bf16(__builtin_bit_cast(bf16x8, pa), (bf16x8){v0[0], v0[1], v0[2], v0[3], v1[0], v1[1], v1[2], v1[3]}, o, 0, 0, 0); }
#pragma unroll
              for (int m = 0; m < 2; ++m) {
                  const u32x2 qa0 = *(const LAS u32x2*)(QD + qdfrag + m * 32), qa1 = *(const LAS u32x2*)(QD + qdfrag + m * 32 + 16);
                  v4u qa; qa.x = qa0.x; qa.y = qa0.y; qa.z = qa1.x; qa.w = qa1.y;
                  v4u sb; sb.x = pk2(S[8 * m + 0], S[8 * m + 1]); sb.y = pk2(S[8 * m + 2], S[8 * m + 3]); sb.z = pk2(S[8 * m + 4], S[8 * m + 5]); sb.w = pk2(S[8 * m + 6], S[8 * m + 7]);
                  o = __builtin_amdgcn_mfma_f32_32x32x16_bf16(__builtin_bit_cast(bf16x8, qa), __builtin_bit_cast(bf16x8, sb), o, 0, 0, 0); }
#pragma unroll
              for (int a4 = 0; a4 < 4; ++a4) { const f32x4 ev = *(const LAS f32x4*)(EEND + 32 * dt + 8 * a4 + 4 * hi);
                  S[4 * a4 + 0] *= ev[0]; S[4 * a4 + 1] *= ev[1]; S[4 * a4 + 2] *= ev[2]; S[4 * a4 + 3] *= ev[3]; }
#pragma unroll
              for (int m = 0; m < 2; ++m) {
                  const s16x4v k0 = __builtin_bit_cast(s16x4v, __builtin_amdgcn_ds_read_tr16_b64_v4i16((LAS s16x4v*)(KD + trk + m * 16 * RS)));
                  const s16x4v k1 = __builtin_bit_cast(s16x4v, __builtin_amdgcn_ds_read_tr16_b64_v4i16((LAS s16x4v*)(KD + trk + m * 16 * RS + 4 * RS)));
                  const s16x4v v0 = __builtin_bit_cast(s16x4v, __builtin_amdgcn_ds_read_tr16_b64_v4i16((LAS s16x4v*)(VV + trv + m * 16 * VS)));
                  const s16x4v v1 = __builtin_bit_cast(s16x4v, __builtin_amdgcn_ds_read_tr16_b64_v4i16((LAS s16x4v*)(VV + trv + m * 16 * VS + 4 * VS)));
                  S = __builtin_amdgcn_mfma_f32_32x32x16_bf16((bf16x8){k0[0], k0[1], k0[2], k0[3], k1[0], k1[1], k1[2], k1[3]}, (bf16x8){v0[0], v0[1], v0[2], v0[3], v1[0], v1[1], v1[2], v1[3]}, S, 0, 0, 0); }
#pragma unroll
              for (int r = 0; r < 16; ++r) OP[(w * 32 + ((r & 3) + 8 * (r >> 2) + 4 * hi)) * 32 + c] = o[r];
            }
            __syncthreads();
#pragma unroll
            for (int i = 0; i < 4; ++i) { const int idx = tid + 512 * i, t = idx >> 6, v = idx & 63, vt_ = v >> 5, vl = v & 31;
                const float s = (OP[((0 * 2 + vt_) * 32 + t) * 32 + vl] + OP[((1 * 2 + vt_) * 32 + t) * 32 + vl]) + (OP[((2 * 2 + vt_) * 32 + t) * 32 + vl] + OP[((3 * 2 + vt_) * 32 + t) * 32 + vl]);
                O[(row0 + (size_t)ck * 32 + t) * D + h * 128 + half * 64 + v] = s; }
        }
        __syncthreads();
    }
}

#ifndef HG_O_NT
#define HG_O_NT 0
#endif
__device__ __forceinline__ void hgrn4_phase(Frame& F, const bf16* Q, const void* Fgv, const bf16* I, bf16* OPART) {
#if HG_KBF
    const bf16* Fg = (const bf16*)Fgv;
#else
    const float* Fg = (const float*)Fgv;
#endif
    constexpr int RS = 144, VS = 272;
#define HG_BAR() asm volatile("s_waitcnt lgkmcnt(0)\n\ts_barrier" ::: "memory")
    LAS unsigned char* L = F.lds + RING_OFF;
    LAS float* TOT = (LAS float*)L;
    LAS float* CUM = (LAS float*)(L + 2048);
    LAS unsigned char* QE = L + 10240; LAS unsigned char* KE = QE + 4608; LAS unsigned char* QD = KE + 4608; LAS unsigned char* KD = QD + 4608;
    LAS unsigned char* VV = L + 28672;
    LAS float* EREF = (LAS float*)(L + 37376); LAS float* EER = EREF + 64; LAS float* EEND = EER + 64; LAS float* REF = EEND + 64;
    LAS float* OP = (LAS float*)(L + 38400);
    const int tid = F.tid, lane = F.lane, w = F.wave, dt = w >> 2, vt = w & 3;
    const int dA = tid & 63, oct = tid >> 6, tB = tid >> 4, d4 = (tid & 15) * 4, v8 = (tid & 15) * 8;
    const int c = lane & 31, hi = lane >> 5, g = lane >> 4, q_ = (lane & 15) >> 2, p_ = lane & 3;
    const int rowfrag = c * RS + (32 * dt + 8 * hi) * 2, qdfrag = c * RS + (32 * dt + 4 * hi) * 2;
    const int trk = (8 * hi + q_) * RS + (32 * dt + 16 * (g & 1) + 4 * p_) * 2;
    const int trv = (8 * hi + q_) * VS + (32 * vt + 16 * (g & 1) + 4 * p_) * 2, trvp = (4 * hi + q_) * VS + (32 * vt + 16 * (g & 1) + 4 * p_) * 2;
    for (int u = blockIdx.x; u < BATCH * NH_HG * 2; u += F.G) {
        const int b = u >> 4, h = (u >> 1) & 7, dh = u & 1; const size_t row0 = (size_t)b * SEQ;
        f32x16 S;
#pragma unroll
        for (int r = 0; r < 16; ++r) S[r] = 0.f;
        const auto* fA = Fg + (row0 + 4 * oct) * D + h * 128 + 64 * dh + dA;
        const bf16* qB = Q + (row0 + tB) * D + h * 128 + 64 * dh + d4; const auto* fB = Fg + (row0 + tB) * D + h * 128 + 64 * dh + d4; const bf16* vB = I + (row0 + tB) * D + h * 128 + v8;
        bf16* oB = OPART + (size_t)dh * M * D + (row0 + tB) * D + h * 128 + v8;
#if HG_KBF
#define HG_FA_T unsigned short
#define HG_LDFA(p_) (*(const GAS unsigned short*)(p_))
#define HG_F_OF(x_) (1.0f - __uint_as_float((unsigned)(x_) << 16))
#define HG_RF_T u32x2
#define HG_LDFB(p_) (*(const GAS u32x2*)(p_))
#define HG_KV(e_) ((e_) == 0 ? bf_lo(rf.x) : (e_) == 1 ? bf_hi(rf.x) : (e_) == 2 ? bf_lo(rf.y) : bf_hi(rf.y))
#else
#define HG_FA_T float
#define HG_LDFA(p_) __builtin_nontemporal_load((const GAS float*)(p_))
#define HG_F_OF(x_) (x_)
#define HG_RF_T f32x4
#define HG_LDFB(p_) __builtin_nontemporal_load((const GAS f32x4*)(p_))
#define HG_KV(e_) (1.0f - rf[e_])
#endif
        HG_FA_T fa[4];
#pragma unroll
        for (int i = 0; i < 4; ++i) fa[i] = HG_LDFA(fA + (size_t)i * D);
        u32x2 rq = __builtin_nontemporal_load((const GAS u32x2*)qB); HG_RF_T rf = HG_LDFB(fB); v4u rv = __builtin_nontemporal_load((const GAS v4u*)vB);
        for (int ck = 0; ck < SEQ / 32; ++ck) {
            float cl[4]; { float run = 0.f;
#pragma unroll
                for (int i = 0; i < 4; ++i) { run += __builtin_amdgcn_logf(HG_F_OF(fa[i])); cl[i] = run; }
                TOT[oct * 64 + dA] = run; }
            HG_BAR();
            { float T[8];
#pragma unroll
              for (int k = 0; k < 8; ++k) T[k] = TOT[k * 64 + dA];
              float off = 0.f;
#pragma unroll
              for (int k = 0; k < 7; ++k) off += (oct > k) ? T[k] : 0.f;
#pragma unroll
              for (int i = 0; i < 4; ++i) CUM[(4 * oct + i) * 64 + dA] = off + cl[i];
              const float ref = (T[0] + T[1]) + (T[2] + T[3]), end = ref + ((T[4] + T[5]) + (T[6] + T[7]));
              if (oct == 0) EREF[dA] = __builtin_amdgcn_exp2f(ref); else if (oct == 1) EER[dA] = __builtin_amdgcn_exp2f(end - ref); else if (oct == 2) EEND[dA] = __builtin_amdgcn_exp2f(end); else if (oct == 3) REF[dA] = ref; }
            HG_BAR();
            { const f32x4 cu = *(const LAS f32x4*)(CUM + tB * 64 + d4), r4 = *(const LAS f32x4*)(REF + d4), er = *(const LAS f32x4*)(EREF + d4), ee = *(const LAS f32x4*)(EER + d4);
              const float qv[4] = {bf_lo(rq.x), bf_hi(rq.x), bf_lo(rq.y), bf_hi(rq.y)};
              float qe[4], ke[4], qd[4], kd[4];
#pragma unroll
              for (int e = 0; e < 4; ++e) { const float a = __builtin_amdgcn_exp2f(cu[e] - r4[e]), ai = __builtin_amdgcn_rcpf(a), kv = HG_KV(e);
                  qe[e] = qv[e] * a; ke[e] = kv * ai; qd[e] = qe[e] * er[e]; kd[e] = ke[e] * ee[e]; }
              u32x2 o; const int ro = tB * RS + d4 * 2;
              o.x = pk2(qe[0], qe[1]); o.y = pk2(qe[2], qe[3]); *(LAS u32x2*)(QE + ro) = o;
              o.x = pk2(ke[0], ke[1]); o.y = pk2(ke[2], ke[3]); *(LAS u32x2*)(KE + ro) = o;
              o.x = pk2(qd[0], qd[1]); o.y = pk2(qd[2], qd[3]); *(LAS u32x2*)(QD + ro) = o;
              o.x = pk2(kd[0], kd[1]); o.y = pk2(kd[2], kd[3]); *(LAS u32x2*)(KD + ro) = o;
              *(LAS v4u*)(VV + tB * VS + v8 * 2) = rv; }
            if (ck + 1 < SEQ / 32) { const size_t adv = (size_t)(ck + 1) * 32 * D;
#pragma unroll
                for (int i = 0; i < 4; ++i) fa[i] = HG_LDFA(fA + adv + (size_t)i * D);
                rq = __builtin_nontemporal_load((const GAS u32x2*)(qB + adv)); rf = HG_LDFB(fB + adv); rv = __builtin_nontemporal_load((const GAS v4u*)(vB + adv)); }
            HG_BAR();
            { f32x16 sc;
#pragma unroll
              for (int r = 0; r < 16; ++r) sc[r] = 0.f;
#pragma unroll
              for (int m = 0; m < 2; ++m) { const bf16x8 ka = *(const LAS bf16x8*)(KE + rowfrag + m * 32), qb = *(const LAS bf16x8*)(QE + rowfrag + m * 32);
                  sc = __builtin_amdgcn_mfma_f32_32x32x16_bf16(ka, qb, sc, 0, 0, 0); }
              unsigned pw[8];
#pragma unroll
              for (int i = 0; i < 8; ++i) { const int r0_ = 2 * i, r1_ = 2 * i + 1; const int s0_ = (r0_ & 3) + 8 * (r0_ >> 2) + 4 * hi, s1_ = (r1_ & 3) + 8 * (r1_ >> 2) + 4 * hi;
                  pw[i] = pk2(s0_ <= c ? sc[r0_] : 0.f, s1_ <= c ? sc[r1_] : 0.f); }
              f32x16 o;
#pragma unroll
              for (int r = 0; r < 16; ++r) o[r] = 0.f;
#pragma unroll
              for (int m = 0; m < 2; ++m) {
                  v4u pa; pa.x = pw[4 * m]; pa.y = pw[4 * m + 1]; pa.z = pw[4 * m + 2]; pa.w = pw[4 * m + 3];
                  const s16x4v v0 = __builtin_bit_cast(s16x4v, __builtin_amdgcn_ds_read_tr16_b64_v4i16((LAS s16x4v*)(VV + trvp + m * 16 * VS)));
                  const s16x4v v1 = __builtin_bit_cast(s16x4v, __builtin_amdgcn_ds_read_tr16_b64_v4i16((LAS s16x4v*)(VV + trvp + m * 16 * VS + 8 * VS)));
                  o = __builtin_amdgcn_mfma_f32_32x32x16_bf16(__builtin_bit_cast(bf16x8, pa), (bf16x8){v0[0], v0[1], v0[2], v0[3], v1[0], v1[1], v1[2], v1[3]}, o, 0, 0, 0); }
#pragma unroll
              for (int m = 0; m < 2; ++m) {
                  const u32x2 qa0 = *(const LAS u32x2*)(QD + qdfrag + m * 32), qa1 = *(const LAS u32x2*)(QD + qdfrag + m * 32 + 16);
                  v4u qa; qa.x = qa0.x; qa.y = qa0.y; qa.z = qa1.x; qa.w = qa1.y;
                  v4u sb; sb.x = pk2(S[8 * m + 0], S[8 * m + 1]); sb.y = pk2(S[8 * m + 2], S[8 * m + 3]); sb.z = pk2(S[8 * m + 4], S[8 * m + 5]); sb.w = pk2(S[8 * m + 6], S[8 * m + 7]);
                  o = __builtin_amdgcn_mfma_f32_32x32x16_bf16(__builtin_bit_cast(bf16x8, qa), __builtin_bit_cast(bf16x8, sb), o, 0, 0, 0); }
#pragma unroll
              for (int a4 = 0; a4 < 4; ++a4) { const f32x4 ev = *(const LAS f32x4*)(EEND + 32 * dt + 8 * a4 + 4 * hi);
                  S[4 * a4 + 0] *= ev[0]; S[4 * a4 + 1] *= ev[1]; S[4 * a4 + 2] *= ev[2]; S[4 * a4 + 3] *= ev[3]; }
#pragma unroll
              for (int m = 0; m < 2; ++m) {
                  const s16x4v k0 = __builtin_bit_cast(s16x4v, __builtin_amdgcn_ds_read_tr16_b64_v4i16((LAS s16x4v*)(KD + trk + m * 16 * RS)));
                  const s16x4v k1 = __builtin_bit_cast(s16x4v, __builtin_amdgcn_ds_read_tr16_b64_v4i16((LAS s16x4v*)(KD + trk + m * 16 * RS + 4 * RS)));
                  const s16x4v v0 = __builtin_bit_cast(s16x4v, __builtin_amdgcn_ds_read_tr16_b64_v4i16((LAS s16x4v*)(VV + trv + m * 16 * VS)));
                  const s16x4v v1 = __builtin_bit_cast(s16x4v, __builtin_amdgcn_ds_read_tr16_b64_v4i16((LAS s16x4v*)(VV + trv + m * 16 * VS + 4 * VS)));
                  S = __builtin_amdgcn_mfma_f32_32x32x16_bf16((bf16x8){k0[0], k0[1], k0[2], k0[3], k1[0], k1[1], k1[2], k1[3]}, (bf16x8){v0[0], v0[1], v0[2], v0[3], v1[0], v1[1], v1[2], v1[3]}, S, 0, 0, 0); }
#pragma unroll
              for (int r = 0; r < 16; ++r) OP[(w * 32 + ((r & 3) + 8 * (r >> 2) + 4 * hi)) * 32 + c] = o[r];
            }
            HG_BAR();
            { const int vt5 = v8 >> 5, c5 = v8 & 31; const LAS float* p0 = OP + ((0 * 4 + vt5) * 32 + tB) * 32 + c5; const LAS float* p1 = OP + ((1 * 4 + vt5) * 32 + tB) * 32 + c5;
              const f32x4 a0 = *(const LAS f32x4*)p0 + *(const LAS f32x4*)p1, a1 = *(const LAS f32x4*)(p0 + 4) + *(const LAS f32x4*)(p1 + 4);
              v4u ov; ov.x = pk2(a0[0], a0[1]); ov.y = pk2(a0[2], a0[3]); ov.z = pk2(a1[0], a1[1]); ov.w = pk2(a1[2], a1[3]);
              if (HG_O_NT) __builtin_nontemporal_store(ov, (GAS v4u*)(oB + (size_t)ck * 32 * D)); else *(GAS v4u*)(oB + (size_t)ck * 32 * D) = ov; }
        }
        __syncthreads();
    }
#undef HG_BAR
}
__device__ __forceinline__ void hgate2_phase(Frame& F, const bf16* OPART, const bf16* SG, const float* ng, bf16* H) {
    const int gw = F.vcu * NWAVES + F.wave, NGW = F.G * NWAVES;
    const f32x4 g4 = *(const f32x4*)(ng + ((4 * F.lane) & 127));
    for (int m0 = gw; m0 < M; m0 += 2 * NGW) {
        u32x2 o0[2][4], o1[2][4], gv[2][4];
#pragma unroll
        for (int k = 0; k < 2; ++k) { const int m = m0 + k * NGW; if (m < M) {
#pragma unroll
            for (int j = 0; j < 4; ++j) { const int cc = 256 * j + 4 * F.lane; o0[k][j] = __builtin_nontemporal_load((const GAS u32x2*)(OPART + (size_t)m * D + cc)); o1[k][j] = __builtin_nontemporal_load((const GAS u32x2*)(OPART + (size_t)M * D + (size_t)m * D + cc)); gv[k][j] = __builtin_nontemporal_load((const GAS u32x2*)(SG + (size_t)m * D + cc)); } } }
#pragma unroll
        for (int k = 0; k < 2; ++k) { const int m = m0 + k * NGW; if (m < M) {
#pragma unroll
            for (int j = 0; j < 4; ++j) { const int cc = 256 * j + 4 * F.lane; const u32x2 gw2 = gv[k][j];
                f32x4 o; o[0] = bf_lo(o0[k][j].x) + bf_lo(o1[k][j].x); o[1] = bf_hi(o0[k][j].x) + bf_hi(o1[k][j].x); o[2] = bf_lo(o0[k][j].y) + bf_lo(o1[k][j].y); o[3] = bf_hi(o0[k][j].y) + bf_hi(o1[k][j].y);
                float q = (o[0] * o[0] + o[1] * o[1]) + (o[2] * o[2] + o[3] * o[3]);
#pragma unroll
                for (int s2 = 1; s2 < 32; s2 <<= 1) q += shx(q, s2, F.lane);
                const float rs = 1.0f / sqrtf(q * (1.0f / 128.0f) + RMS_EPS);
                f32x4 r; r[0] = o[0] * rs * g4[0] * bf_lo(gw2.x); r[1] = o[1] * rs * g4[1] * bf_hi(gw2.x); r[2] = o[2] * rs * g4[2] * bf_lo(gw2.y); r[3] = o[3] * rs * g4[3] * bf_hi(gw2.y);
                u32x2 wv; wv.x = pk2(r[0], r[1]); wv.y = pk2(r[2], r[3]); if (H_ST_NT) __builtin_nontemporal_store(wv, (GAS u32x2*)(H + (size_t)m * D + cc)); else *(GAS u32x2*)(H + (size_t)m * D + cc) = wv; } } }
    }
}

#ifndef PHMASK
#define PHMASK 0x3ffffff
#endif
#define ON(i) (((PHMASK) >> (i)) & 1)
#ifndef DUPMASK
#define DUPMASK 0
#endif
#define DUP(i) (((DUPMASK) >> (i)) & 1)
#define RUN(i, ...) do { if constexpr (ON(i)) { __VA_ARGS__; if constexpr (DUP(i)) { __syncthreads(); __VA_ARGS__; } } } while (0)
struct Args { const float* in[19]; float* out; unsigned char* ws; int ph_lo, ph_hi, one, pad; };
__global__ void __launch_bounds__(NWAVES * 64, 2) trunk_fwd(Args args) {
    extern __shared__ __attribute__((aligned(16))) unsigned char lds[];
    Frame F;
    F.lds = (LAS unsigned char*)lds;
    F.MISC = (volatile LAS unsigned*)(F.lds + MISC_OFF);
    F.tid = threadIdx.x; F.lane = F.tid & 63; F.wave = __builtin_amdgcn_readfirstlane(F.tid >> 6);
    F.G = gridDim.x; { const int bx = blockIdx.x; F.vcu = (F.G % 8 == 0) ? (bx % 8) * (F.G / 8) + bx / 8 : bx; }
    unsigned char* ws = args.ws;
    F.ctl = (gu32*)(ws + WS_CTL);
    for (int u = F.tid; u < (LDS_BYTES - LDSCTL_OFF) / 4; u += NWAVES * 64) ((LAS unsigned*)(F.lds + LDSCTL_OFF))[u] = 0u;
    __syncthreads();
    const bool one = args.one != 0;
    XcdBarrier bar; bar.bar = (unsigned*)(F.ctl + CW_BAR); bar.x = 0; bar.st = nullptr;
    if (one) bar = xcd_barrier_post((unsigned*)(F.ctl + CW_BAR), F.MISC + 8);
    const int lo = args.ph_lo, hi = args.ph_hi;
#define IN(k) (lo <= (k) && (k) < hi)
#ifndef HGRN
#define HGRN hgrn2_phase
#endif
#ifndef SBATTN
#define SBATTN sbattn2_phase
#endif
#define ENTER() do { int t_ = threadIdx.x; asm volatile("" : "+v"(t_)); F.tid = t_; F.lane = t_ & 63; F.wave = __builtin_amdgcn_readfirstlane(t_ >> 6); asm volatile("" : "+s"(ws)); } while (0)
#define SEAM(k) do { if (IN((k) + 1)) xcd_barrier(bar); } while (0)
#define FUSED_LN_GEMM(KIND, Aptr, Bptr, Kdim, XIN, GATE, GAM, BET, NSC, NSH, BANK, CODE) do { \
        const unsigned poison_ = (__hip_atomic_load((gu32*)(ws + WS_CTL) + CW_TMO, RLX_AGENT) != 0u) ? 1u : 0u; \
        pg8::Gemm g{Aptr, Bptr, M, D, Kdim, 0}; pg8::StaticOrder S0; S0.init(M, D, F.G, (int)blockIdx.x); \
        pg8::PanelStats st{(unsigned*)(ws + WS_XB + (size_t)(BANK) * 2 * MiB), (unsigned*)(ws + WS_CTL) + CW_SEAM + (BANK) * SEAM_BANK, (unsigned*)(ws + WS_CTL) + CW_TMO, 4, LN_EPS, (unsigned)(CODE)}; \
        pg8::EpiLnMod E{XIN, xres, Hb, GATE, GAM, BET, NSC, NSH, st, poison_}; \
        for (int sl = 0; sl < (M / 256) * (D / 256) / 256; ++sl) { pg8::SliceOrder S{S0, sl}; \
            RUN(KIND, pg8::gemm_phase<pg8::EpiLnMod, pg8::SliceOrder, false, PG8_SP2>(F.lds + RING_OFF, g, S, E)); __syncthreads(); } } while (0)
#ifndef CONV_EARLY
#define CONV_EARLY 0
#endif
#define CONV_EARLY_K 15
#ifdef FUSE_LN
#define FUSE_LN_GUARD FUSE_LN
#else
#define FUSE_LN_GUARD 0
#endif
#ifndef SWIGLU_DEFER
#define SWIGLU_DEFER 0
#endif
#ifndef WIDE_ST
#define WIDE_ST 1
#endif
#if WIDE_ST
#define EPI_Y pg8::EpiBf16W
#define EPI_Y_NB
#else
#define EPI_Y pg8::EpiBf16<0>
#define EPI_Y_NB nullptr,
#endif
#ifndef MOE_TAIL
#define MOE_TAIL 0
#endif
static_assert(!(INTER_PAIR && MOE_TAIL) && !(INTER_PAIR && FUSE_LN_GUARD), "the row-pair interleaved FFN hidden layout is wired into the plain W2 GEMM phases only");
#ifndef MOE_GATHER
#define MOE_GATHER 1
#endif
#ifndef QP_ON
#define QP_ON 0
#endif
#ifndef QP_R0_W13
#define QP_R0_W13 6
#endif
#ifndef WGM_N1024
#define WGM_N1024 8
#endif
#ifndef W2_REV
#define W2_REV 0
#endif
#ifndef FUSE_LN
#define FUSE_LN 0
#endif
#ifndef FUSE_SITES
#define FUSE_SITES 7
#endif
    const bool qp = QP_ON && (F.G == 256);
    const bool fuseok = FUSE_LN && (F.G == 256); const bool fuse0 = fuseok && (FUSE_SITES & 1), fuse1 = fuseok && (FUSE_SITES & 2), fuse2 = fuseok && (FUSE_SITES & 4);
    const float* x_in = args.in[0]; const float* c_in = args.in[1]; const float* ada_w = args.in[2]; const float* ada_b = args.in[3];
    const float* ln1_g = args.in[4]; const float* ln1_b = args.in[5]; const float* ln2_g = args.in[6]; const float* ln2_b = args.in[7];
    const float* sb_w_qkv = args.in[8]; const float* sb_w_o = args.in[9]; const float* hg_w_in = args.in[10]; const float* hg_norm_g = args.in[11]; const float* hg_w_o = args.in[12];
    const float* hg_lb = args.in[13]; const float* ffn_w13 = args.in[14]; const float* ffn_w2 = args.in[15]; const float* moe_router = args.in[16]; const float* moe_w13 = args.in[17]; const float* moe_w2 = args.in[18];
    float* xout_final = args.out;
#ifndef XBF16
#define XBF16 0
#endif
#if XBF16
#define xres ((float*)(ws + WS_XBF))
#else
#define xres xout_final
#endif
#define mod ((float*)(ws + WS_MOD))
#define lbv ((float*)(ws + WS_LB))
#define route ((unsigned*)(ws + WS_ROUTE))
#define wbuf (ws + WS_W)
#define wsb (ws + WS_WSB)
#define Hb ((bf16*)(ws + WS_H))
#define Yb ((bf16*)(ws + WS_Y))

    if (IN(0)) { ENTER(); RUN(0, mod_phase(F, c_in, ada_w, ada_b, hg_lb, mod, lbv)); RUN(1, conv_sb(F, sb_w_qkv, sb_w_o, ffn_w13, ffn_w2, wsb)); SEAM(0); }
    if (IN(1)) { ENTER(); RUN(2, modulate_phase(F, x_in, mod, Hb)); SEAM(1); }

    for (int pair = 0; pair < 2; ++pair) {
        const int pb = 2 + 16 * pair, lS = 2 * pair, lH = 2 * pair + 1;
#define modS (mod + (size_t)lS * BATCH * MODW)
#define modH (mod + (size_t)lH * BATCH * MODW)
        if (IN(pb + 0)) { ENTER();
            pg8::Gemm g{Hb, (const bf16*)(wsb + W_SB_QKV), M, 3 * D, D, 0}; pg8::StaticOrder S; S.init(M, 3 * D, F.G, (int)blockIdx.x);
            EPI_Y E{(bf16*)(ws + B_Q), D, EPI_Y_NB D, (size_t)(B_K - B_Q) / 2, 0.125f};
            RUN(3, pg8::gemm_phase<EPI_Y, pg8::StaticOrder, PG8_ALIGN, PG8_SP2>(F.lds + RING_OFF, g, S, E));
            SEAM(pb + 0); }
        if (IN(pb + 1)) { ENTER(); RUN(4, SBATTN(F, (const bf16*)(ws + B_Q), (const bf16*)(ws + B_K), (const bf16*)(ws + B_V), Hb)); SEAM(pb + 1); }
        if (IN(pb + 2)) { ENTER();
            if (fuse0) { FUSED_LN_GEMM(18, Hb, (const bf16*)(wsb + W_SB_O), D, pair == 0 ? x_in : xres, modS + 2 * D, ln1_g + lS * D, ln1_b + lS * D, modS + 4 * D, modS + 3 * D, pair * 3 + 0, 0x710); }
            else {
            pg8::Gemm g{Hb, (const bf16*)(wsb + W_SB_O), M, D, D, 0}; pg8::StaticOrder S; S.init(M, D, F.G, (int)blockIdx.x, 0, WGM_N1024);
            EPI_Y E{Yb, D, EPI_Y_NB 0, 0, 1.f};
            RUN(5, pg8::gemm_phase<EPI_Y, pg8::StaticOrder, PG8_ALIGN, PG8_SP2>(F.lds + RING_OFF, g, S, E)); }
            SEAM(pb + 2); }
        if (IN(pb + 3) && !fuse0) { ENTER();
            if (qp) {
                gu32* rdy = (gu32*)(ws + WS_CTL) + CW_RDY + (pair * 4 + 0) * RDY_BANK;
                if (pair == 0) { RUN(23, ln_phase<false, false, true, false, false, false, true>(F, x_in, xres, Yb, modS + 2 * D, ln1_g + lS * D, ln1_b + lS * D, modS + 4 * D, modS + 3 * D, Hb, nullptr, nullptr, rdy)); }
                else RUN(24, ln_phase<false, false, true, false, false, false, true>(F, xres, xres, Yb, modS + 2 * D, ln1_g + lS * D, ln1_b + lS * D, modS + 4 * D, modS + 3 * D, Hb, nullptr, nullptr, rdy));
            } else {
            if (pair == 0) { RUN(6, ln_phase<false, false, true, false, false, XBF16 != 0>(F, x_in, xres, Yb, modS + 2 * D, ln1_g + lS * D, ln1_b + lS * D, modS + 4 * D, modS + 3 * D, Hb, nullptr, nullptr, nullptr)); }
            else RUN(22, ln_phase<false, false, true, false, XBF16 != 0, XBF16 != 0>(F, xres, xres, Yb, modS + 2 * D, ln1_g + lS * D, ln1_b + lS * D, modS + 4 * D, modS + 3 * D, Hb, nullptr, nullptr, nullptr));
            SEAM(pb + 3); } }
        if (IN(pb + 4)) { ENTER();
            pg8::Gemm g{Hb, (const bf16*)(wsb + W_SB_13), M, 2 * FF, D, 0};
            pg8::EpiSwiGLU E{(bf16*)(ws + B_INTER), FF};
            if (qp) { pg8::TwoSpeedOrder S; S.init(2 * FF, (int)blockIdx.x, QP_R0_W13, (const unsigned*)(ws + WS_CTL) + CW_RDY + (pair * 4 + 0) * RDY_BANK, 128u, (unsigned*)(ws + WS_CTL) + CW_TMO);
                RUN(25, pg8::gemm_phase<pg8::EpiSwiGLU, pg8::TwoSpeedOrder, PG8_ALIGN, PG8_SP2>(F.lds + RING_OFF, g, S, E)); }
            else { pg8::StaticOrder S; S.init(M, 2 * FF, F.G, (int)blockIdx.x);
#if SWIGLU_DEFER
                pg8::EpiSwiGLUD<SWIGLU_DEFER> ED{(bf16*)(ws + B_INTER), FF, (void*)Yb};
                RUN(7, pg8::gemm_phase<pg8::EpiSwiGLUD<SWIGLU_DEFER>, pg8::StaticOrder, PG8_ALIGN, PG8_SP2>(F.lds + RING_OFF, g, S, ED));
#else
                RUN(7, pg8::gemm_phase<pg8::EpiSwiGLU, pg8::StaticOrder, PG8_ALIGN, PG8_SP2>(F.lds + RING_OFF, g, S, E));
#endif
                }
            SEAM(pb + 4); }
        if (IN(pb + 5)) { ENTER();
            if (fuse1) { FUSED_LN_GEMM(19, (const bf16*)(ws + B_INTER), (const bf16*)(wsb + W_SB_2), FF, xres, modS + 5 * D, ln2_g + lS * D, ln2_b + lS * D, modH + 1 * D, modH + 0 * D, pair * 3 + 1, 0x720); }
            else {
            pg8::Gemm g{(const bf16*)(ws + B_INTER), (const bf16*)(wsb + W_SB_2), M, D, FF, 0, 0, INTER_PAIR}; pg8::StaticOrder S; S.init(M, D, F.G, (int)blockIdx.x, W2_REV, WGM_N1024);
            EPI_Y E{Yb, D, EPI_Y_NB 0, 0, 1.f};
            RUN(8, pg8::gemm_phase<EPI_Y, pg8::StaticOrder, PG8_ALIGN, PG8_SP2>(F.lds + RING_OFF, g, S, E)); }
            SEAM(pb + 5); }
        if (IN(pb + 6)) { ENTER();
            if (!fuse1) { RUN(22, ln_phase<false, false, true, false, XBF16 != 0, XBF16 != 0>(F, xres, xres, Yb, modS + 5 * D, ln2_g + lS * D, ln2_b + lS * D, modH + 1 * D, modH + 0 * D, Hb, nullptr, nullptr, nullptr)); }
            { const ConvHg J{hg_w_in + (size_t)pair * D * 4 * D, hg_w_o + (size_t)pair * D * D, moe_w13 + (size_t)pair * NEXP * D * 2 * FF, moe_w2 + (size_t)pair * NEXP * FF * D, wbuf};
              int k0c = 0;
#if CONV_EARLY
              if (pair == 1 && one && F.G == 256) { unsigned c0[8];
#pragma unroll
                  for (int e = 0; e < 8; ++e) c0[e] = (unsigned)__builtin_amdgcn_readfirstlane(__hip_atomic_load((gu32*)(ws + WS_CTL) + CW_CNT + 64 * e, RLX_AGENT));
                  pg8::GroupedOrder S0; S0.init(c0, D, F.G, (int)blockIdx.x); pg8::Unit ut;
                  if ((S0.nwg % F.G) != 0 && !S0.next(S0.nwg / F.G, ut)) k0c = CONV_EARLY_K; }
#endif
              RUN(9, conv_hg_items(F, J, (LAS float*)(F.lds + RING_OFF + F.wave * 16384), k0c, (45568 + F.G * NWAVES - 1) / (F.G * NWAVES))); }
            SEAM(pb + 6); }
#define cnt ((gu32*)(ws + WS_CTL) + CW_CNT + pair * 8 * 64)
        if (IN(pb + 7)) { ENTER();
            pg8::Gemm g{Hb, (const bf16*)(wbuf + W_HG_IN), M, 4 * D, D, 0}; pg8::StaticOrder S; S.init(M, 4 * D, F.G, (int)blockIdx.x);
            static_assert(B_HF - B_HQ == pg8::EpiHgIn::OFF_F && B_HI - B_HQ == pg8::EpiHgIn::OFF_I && B_HGT - B_HQ == pg8::EpiHgIn::OFF_G, "EpiHgIn offsets");
            pg8::EpiHgIn E{ws + B_HQ, lbv + pair * D};
            RUN(10, pg8::gemm_phase<pg8::EpiHgIn, pg8::StaticOrder, PG8_ALIGN, PG8_SP2>(F.lds + RING_OFF, g, S, E));
            SEAM(pb + 7); }
        if (IN(pb + 8)) { ENTER(); RUN(11, hgrn4_phase(F, (const bf16*)(ws + B_HQ), (const void*)(ws + B_HF), (const bf16*)(ws + B_HI), (bf16*)(ws + B_HO))); SEAM(pb + 8); }
        if (IN(pb + 9)) { ENTER(); RUN(12, hgate2_phase(F, (const bf16*)(ws + B_HO), (const bf16*)(ws + B_HGT), hg_norm_g + pair * 128, Hb)); SEAM(pb + 9); }
        if (IN(pb + 10)) { ENTER();
            if (fuse2) { FUSED_LN_GEMM(20, Hb, (const bf16*)(wbuf + W_HG_O), D, xres, modH + 2 * D, ln1_g + lH * D, ln1_b + lH * D, modH + 4 * D, modH + 3 * D, pair * 3 + 2, 0x730); }
            else {
            pg8::Gemm g{Hb, (const bf16*)(wbuf + W_HG_O), M, D, D, 0}; pg8::StaticOrder S; S.init(M, D, F.G, (int)blockIdx.x, 0, WGM_N1024);
            EPI_Y E{Yb, D, EPI_Y_NB 0, 0, 1.f};
            RUN(5, pg8::gemm_phase<EPI_Y, pg8::StaticOrder, PG8_ALIGN, PG8_SP2>(F.lds + RING_OFF, g, S, E)); }
            SEAM(pb + 10); }
        if (IN(pb + 11)) { ENTER();
            if (fuse2) { RUN(21, ln_phase<false, true, true, true>(F, xres, xres, Yb, modH + 2 * D, ln1_g + lH * D, ln1_b + lH * D, modH + 4 * D, modH + 3 * D, Hb, moe_router + (size_t)pair * D * NEXP, route, cnt, MOE_GATHER ? (unsigned*)(ws + WS_XB) : nullptr)); }
            else { RUN(13, ln_phase<false, true, true, false, XBF16 != 0, XBF16 != 0>(F, xres, xres, Yb, modH + 2 * D, ln1_g + lH * D, ln1_b + lH * D, modH + 4 * D, modH + 3 * D, Hb, moe_router + (size_t)pair * D * NEXP, route, cnt, MOE_GATHER ? (unsigned*)(ws + WS_XB) : nullptr)); }
            SEAM(pb + 11); }
#if !MOE_GATHER
        if (IN(pb + 12)) { ENTER(); RUN(14, permute_phase(F, Hb, route, cnt, (bf16*)(ws + B_HS))); SEAM(pb + 12); }
#endif
        if (IN(pb + 13)) { ENTER();
            unsigned cv[8];
#pragma unroll
            for (int e = 0; e < 8; ++e) cv[e] = (unsigned)__builtin_amdgcn_readfirstlane(__hip_atomic_load(cnt + 64 * e, RLX_AGENT));
            pg8::EpiSwiGLU E{(bf16*)(ws + B_MINTER), FF};
#if MOE_GATHER
            pg8::Gemm g{Hb, (const bf16*)(wbuf + W_HG_13), M, 2 * FF, D, (size_t)2 * FF * D * 2}; pg8::GatherOrder S; S.init(cv, 2 * FF, F.G, (int)blockIdx.x); S.tab = (const unsigned*)(ws + WS_XB); S.tab_stride = M;
            RUN(15, pg8::gemm_phase<pg8::EpiSwiGLU, pg8::GatherOrder, PG8_ALIGN, PG8_SP2>(F.lds + RING_OFF, g, S, E));
#else
            pg8::Gemm g{(const bf16*)(ws + B_HS), (const bf16*)(wbuf + W_HG_13), MPAD, 2 * FF, D, (size_t)2 * FF * D * 2}; pg8::GroupedOrder S; S.init(cv, 2 * FF, F.G, (int)blockIdx.x);
            RUN(15, pg8::gemm_phase<pg8::EpiSwiGLU, pg8::GroupedOrder, PG8_ALIGN, PG8_SP2>(F.lds + RING_OFF, g, S, E));
#endif
            SEAM(pb + 13); }
        if (IN(pb + 14)) { ENTER();
            unsigned cv[8];
#pragma unroll
            for (int e = 0; e < 8; ++e) cv[e] = (unsigned)__builtin_amdgcn_readfirstlane(__hip_atomic_load(cnt + 64 * e, RLX_AGENT));
            pg8::Gemm g{(const bf16*)(ws + B_MINTER), (const bf16*)(wbuf + W_HG_2), MPAD, D, FF, (size_t)D * FF * 2, 0, INTER_PAIR && !MOE_TAIL}; pg8::GroupedOrder S; S.init(cv, D, F.G, (int)blockIdx.x);
            EPI_Y E{(bf16*)(ws + B_YS), D, EPI_Y_NB 0, 0, 1.f};
#if MOE_TAIL
            const int t_first = (S.nwg / F.G) * F.G, t_n = S.nwg - t_first;
            const int t_ks = (t_n * 7 <= F.G) ? 7 : (t_n * 4 <= F.G) ? 4 : (t_n * 2 <= F.G) ? 2 : 1;
            const bool t_split = one && t_n > 0 && t_ks > 1;
            if (t_split) S.lim = t_first;
#endif
            RUN(16, pg8::gemm_phase<EPI_Y, pg8::GroupedOrder, PG8_ALIGN, PG8_SP2>(F.lds + RING_OFF, g, S, E));
#if MOE_TAIL
            if (t_split) { __syncthreads();
                pg8::TailOrder T{S, t_first, t_n, t_ks, FF / t_ks, (int)blockIdx.x};
                pg8::Gemm gt{(const bf16*)(ws + B_MINTER), (const bf16*)(wbuf + W_HG_2), MPAD, D, FF / t_ks, (size_t)D * FF * 2, FF};
                pg8::EpiBf16<0> Et{Hb, 256, nullptr, 0, 0, 1.f};
                RUN(16, pg8::gemm_phase<pg8::EpiBf16<0>, pg8::TailOrder, PG8_ALIGN, PG8_SP2>(F.lds + RING_OFF, gt, T, Et));
                xcd_barrier(bar);
                RUN(16, moe_tail_reduce(F, S, t_first, t_n, t_ks, Hb, (bf16*)(ws + B_YS))); }
#endif
#if CONV_EARLY
            if (pair == 0 && one && F.G == 256) { pg8::Unit ut;
                if ((S.nwg % F.G) != 0 && !S.next(S.nwg / F.G, ut)) { __syncthreads();
                    const ConvHg J1{hg_w_in + (size_t)1 * D * 4 * D, hg_w_o + (size_t)1 * D * D, moe_w13 + (size_t)1 * NEXP * D * 2 * FF, moe_w2 + (size_t)1 * NEXP * FF * D, wbuf};
                    RUN(9, conv_hg_items(F, J1, (LAS float*)(F.lds + RING_OFF + F.wave * 16384), 0, CONV_EARLY_K)); } }
#endif
            SEAM(pb + 14); }
        if (IN(pb + 15)) { ENTER();
            if (pair == 0) {
                const float* modN = mod + (size_t)(lH + 1) * BATCH * MODW;
                RUN(17, ln_phase<true, false, true, false, XBF16 != 0, XBF16 != 0>(F, xres, xres, (const bf16*)(ws + B_YS), modH + 5 * D, ln2_g + lH * D, ln2_b + lH * D, modN + 1 * D, modN + 0 * D, Hb, nullptr, route, cnt));
                RUN(1, conv_sb(F, sb_w_qkv + (size_t)D * 3 * D, sb_w_o + (size_t)D * D, ffn_w13 + (size_t)D * 2 * FF, ffn_w2 + (size_t)FF * D, wsb));
                SEAM(pb + 15);
            } else {
                RUN(17, ln_phase<true, false, false, false, XBF16 != 0, false>(F, xres, xout_final, (const bf16*)(ws + B_YS), modH + 5 * D, ln2_g + lH * D, ln2_b + lH * D, nullptr, nullptr, nullptr, nullptr, route, cnt));
            } }
    }
#undef IN
#undef SEAM
#undef FUSED_LN_GEMM
#undef mod
#undef lbv
#undef route
#undef wbuf
#undef xres
#undef wsb
#undef Hb
#undef Yb
#undef modS
#undef modH
#undef cnt
}

extern "C" void kernel_launch(void* const* d_in, const int* in_sizes, int n_in, void* d_out, int out_size, void* d_ws, size_t ws_size, hipStream_t stream) {
    static int grid = 0;
    if (grid == 0) {
        if (n_in != 19 || in_sizes[0] != M * D || out_size != M * D || ws_size < WS_END) { fprintf(stderr, "kernel_launch: unexpected shapes (n_in %d, in0 %d, out %d, ws %zu < %zu)\n", n_in, n_in > 0 ? in_sizes[0] : -1, out_size, ws_size, (size_t)WS_END); grid = -1; return; }
        int dev = 0, cus = 0, per_cu = 0;
        if (hipGetDevice(&dev) != hipSuccess || hipDeviceGetAttribute(&cus, hipDeviceAttributeMultiprocessorCount, dev) != hipSuccess) { grid = -1; return; }
        if (hipFuncSetAttribute((const void*)trunk_fwd, hipFuncAttributeMaxDynamicSharedMemorySize, LDS_BYTES) != hipSuccess) { fprintf(stderr, "kernel_launch: hipFuncSetAttribute failed\n"); grid = -1; return; }
        if (hipOccupancyMaxActiveBlocksPerMultiprocessor(&per_cu, (const void*)trunk_fwd, NWAVES * 64, LDS_BYTES) != hipSuccess || per_cu < 1) fprintf(stderr, "kernel_launch: note: occupancy query reports %d\n", per_cu);
        (void)hipGetLastError();
        grid = cus;
    }
    if (grid < 0) return;
    if (hipMemsetAsync((char*)d_ws + WS_CTL, 0, CTL_ZERO_BYTES, stream) != hipSuccess) return;
    Args a{};
    for (int i = 0; i < 19; ++i) a.in[i] = (const float*)d_in[i];
    a.out = (float*)d_out; a.ws = (unsigned char*)d_ws; a.pad = 0;
#if MK_ONE_LAUNCH
    a.ph_lo = 0; a.ph_hi = N_PHASES; a.one = 1;
    hipLaunchKernelGGL(trunk_fwd, dim3(grid), dim3(NWAVES * 64), LDS_BYTES, stream, a);
#else
    for (int p = 0; p < N_PHASES; ++p) { a.ph_lo = p; a.ph_hi = p + 1; a.one = 0;
        hipLaunchKernelGGL(trunk_fwd, dim3(grid), dim3(NWAVES * 64), LDS_BYTES, stream, a); }
#endif
}
```

```cpp
#include <hip/hip_runtime.h>
#include <cstdio>
#include <cstdint>
#include <cmath>
#define XBF16 1
namespace pg8 {
#define PG8_LAS __attribute__((address_space(3)))
typedef unsigned short bf16_t;
typedef short bf16x8 __attribute__((ext_vector_type(8)));
typedef float f32x4 __attribute__((ext_vector_type(4)));
typedef unsigned u32x4 __attribute__((ext_vector_type(4)));
constexpr int BM = 256, BK = 64, HALF = 128, HTB = HALF * BK * 2  , STAGE_BYTES = 8 * HTB, NXCD = 8, WGM = 4;

__host__ __device__ __forceinline__ int lds_byte(int r, int c) { const int st = (r >> 4) * 2 + (c >> 5), rr = r & 15, cc = c & 31, ob = rr * 64 + cc * 2; return st * 1024 + (ob ^ (((ob >> 9) & 1) << 5)); }
__host__ __device__ __forceinline__ void stage_rc(int b, int& R, int& C) { const int st = b / 1024, sb = b % 1024, swz = sb ^ (((sb >> 9) & 1) << 5); R = (st >> 1) * 16 + swz / 64; C = (st & 1) * 32 + (swz % 64) / 2; }
__host__ __device__ __forceinline__ int perm32(int rho) { const int n = rho >> 4, i = rho & 15; return 8 * (i >> 2) + 4 * n + (i & 3); }

struct Unit { int pm, pn, eb, ga; };
struct Gemm { const bf16_t* A; const bf16_t* Bt; int M, N, K; size_t estride; int ld = 0; int apair = 0; };

struct StaticOrder {
    int nM, nN, nwg, G, c, rev, wgm;
    __host__ __device__ void init(int M, int N, int G_, int c_, int rev_ = 0, int wgm_ = WGM) { nM = M / BM; nN = N / BM; nwg = nM * nN; G = G_; c = c_; rev = rev_; wgm = wgm_; }
    __host__ __device__ bool next(int i, Unit& u) const {
        const long L = (long)i * G + c; if (L >= nwg) return false;
        int wgid = (int)L; { const int q = nwg / NXCD, r = nwg % NXCD, xcd = wgid % NXCD; int off = wgid / NXCD; if (rev && r == 0) off = q - 1 - off; wgid = (xcd < r ? xcd * (q + 1) : r * (q + 1) + (xcd - r) * q) + off; }
        const int nig = wgm * nN, gid = wgid / nig, fm = gid * wgm, gsz = (nM - fm) < wgm ? (nM - fm) : wgm;
        u.pm = fm + ((wgid % nig) % gsz); u.pn = (wgid % nig) / gsz; u.eb = 0; return true;
    }
    __device__ __forceinline__ void a_ready(const Unit&) const {}
    __device__ __forceinline__ void done(const Unit&) const {}
};

typedef float cvt_f32x2 __attribute__((ext_vector_type(2))); typedef __bf16 cvt_bf16x2 __attribute__((ext_vector_type(2)));
__device__ __forceinline__ unsigned cvt_pk_bf16(float lo, float hi) { const cvt_f32x2 v = {lo, hi}; return __builtin_bit_cast(unsigned, __builtin_convertvector(v, cvt_bf16x2)); }
typedef float f32x2 __attribute__((ext_vector_type(2)));
__device__ __forceinline__ f32x2 gelu_pk(f32x2 v) {
    const f32x2 av = __builtin_elementwise_abs(v), d = av * 0.2316418882f + 1.0f;
    f32x2 t; t.x = __builtin_amdgcn_rcpf(d.x); t.y = __builtin_amdgcn_rcpf(d.y);
    f32x2 q = t * 0.5307027145f + (-0.7265760135f); q = q * t + 0.7107068705f; q = q * t + (-0.142248368f); q = q * t + 0.127414796f; q = q * t;
    const f32x2 s = (v * v) * (-0.72134752044f);
    f32x2 e; e.x = __builtin_amdgcn_exp2f(s.x); e.y = __builtin_amdgcn_exp2f(s.y);
    const f32x2 m = v * (q * e), r = v - m;
    f32x2 o; o.x = v.x < 0.f ? m.x : r.x; o.y = v.y < 0.f ? m.y : r.y; return o;
}

#ifndef EPI_NT
#define EPI_NT 0
#endif
#if EPI_NT
#define EPI_STORE16(p, v) __builtin_nontemporal_store((v), (__attribute__((address_space(1))) u32x4*)(p))
#define EPI_STOREF4(p, v) __builtin_nontemporal_store((v), (__attribute__((address_space(1))) f32x4*)(p))
#else
#define EPI_STORE16(p, v) (*(__attribute__((address_space(1))) u32x4*)(p) = (v))
#define EPI_STOREF4(p, v) (*(__attribute__((address_space(1))) f32x4*)(p) = (v))
#endif
template <int ACT  > struct EpiBf16 {
    static constexpr bool PERM = true, AFTER_DRAIN = false; static constexpr int NSTORES = 16; static_assert(ACT == 0 || ACT == 1, "EpiBf16: ACT is 0 (none) or 1 (gelu_pk)");
    bf16_t* O; int ldc; const float* bias; int split_cols; size_t split_stride; float scale0;
    __device__ __forceinline__ void operator()(const f32x4 (&acc)[2][2][4][2], const Unit& u, int wr, int wc, int fr, int fq) const {
        const int row0 = u.pm * BM + wr * 64 + fr; int colt = u.pn * BM; bf16_t* base = O;
        float sc = 1.f; if (split_cols) { const int t = colt / split_cols; base += (size_t)t * split_stride; colt -= t * split_cols; if (t == 0) sc = scale0; }
        const bool scaled = (sc != 1.f);
        const int col0 = colt + wc * 32 + 8 * fq, bcol0 = u.pn * BM + wc * 32 + 8 * fq;
        f32x4 bv[2][2];
#pragma unroll
        for (int bj = 0; bj < 2; ++bj)
#pragma unroll
            for (int n = 0; n < 2; ++n) bv[bj][n] = bias ? *(const f32x4*)(bias + bcol0 + bj * HALF + 4 * n) : (f32x4){0.f, 0.f, 0.f, 0.f};
#pragma unroll
        for (int ai = 0; ai < 2; ++ai)
#pragma unroll
            for (int m = 0; m < 4; ++m) { bf16_t* rowp = base + (size_t)(row0 + ai * HALF + m * 16) * ldc + col0;
#pragma unroll
                for (int bj = 0; bj < 2; ++bj) { f32x4 v0 = acc[ai][bj][m][0], v1 = acc[ai][bj][m][1]; if (bias) { v0 = v0 + bv[bj][0]; v1 = v1 + bv[bj][1]; }
                    if (ACT == 1) { f32x2 a = gelu_pk((f32x2){v0[0], v0[1]}), b = gelu_pk((f32x2){v0[2], v0[3]}), c = gelu_pk((f32x2){v1[0], v1[1]}), d = gelu_pk((f32x2){v1[2], v1[3]});
                        v0 = (f32x4){a.x, a.y, b.x, b.y}; v1 = (f32x4){c.x, c.y, d.x, d.y}; }
                    if (scaled) { v0 = v0 * sc; v1 = v1 * sc; } u32x4 w; w.x = cvt_pk_bf16(v0[0], v0[1]); w.y = cvt_pk_bf16(v0[2], v0[3]); w.z = cvt_pk_bf16(v1[0], v1[1]); w.w = cvt_pk_bf16(v1[2], v1[3]);
                    EPI_STORE16(rowp + bj * HALF, w); } }
    }
};
#ifndef EPI_BIG_NT
#define EPI_BIG_NT 1
#endif
#if EPI_BIG_NT
#define EPI_BIG16(p, v) __builtin_nontemporal_store((v), (__attribute__((address_space(1))) u32x4*)(p))
#define EPI_BIGF4(p, v) __builtin_nontemporal_store((v), (__attribute__((address_space(1))) f32x4*)(p))
#else
#define EPI_BIG16(p, v) EPI_STORE16(p, v)
#define EPI_BIGF4(p, v) EPI_STOREF4(p, v)
#endif
__device__ __forceinline__ float fast_sigmoid(float v) { return __builtin_amdgcn_rcpf(1.0f + __builtin_amdgcn_exp2f(-1.4426950408889634f * v)); }
__device__ __forceinline__ float fast_silu(float v) { return v * fast_sigmoid(v); }
__device__ __forceinline__ unsigned swiglu_pk(f32x2 a, f32x2 b) { const f32x2 t = a * (-1.4426950408889634f); f32x2 e; e.x = __builtin_amdgcn_exp2f(t.x); e.y = __builtin_amdgcn_exp2f(t.y); const f32x2 d = e + 1.0f; f32x2 r; r.x = __builtin_amdgcn_rcpf(d.x); r.y = __builtin_amdgcn_rcpf(d.y); const f32x2 s = (a * r) * b; return cvt_pk_bf16(s.x, s.y); }
#ifndef INTER_PAIR
#define INTER_PAIR 1
#endif
struct EpiSwiGLU {
    static constexpr bool PERM = true, AFTER_DRAIN = false; static constexpr int NSTORES = 8;
    bf16_t* O; int ldc;
    __device__ __forceinline__ void operator()(const f32x4 (&acc)[2][2][4][2], const Unit& u, int wr, int wc, int fr, int fq) const {
        const int row0 = u.pm * BM + wr * 64 + fr, col0 = u.pn * HALF + wc * 32 + 8 * fq;
#pragma unroll
        for (int ai = 0; ai < 2; ++ai)
#pragma unroll
            for (int m = 0; m < 4; ++m) {
#if INTER_PAIR
                const int row_ = row0 + ai * HALF + m * 16; bf16_t* rowp = O + (size_t)(row_ >> 1) * 2 * ldc + (col0 >> 5) * 64 + (row_ & 1) * 32 + (col0 & 31);
#else
                bf16_t* rowp = O + (size_t)(row0 + ai * HALF + m * 16) * ldc + col0;
#endif
                const f32x4 a0 = acc[ai][0][m][0], a1 = acc[ai][0][m][1], b0 = acc[ai][1][m][0], b1 = acc[ai][1][m][1];
                u32x4 w; w.x = swiglu_pk((f32x2){a0[0], a0[1]}, (f32x2){b0[0], b0[1]}); w.y = swiglu_pk((f32x2){a0[2], a0[3]}, (f32x2){b0[2], b0[3]});
                w.z = swiglu_pk((f32x2){a1[0], a1[1]}, (f32x2){b1[0], b1[1]}); w.w = swiglu_pk((f32x2){a1[2], a1[3]}, (f32x2){b1[2], b1[3]});
                EPI_BIG16(rowp, w); }
    }
};
template <int ND> struct EpiSwiGLUD {
    static constexpr bool PERM = true, AFTER_DRAIN = false; static constexpr int NSTORES = 8 - ND, DEFER = ND; static_assert(INTER_PAIR && ND >= 1 && ND <= 8, "");
    bf16_t* O; int ldc; void* dummy;
    __device__ __forceinline__ void pack(const f32x4 (&acc)[2][2][4][2], const Unit& u, int wr, int wc, int fr, int fq, u32x4 (&dq)[ND], char*& dbase, unsigned& dld) const {
        const int row0 = u.pm * BM + wr * 64 + fr, col0 = u.pn * HALF + wc * 32 + 8 * fq;
        bf16_t* p0 = O + (size_t)(row0 >> 1) * 2 * ldc + (col0 >> 5) * 64 + (row0 & 1) * 32 + (col0 & 31);
#pragma unroll
        for (int ai = 0; ai < 2; ++ai)
#pragma unroll
            for (int m = 0; m < 4; ++m) { const f32x4 a0 = acc[ai][0][m][0], a1 = acc[ai][0][m][1], b0 = acc[ai][1][m][0], b1 = acc[ai][1][m][1];
                u32x4 w; w.x = swiglu_pk((f32x2){a0[0], a0[1]}, (f32x2){b0[0], b0[1]}); w.y = swiglu_pk((f32x2){a0[2], a0[3]}, (f32x2){b0[2], b0[3]});
                w.z = swiglu_pk((f32x2){a1[0], a1[1]}, (f32x2){b1[0], b1[1]}); w.w = swiglu_pk((f32x2){a1[2], a1[3]}, (f32x2){b1[2], b1[3]});
                if (ai * 4 + m < 8 - ND) EPI_BIG16(p0 + (size_t)(ai * HALF + m * 16) * ldc, w); else dq[ai * 4 + m - (8 - ND)] = w; }
        dbase = (char*)p0; dld = (unsigned)ldc * 2u;
    }
    __device__ __forceinline__ void operator()(const f32x4 (&)[2][2][4][2], const Unit&, int, int, int, int) const {}
};
__device__ __forceinline__ u32x4 ror8_dpp(u32x4 v) { u32x4 r;
    r.x = (unsigned)__builtin_amdgcn_update_dpp(0, (int)v.x, 0x128, 0xf, 0xf, false); r.y = (unsigned)__builtin_amdgcn_update_dpp(0, (int)v.y, 0x128, 0xf, 0xf, false);
    r.z = (unsigned)__builtin_amdgcn_update_dpp(0, (int)v.z, 0x128, 0xf, 0xf, false); r.w = (unsigned)__builtin_amdgcn_update_dpp(0, (int)v.w, 0x128, 0xf, 0xf, false); return r; }
#define EPI_WIDE_PAIR(rowbase_ptr  , ldc_, w0_, w1_, lo_) do { \
        u32x4 snd_; snd_.x = (lo_) ? (w1_).x : (w0_).x; snd_.y = (lo_) ? (w1_).y : (w0_).y; snd_.z = (lo_) ? (w1_).z : (w0_).z; snd_.w = (lo_) ? (w1_).w : (w0_).w; const u32x4 rcv_ = ror8_dpp(snd_); \
        u32x4 da_, db_; da_.x = (lo_) ? (w0_).x : rcv_.x; da_.y = (lo_) ? (w0_).y : rcv_.y; da_.z = (lo_) ? (w0_).z : rcv_.z; da_.w = (lo_) ? (w0_).w : rcv_.w; \
        db_.x = (lo_) ? rcv_.x : (w1_).x; db_.y = (lo_) ? rcv_.y : (w1_).y; db_.z = (lo_) ? rcv_.z : (w1_).z; db_.w = (lo_) ? rcv_.w : (w1_).w; \
        EPI_BIG16((rowbase_ptr), da_); EPI_BIG16((rowbase_ptr) + (size_t)8 * (ldc_), db_); } while (0)
struct EpiBf16W {
    static constexpr bool PERM = true, AFTER_DRAIN = false, ADJ = true; static constexpr int NSTORES = 16;
    bf16_t* O; int ldc; int split_cols; size_t split_stride; float scale0;
    __device__ __forceinline__ void operator()(const f32x4 (&acc)[2][2][4][2], const Unit& u, int wr, int wc, int fr, int fq) const {
        int colt = u.pn * BM; bf16_t* base = O; float sc = 1.f; if (split_cols) { const int t = colt / split_cols; base += (size_t)t * split_stride; colt -= t * split_cols; if (t == 0) sc = scale0; }
        const bool scaled = (sc != 1.f), lo = fr < 8;
        bf16_t* p0 = base + (size_t)(u.pm * BM + wr * 64 + (fr & 7)) * ldc + colt + wc * 64 + (lo ? 0 : 32) + 8 * fq;
#pragma unroll
        for (int ai = 0; ai < 2; ++ai)
#pragma unroll
            for (int m = 0; m < 4; ++m) { u32x4 w[2];
#pragma unroll
                for (int bj = 0; bj < 2; ++bj) { f32x4 v0 = acc[ai][bj][m][0], v1 = acc[ai][bj][m][1]; if (scaled) { v0 = v0 * sc; v1 = v1 * sc; }
                    w[bj].x = cvt_pk_bf16(v0[0], v0[1]); w[bj].y = cvt_pk_bf16(v0[2], v0[3]); w[bj].z = cvt_pk_bf16(v1[0], v1[1]); w[bj].w = cvt_pk_bf16(v1[2], v1[3]); }
                EPI_WIDE_PAIR(p0 + (size_t)(ai * HALF + m * 16) * ldc, ldc, w[0], w[1], lo); }
    }
};
#ifndef HG_KBF
#define HG_KBF 1
#endif
#ifndef HG_WIDE
#define HG_WIDE 1
#endif
struct EpiHgIn {
    static constexpr bool PERM = true, AFTER_DRAIN = false, ADJ = (HG_KBF != 0) && (HG_WIDE != 0); static constexpr int NSTORES = 16;
    unsigned char* base0; const float* lb;
    static constexpr size_t OFF_F = (size_t)128 << 20, OFF_I = (size_t)384 << 20, OFF_G = (size_t)512 << 20;
    __device__ __forceinline__ void operator()(const f32x4 (&acc)[2][2][4][2], const Unit& u, int wr, int wc, int fr, int fq) const {
        const int sec = u.pn >> 2, row0 = u.pm * BM + wr * 64 + fr, col0 = (u.pn & 3) * BM + wc * 32 + 8 * fq;
        if (sec == 1 && !HG_KBF) {
#pragma unroll
            for (int bj = 0; bj < 2; ++bj)
#pragma unroll
                for (int n = 0; n < 2; ++n) { const f32x4 l = *(const f32x4*)(lb + col0 + bj * HALF + 4 * n);
#pragma unroll
                    for (int ai = 0; ai < 2; ++ai)
#pragma unroll
                        for (int m = 0; m < 4; ++m) { float* rowp = (float*)(base0 + OFF_F) + (size_t)(row0 + ai * HALF + m * 16) * 1024 + col0; const f32x4 v = acc[ai][bj][m][n]; f32x4 o;
#pragma unroll
                            for (int i = 0; i < 4; ++i) o[i] = l[i] + (1.0f - l[i]) * fast_sigmoid(v[i]);
                            EPI_BIGF4(rowp + bj * HALF + 4 * n, o); } }
        } else if (ADJ) {
            bf16_t* base = (bf16_t*)(base0 + (sec == 0 ? (size_t)0 : (sec == 1 ? OFF_F : (sec == 2 ? OFF_I : OFF_G)))); const bool act = (sec == 3), key = (sec == 1), lo = fr < 8;
            const int cw = (u.pn & 3) * BM + wc * 64 + 8 * fq;
            bf16_t* p0 = base + (size_t)(u.pm * BM + wr * 64 + (fr & 7)) * 1024 + (u.pn & 3) * BM + wc * 64 + (lo ? 0 : 32) + 8 * fq;
#pragma unroll
            for (int ai = 0; ai < 2; ++ai)
#pragma unroll
                for (int m = 0; m < 4; ++m) { u32x4 w[2];
#pragma unroll
                    for (int bj = 0; bj < 2; ++bj) { f32x4 v0 = acc[ai][bj][m][0], v1 = acc[ai][bj][m][1];
                        if (key) { const f32x4 l0 = *(const f32x4*)(lb + cw + bj * 32), l1 = *(const f32x4*)(lb + cw + bj * 32 + 4);
#pragma unroll
                            for (int i = 0; i < 4; ++i) { v0[i] = (1.0f - l0[i]) * fast_sigmoid(-v0[i]); v1[i] = (1.0f - l1[i]) * fast_sigmoid(-v1[i]); } }
                        if (act) {
#pragma unroll
                            for (int i = 0; i < 4; ++i) { v0[i] = fast_silu(v0[i]); v1[i] = fast_silu(v1[i]); } }
                        w[bj].x = cvt_pk_bf16(v0[0], v0[1]); w[bj].y = cvt_pk_bf16(v0[2], v0[3]); w[bj].z = cvt_pk_bf16(v1[0], v1[1]); w[bj].w = cvt_pk_bf16(v1[2], v1[3]); }
                    EPI_WIDE_PAIR(p0 + (size_t)(ai * HALF + m * 16) * 1024, 1024, w[0], w[1], lo); }
        } else {
            bf16_t* base = (bf16_t*)(base0 + (sec == 0 ? (size_t)0 : (sec == 1 ? OFF_F : (sec == 2 ? OFF_I : OFF_G)))); const bool act = (sec == 3), key = HG_KBF && (sec == 1);
#pragma unroll
            for (int ai = 0; ai < 2; ++ai)
#pragma unroll
                for (int m = 0; m < 4; ++m) { bf16_t* rowp = base + (size_t)(row0 + ai * HALF + m * 16) * 1024 + col0;
#pragma unroll
                    for (int bj = 0; bj < 2; ++bj) { f32x4 v0 = acc[ai][bj][m][0], v1 = acc[ai][bj][m][1];
                        if (key) { const f32x4 l0 = *(const f32x4*)(lb + col0 + bj * HALF), l1 = *(const f32x4*)(lb + col0 + bj * HALF + 4);
#pragma unroll
                            for (int i = 0; i < 4; ++i) { v0[i] = (1.0f - l0[i]) * fast_sigmoid(-v0[i]); v1[i] = (1.0f - l1[i]) * fast_sigmoid(-v1[i]); } }
                        if (act) {
#pragma unroll
                            for (int i = 0; i < 4; ++i) { v0[i] = fast_silu(v0[i]); v1[i] = fast_silu(v1[i]); } }
                        u32x4 w; w.x = cvt_pk_bf16(v0[0], v0[1]); w.y = cvt_pk_bf16(v0[2], v0[3]); w.z = cvt_pk_bf16(v1[0], v1[1]); w.w = cvt_pk_bf16(v1[2], v1[3]);
                        EPI_BIG16(rowp + bj * HALF, w); } }
        }
    }
};
#ifndef MOE_WGM
#define MOE_WGM 4
#endif
struct GroupedOrder {
    int nM, nN, nwg, G, c, lim; int tb[9];
    __device__ __forceinline__ void init(const unsigned (&cnt)[8], int N, int G_, int c_) {
        int s = 0;
#pragma unroll
        for (int e = 0; e < 8; ++e) { tb[e] = s; s += (int)((cnt[e] + 255u) >> 8); }
        tb[8] = s; nM = s; nN = N / BM; nwg = nM * nN; G = G_; c = c_; lim = nwg; }
    __device__ __forceinline__ bool next(int i, Unit& u) const {
        const long L = (long)i * G + c; if (L >= lim) return false;
        unit_of((int)L, u); return true; }
    __device__ __forceinline__ bool unit_of(int L, Unit& u) const {
        int wgid = L; { const int q = nwg / NXCD, r = nwg % NXCD, xcd = wgid % NXCD, off = wgid / NXCD; wgid = (xcd < r ? xcd * (q + 1) : r * (q + 1) + (xcd - r) * q) + off; }
        const int nig = MOE_WGM * nN, gid = wgid / nig, fm = gid * MOE_WGM, gsz = (nM - fm) < MOE_WGM ? (nM - fm) : MOE_WGM;
        u.pm = fm + ((wgid % nig) % gsz); u.pn = (wgid % nig) / gsz;
        int e = 0;
#pragma unroll
        for (int j = 1; j < 8; ++j) e += (u.pm >= tb[j]) ? 1 : 0;
        u.eb = e; return true;
    }
    __device__ __forceinline__ void a_ready(const Unit&) const {}
    __device__ __forceinline__ void done(const Unit&) const {}
};
struct TailOrder {
    static constexpr bool CUSTOM = true; GroupedOrder S; int first, ntail, KS, kslice, c;
    __device__ __forceinline__ bool next(int i, Unit& u) const {
        if (i != 0 || c >= ntail * KS) return false;
        Unit r; S.unit_of(first + c % ntail, r); u.pm = c; u.pn = 0; u.eb = r.eb; u.ga = r.pm | (r.pn << 20); return true; }
    __device__ __forceinline__ const char* abase(const Gemm& g, const Unit& u) const { return (const char*)g.A + ((size_t)(u.ga & 0xfffff) * BM * g.ld + (size_t)(u.pm / ntail) * kslice) * 2; }
    __device__ __forceinline__ const char* bbase(const Gemm& g, const Unit& u) const { return (const char*)g.Bt + (size_t)u.eb * g.estride + ((size_t)(u.ga >> 20) * BM * g.ld + (size_t)(u.pm / ntail) * kslice) * 2; }
    __device__ __forceinline__ void a_ready(const Unit&) const {}
    __device__ __forceinline__ void done(const Unit&) const {}
};

struct GatherOrder : GroupedOrder {
    static constexpr bool GATHER = true; const unsigned* tab; int tab_stride;
    __device__ __forceinline__ bool next(int i, Unit& u) const {
        if (!GroupedOrder::next(i, u)) return false;
        int first = 0;
#pragma unroll
        for (int j = 1; j < 8; ++j) first = (u.pm >= tb[j]) ? tb[j] : first;
        u.ga = u.eb * tab_stride + (u.pm - first) * BM; return true; }
};

struct TwoSpeedOrder {
    int x, j, nN, upx, R0; const unsigned* ready; unsigned need; unsigned* tmo; mutable int alld;
    __device__ __forceinline__ void init(int N, int c, int R0_, const unsigned* ready_, unsigned need_, unsigned* tmo_) { x = c & 7; j = c >> 3; nN = N / BM; upx = 32 * nN; R0 = R0_; ready = ready_; need = need_; tmo = tmo_; alld = 0; }
    __device__ __forceinline__ bool next(int i, Unit& u) const {
        int idx; if (!(j & 1)) idx = (i < R0) ? 16 * i + (j >> 1) : 16 * R0 + 32 * (i - R0) + j; else idx = 16 * R0 + 32 * i + j;
        if (idx >= upx) return false;
        const int g = idx / (4 * nN), r = idx % (4 * nN); u.pm = 32 * x + 4 * g + (r & 3); u.pn = r >> 2; u.eb = 0; return true;
    }
    __device__ __forceinline__ void a_ready(const Unit& u) const {
        if (alld) return;
        const unsigned* w = ready + 16 * (u.pm >> 2); const unsigned long long t0 = __builtin_amdgcn_s_memrealtime(); unsigned polls = 0;
        while ((unsigned)__builtin_amdgcn_readfirstlane(__hip_atomic_load(w, __ATOMIC_RELAXED, __HIP_MEMORY_SCOPE_AGENT)) < need) {
            if ((++polls & 255u) == 0u && __builtin_amdgcn_readfirstlane(__hip_atomic_load(tmo, __ATOMIC_RELAXED, __HIP_MEMORY_SCOPE_AGENT)) != 0u) break;
            if (__builtin_amdgcn_s_memrealtime() - t0 > 2000000ull) { if ((threadIdx.x & 63) == 0) { unsigned expect = 0u; __hip_atomic_compare_exchange_strong(tmo + 1, &expect, 0x680u | (unsigned)(u.pm & 0xff), __ATOMIC_RELAXED, __ATOMIC_RELAXED, __HIP_MEMORY_SCOPE_AGENT); __hip_atomic_store(tmo, 1u, __ATOMIC_RELAXED, __HIP_MEMORY_SCOPE_AGENT); } break; }
            __builtin_amdgcn_s_sleep(2); }
        if ((unsigned)__builtin_amdgcn_readfirstlane(__hip_atomic_load(ready + 16 * (8 * x + 7), __ATOMIC_RELAXED, __HIP_MEMORY_SCOPE_AGENT)) >= need) alld = 1;
        __builtin_amdgcn_fence(__ATOMIC_ACQUIRE, "agent");
        asm volatile("s_waitcnt vmcnt(0)" ::: "memory");
    }
    __device__ __forceinline__ void done(const Unit&) const {}
};
struct PanelStats {
    unsigned* xbuf;
    unsigned* cnt;
    unsigned* tmo;
    int ntn; float eps;
    unsigned code;
    __device__ __forceinline__ bool run(const f32x4 (&v)[2][2][4][2], const Unit& u, int wr, int wc, int fr, int fq, PG8_LAS unsigned char* lds, int wid, int lane) const {
        typedef float f32x2v __attribute__((ext_vector_type(2)));
        PG8_LAS f32x2v* P = (PG8_LAS f32x2v*)lds;
        PG8_LAS f32x2v* S = (PG8_LAS f32x2v*)(lds + 8192);
        PG8_LAS unsigned* flag = (PG8_LAS unsigned*)(lds + 8192 + 2048);
#pragma unroll
        for (int ai = 0; ai < 2; ++ai)
#pragma unroll
            for (int m = 0; m < 4; ++m) {
                float s = 0.f;
#pragma unroll
                for (int bj = 0; bj < 2; ++bj)
#pragma unroll
                    for (int n = 0; n < 2; ++n) { const f32x4 x = v[ai][bj][m][n]; s += (x[0] + x[1]) + (x[2] + x[3]); }
                s += __shfl_xor(s, 16); s += __shfl_xor(s, 32);
                const float mw = s * (1.0f / 64.0f); float q = 0.f;
#pragma unroll
                for (int bj = 0; bj < 2; ++bj)
#pragma unroll
                    for (int n = 0; n < 2; ++n) { const f32x4 d = v[ai][bj][m][n] - mw; q += (d[0] * d[0] + d[1] * d[1]) + (d[2] * d[2] + d[3] * d[3]); }
                q += __shfl_xor(q, 16); q += __shfl_xor(q, 32);
                if (fq == 0) P[(ai * HALF + wr * 64 + m * 16 + fr) * 4 + wc] = (f32x2v){mw, q};
            }
        asm volatile("s_waitcnt lgkmcnt(0)" ::: "memory"); __builtin_amdgcn_s_barrier(); asm volatile("" ::: "memory");
#if defined(BROKEN_EXCHANGE_NO_WAIT)
#warning BROKEN CONTROL BUILD: the row-statistics exchange does not wait; results are wrong by design
        if (blockIdx.x >= 64) { const long long t0_ = clock64(); while (clock64() - t0_ < 60000) __builtin_amdgcn_s_sleep(8); }
#endif
        const int row = wid * 32 + (lane & 31);
        if (lane < 32) {
            const f32x2v a = P[row * 4 + 0], b = P[row * 4 + 1], c = P[row * 4 + 2], d = P[row * 4 + 3];
            const float mt = (a.x + b.x + c.x + d.x) * 0.25f;
            const float da = a.x - mt, db = b.x - mt, dc = c.x - mt, dd = d.x - mt;
            const float m2 = (a.y + b.y) + (c.y + d.y) + 64.0f * ((da * da + db * db) + (dc * dc + dd * dd));
            unsigned long long* slot = (unsigned long long*)xbuf + ((size_t)(u.pm * BM + row) * 4 + u.pn);
            __hip_atomic_store(slot, ((unsigned long long)__float_as_uint(m2) << 32) | __float_as_uint(mt), __ATOMIC_RELAXED, __HIP_MEMORY_SCOPE_AGENT);
        }
        asm volatile("s_waitcnt vmcnt(0)" ::: "memory");
        if (lane == 0) __hip_atomic_fetch_add(cnt + 64 * u.pm, 1u, __ATOMIC_RELAXED, __HIP_MEMORY_SCOPE_AGENT);
        if (wid == 0) {
            bool dead = false; const unsigned long long t0 = __builtin_amdgcn_s_memrealtime(); const unsigned want = 8u * (unsigned)ntn;
            for (;;) {
#if defined(BROKEN_EXCHANGE_NO_WAIT)
                break;
#endif
                if ((unsigned)__builtin_amdgcn_readfirstlane(__hip_atomic_load(cnt + 64 * u.pm, __ATOMIC_RELAXED, __HIP_MEMORY_SCOPE_AGENT)) >= want) break;
                if (__builtin_amdgcn_s_memrealtime() - t0 > 2000000ull) {
                    if (lane == 0) { unsigned expect = 0u; __hip_atomic_compare_exchange_strong(tmo + 1, &expect, code | (unsigned)(u.pm & 0xff), __ATOMIC_RELAXED, __ATOMIC_RELAXED, __HIP_MEMORY_SCOPE_AGENT);
                                     __hip_atomic_store(tmo, 1u, __ATOMIC_RELAXED, __HIP_MEMORY_SCOPE_AGENT); }
                    dead = true; break; }
                __builtin_amdgcn_s_sleep(2);
            }
            __builtin_amdgcn_fence(__ATOMIC_ACQUIRE, "agent");
            if (lane == 0) flag[0] = dead ? 1u : 0u;
        }
        asm volatile("s_waitcnt vmcnt(0) lgkmcnt(0)" ::: "memory"); __builtin_amdgcn_s_barrier(); asm volatile("" ::: "memory");
        const bool bad = flag[0] != 0u;
        if (lane < 32) {
            const unsigned long long* slot = (const unsigned long long*)xbuf + (size_t)(u.pm * BM + row) * 4; float mt[4], m2[4]; float ms = 0.f;
#pragma unroll
            for (int t = 0; t < 4; ++t) { if (t < ntn) { const unsigned long long w = __hip_atomic_load(slot + t, __ATOMIC_RELAXED, __HIP_MEMORY_SCOPE_AGENT); mt[t] = __uint_as_float((unsigned)w); m2[t] = __uint_as_float((unsigned)(w >> 32)); } else { mt[t] = 0.f; m2[t] = 0.f; } ms += mt[t]; }
            const float mean = ms / (float)ntn; float q = 0.f;
#pragma unroll
            for (int t = 0; t < 4; ++t) if (t < ntn) { const float dm = mt[t] - mean; q += m2[t] + 256.0f * dm * dm; }
            S[row] = (f32x2v){mean, 1.0f / sqrtf(q / (256.0f * (float)ntn) + eps)};
        }
        asm volatile("s_waitcnt lgkmcnt(0)" ::: "memory"); __builtin_amdgcn_s_barrier(); asm volatile("" ::: "memory");
        return bad;
    }
};
struct SliceOrder {
    StaticOrder S; int slice;
    __device__ __forceinline__ bool next(int i, Unit& u) const { return i == 0 ? S.next(slice, u) : false; }
    __device__ __forceinline__ void a_ready(const Unit&) const {}
    __device__ __forceinline__ void done(const Unit&) const {}
};
struct EpiLnMod {
    static constexpr bool PERM = false, AFTER_DRAIN = true; static constexpr int NSTORES = 0;
    const float* xin; float* xout; bf16_t* hout; const float* gate; const float* gam; const float* bet; const float* nsc; const float* nsh; PanelStats st; unsigned poison;
    __device__ __forceinline__ void fused(f32x4 (&acc)[2][2][4][2], const Unit& u, int wr, int wc, int fr, int fq, PG8_LAS unsigned char* lds, int wid, int lane) const {
        typedef float f32x2v __attribute__((ext_vector_type(2))); typedef unsigned u32x2v __attribute__((ext_vector_type(2)));
#define PG8_GAS __attribute__((address_space(1)))
        const PG8_LAS f32x2v* S = (const PG8_LAS f32x2v*)(lds + 8192);
        typedef unsigned u32x4b __attribute__((__vector_size__(16))); typedef unsigned u32x2b __attribute__((__vector_size__(8)));
        const size_t tbase = (size_t)(u.pm * BM) * 1024 + (size_t)(u.pn * BM); const int bofs = ((u.pm * BM) >> 12) * 6144 + u.pn * BM;
        const float* xu = xin + tbase; float* ou = xout + tbase; bf16_t* hu = hout + tbase;
        asm volatile("" : "+s"(xu), "+s"(ou), "+s"(hu));
        const float* gu = gate + bofs; const float* scu = nsc + bofs; const float* shu = nsh + bofs; const float* gmu = gam + u.pn * BM; const float* btu = bet + u.pn * BM;
        const unsigned lo = (unsigned)((wr * 64 + fr) * 1024 + wc * 32 + 4 * fq), lc = (unsigned)(wc * 32 + 4 * fq);
        f32x4 gv[2][2];
#pragma unroll
        for (int bj = 0; bj < 2; ++bj)
#pragma unroll
            for (int n = 0; n < 2; ++n) gv[bj][n] = *(const PG8_GAS f32x4*)(gu + (lc + (unsigned)(bj * HALF + n * 16)));
#pragma unroll
        for (int ai = 0; ai < 2; ++ai)
#pragma unroll
            for (int m = 0; m < 4; m += 2) { f32x4 xv[2][2][2];
#pragma unroll
                for (int mm = 0; mm < 2; ++mm)
#pragma unroll
                    for (int bj = 0; bj < 2; ++bj)
#pragma unroll
                        for (int n = 0; n < 2; ++n) xv[mm][bj][n] = *(const PG8_GAS f32x4*)(xu + (lo + (unsigned)((ai * HALF + (m + mm) * 16) * 1024 + bj * HALF + n * 16)));
#pragma unroll
                for (int mm = 0; mm < 2; ++mm)
#pragma unroll
                    for (int bj = 0; bj < 2; ++bj)
#pragma unroll
                        for (int n = 0; n < 2; ++n) acc[ai][bj][m + mm][n] = xv[mm][bj][n] * 1.6817928305074290861f + gv[bj][n] * acc[ai][bj][m + mm][n];
#pragma unroll
                for (int mm = 0; mm < 2; ++mm) asm volatile("" : "+v"(acc[ai][0][m + mm][0]), "+v"(acc[ai][0][m + mm][1]), "+v"(acc[ai][1][m + mm][0]), "+v"(acc[ai][1][m + mm][1]));
                asm volatile("" ::: "memory"); }
        const bool bad = st.run(acc, u, wr, wc, fr, fq, lds, wid, lane) || poison != 0u;
        const float qnan = __builtin_nanf("");
#pragma unroll
        for (int bj = 0; bj < 2; ++bj)
#pragma unroll
            for (int n = 0; n < 2; ++n) { const unsigned cc = lc + (unsigned)(bj * HALF + n * 16);
                const f32x4 gm = *(const PG8_GAS f32x4*)(gmu + cc), bt = *(const PG8_GAS f32x4*)(btu + cc), sc = *(const PG8_GAS f32x4*)(scu + cc) + 1.0f, sh = *(const PG8_GAS f32x4*)(shu + cc);
#pragma unroll
                for (int ai = 0; ai < 2; ++ai)
#pragma unroll
                    for (int m = 0; m < 4; ++m) { const int r = ai * HALF + wr * 64 + m * 16 + fr; const f32x2v sr = S[r]; const int so = (ai * HALF + m * 16) * 1024 + bj * HALF + n * 16;
                        f32x4 xn = (acc[ai][bj][m][n] - sr.x) * sr.y * gm + bt; if (bad) xn = (f32x4){qnan, qnan, qnan, qnan};
                        *(PG8_GAS f32x4*)(ou + (lo + (unsigned)so)) = xn;
                        const f32x4 hv = xn * sc + sh; u32x2v w; w.x = cvt_pk_bf16(hv[0], hv[1]); w.y = cvt_pk_bf16(hv[2], hv[3]);
                        *(PG8_GAS u32x2v*)(hu + (lo + (unsigned)so)) = w; }
                asm volatile("" ::: "memory"); }
#undef PG8_GAS
    }
};
template <class E, class = void> struct epi_defer { static constexpr int value = 0; };
template <class E> struct epi_defer<E, decltype((void)E::DEFER)> { static constexpr int value = E::DEFER; };
#ifndef W_PAIR
#define W_PAIR 1
#endif
template <class E, class = void> struct epi_adj { static constexpr bool value = false; };
template <class E> struct epi_adj<E, decltype((void)E::ADJ)> { static constexpr bool value = E::ADJ; };
template <class S, class = void> struct sched_custom { static constexpr bool value = false; };
template <class S> struct sched_custom<S, decltype((void)S::CUSTOM)> { static constexpr bool value = S::CUSTOM; };
template <class S, class = void> struct sched_gather { static constexpr bool value = false; };
template <class S> struct sched_gather<S, decltype((void)S::GATHER)> { static constexpr bool value = S::GATHER; };
template <class Epi, class Sched, bool ALIGN_EPI = false, bool SP2 = false>
__device__ __forceinline__ void gemm_phase(PG8_LAS unsigned char* lds, const Gemm g, const Sched& S, const Epi& E) {
    int tid_ = threadIdx.x; asm volatile("" : "+v"(tid_));
    const int tid = tid_, wid = __builtin_amdgcn_readfirstlane(tid >> 6), lane = tid & 63, wr = wid >> 2, wc = wid & 3, fr = lane & 15, fq = lane >> 4;
    const int K = g.K, nt = K / BK, LD = g.ld ? g.ld : g.K;
    constexpr bool CUSTOM = sched_custom<Sched>::value;
    constexpr bool GATHER = sched_gather<Sched>::value; static_assert(!GATHER || SP2, "the gathered A panel is wired into the SP2 loop only");
    unsigned cvA0[2], cvA1[2], sA0[2], sA1[2], gcol[2], grow[2], gni[4];
    unsigned voffA[2], voffB[2];
#pragma unroll
    for (int i = 0; i < 2; ++i) { int R, C; stage_rc(tid * 16 + i * 8192, R, C); const int Rb = epi_adj<Epi>::value ? ((R >> 5) * 64 + perm32(R & 31)) : (Epi::PERM ? ((R & ~31) + perm32(R & 31)) : R);
        voffA[i] = g.apair ? (unsigned)((R >> 1) * 2 * LD + (C >> 5) * 64 + (R & 1) * 32 + (C & 31)) * 2u : (unsigned)(R * LD + C) * 2u; voffB[i] = W_PAIR ? (unsigned)((Rb >> 1) * 2 * LD + (C >> 5) * 64 + (Rb & 1) * 32 + (C & 31)) * 2u : (unsigned)(Rb * LD + C) * 2u; gcol[i] = (unsigned)C * 2u; grow[i] = (unsigned)R; }
    const size_t kstepB = W_PAIR ? (size_t)(BK * 4) : (size_t)(BK * 2);
    const size_t kstepA = g.apair ? (size_t)(BK * 4) : (size_t)(BK * 2);
    const size_t kstep = (size_t)(BK * 2);
    const size_t hstep = (size_t)HALF * LD * 2;
    const size_t hstepB = epi_adj<Epi>::value ? (size_t)32 * LD * 2 : hstep;
    const size_t tstep = 2 * hstep;
    const unsigned ldsw = (unsigned)wid * 1024u;
    const int aoff = lds_byte(wr * 64 + fr, fq * 8), boff = lds_byte(wc * 32 + fr, fq * 8);
#define PG8_SA(b, h) (((b) * 2 + (h)) * HTB)
#define PG8_SB(b, h) ((4 + (b) * 2 + (h)) * HTB)
#define PG8_STAGE(bufoff, gbase, voff) do { _Pragma("unroll") for (int _i = 0; _i < 2; ++_i) \
        __builtin_amdgcn_global_load_lds((const unsigned*)((const char*)(gbase) + (voff)[_i]), (PG8_LAS unsigned*)(lds + (bufoff) + ldsw + _i * 8192), 16, 0, 0); } while (0)
#define PG8_GOFF(idx, i) (((idx) < (unsigned)(g.M - 1) ? (idx) : (unsigned)(g.M - 1)) * (unsigned)(LD * 2) + gcol[i])
#define PG8_GLOAD(uga) do { const __attribute__((address_space(1))) unsigned* tp_ = (const __attribute__((address_space(1))) unsigned*)(S.tab + (uga)); asm volatile("" : "+s"(tp_)); \
        gni[0] = tp_[grow[0]]; gni[1] = tp_[grow[1]]; gni[2] = tp_[grow[0] + 128u]; gni[3] = tp_[grow[1] + 128u]; } while (0)
#define PG8_GLOAD_ASM(uga) do { const unsigned* tp_ = S.tab + (uga); \
        asm volatile("global_load_dword %0, %4, %6\n\tglobal_load_dword %1, %5, %6\n\tglobal_load_dword %2, %4, %6 offset:512\n\tglobal_load_dword %3, %5, %6 offset:512" \
            : "=&v"(gni[0]), "=&v"(gni[1]), "=&v"(gni[2]), "=&v"(gni[3]) : "v"(grow[0] * 4u), "v"(grow[1] * 4u), "s"(tp_) : "memory"); } while (0)
#define PG8_STAGE_A(bufoff, base, half, SEL) do { if constexpr (GATHER) { if constexpr ((SEL) != 0) { if constexpr ((half) != 0) PG8_STAGE(bufoff, base, sA1); else PG8_STAGE(bufoff, base, sA0); } \
            else { if constexpr ((half) != 0) PG8_STAGE(bufoff, base, cvA1); else PG8_STAGE(bufoff, base, cvA0); } } else { PG8_STAGE(bufoff, (base) + (half) * hstep, voffA); } } while (0)
#define PG8_LDA(dst, b, h) do { _Pragma("unroll") for (int m = 0; m < 4; ++m) _Pragma("unroll") for (int k = 0; k < 2; ++k) dst[m][k] = *(const PG8_LAS bf16x8*)(lds + PG8_SA(b, h) + aoff + m * 2048 + k * 1024); } while (0)
#define PG8_LDB(dst, b, h) do { _Pragma("unroll") for (int n = 0; n < 2; ++n) _Pragma("unroll") for (int k = 0; k < 2; ++k) dst[n][k] = *(const PG8_LAS bf16x8*)(lds + PG8_SB(b, h) + boff + n * 2048 + k * 1024); } while (0)
#define PG8_MMA(ai, bj, At, Bt) do { __builtin_amdgcn_s_setprio(1); _Pragma("unroll") for (int m = 0; m < 4; ++m) _Pragma("unroll") for (int n = 0; n < 2; ++n) _Pragma("unroll") for (int k = 0; k < 2; ++k) \
        acc[ai][bj][m][n] = __builtin_amdgcn_mfma_f32_16x16x32_bf16(Bt[n][k], At[m][k], acc[ai][bj][m][n], 0, 0, 0); __builtin_amdgcn_s_setprio(0); } while (0)
#ifndef PG8_RELAX_ASM
#define PG8_RELAX_ASM 1
#endif
#define PG8_WAIT_V(n) asm volatile("s_waitcnt vmcnt(" #n ")" ::: "memory")
#define PG8_WAIT_L(n) asm volatile("s_waitcnt lgkmcnt(" #n ")" ::: "memory")
#if PG8_RELAX_ASM
#define PG8_WAIT_VR() do { if constexpr (Epi::NSTORES == 16) asm volatile("s_cmp_lg_u32 %0, 0\n\ts_cbranch_scc1 1f\n\ts_waitcnt vmcnt(8)\n\ts_branch 2f\n1:\n\ts_waitcnt vmcnt(24)\n2:" :: "s"(relax) : "scc", "memory"); \
        else if constexpr (Epi::NSTORES == 8) asm volatile("s_cmp_lg_u32 %0, 0\n\ts_cbranch_scc1 1f\n\ts_waitcnt vmcnt(8)\n\ts_branch 2f\n1:\n\ts_waitcnt vmcnt(16)\n2:" :: "s"(relax) : "scc", "memory"); \
        else asm volatile("s_waitcnt vmcnt(8)" ::: "memory"); } while (0)
#else
#define PG8_WAIT_VR() PG8_WAIT_V(8)
#endif
#if PG8_RELAX_ASM
#define PG8_WAIT_VG() do { if constexpr (Epi::NSTORES == 8) asm volatile("s_cmp_lg_u32 %0, 0\n\ts_cbranch_scc1 1f\n\ts_waitcnt vmcnt(12)\n\ts_branch 2f\n1:\n\ts_waitcnt vmcnt(20)\n2:" :: "s"(relax) : "scc", "memory"); \
        else asm volatile("s_waitcnt vmcnt(12)" ::: "memory"); } while (0)
#else
#define PG8_WAIT_VG() PG8_WAIT_V(12)
#endif
#define PG8_BAR __builtin_amdgcn_s_barrier()
#define PG8_SCHED __builtin_amdgcn_sched_barrier(0)
    Unit cur, nxt; int ui = 0;
    constexpr int DEFER = epi_defer<Epi>::value;
    u32x4 dq[DEFER > 0 ? DEFER : 1]; char* dbase = nullptr; unsigned dld = 0u;
    if constexpr (DEFER > 0) {
#pragma unroll
        for (int k = 0; k < DEFER; ++k) dq[k] = (u32x4){0u, 0u, 0u, 0u};
        dbase = (char*)E.dummy + ((size_t)blockIdx.x * 512 + (size_t)tid) * 16; }
#define PG8_DOFF(k) ((size_t)((unsigned)((((k) >> 2) * HALF + ((k) & 3) * 16)) * dld))
#define PG8_DMIN(a, b) ((a) < (b) ? (a) : (b))
#define PG8_DSTORE() do { *(__attribute__((address_space(1))) u32x4*)(dbase + PG8_DOFF((8 - DEFER) + PG8_DMIN(t >> 1, DEFER - 1))) = dq[0]; \
        _Pragma("unroll") for (int k = 0; k + 1 < DEFER; ++k) dq[k] = dq[k + 1]; } while (0)
#if defined(PG8_STAGGER_TICKS) && PG8_STAGGER_TICKS > 0
    {
        const unsigned long long t0_ = __builtin_amdgcn_s_memrealtime(); const unsigned long long dt_ = (unsigned long long)((blockIdx.x >> 3) & 7u) * (unsigned long long)(PG8_STAGGER_TICKS);
        while (__builtin_amdgcn_s_memrealtime() - t0_ < dt_) __builtin_amdgcn_s_sleep(4); }
#endif
#ifdef PROBE_KK
#define PG8_NEXT(i, u) S.next((i) >> 1, (u))
#else
#define PG8_NEXT(i, u) S.next((i), (u))
#endif
    if (!PG8_NEXT(0, cur)) return;
    f32x4 acc[2][2][4][2];
#pragma unroll
    for (int a = 0; a < 2; ++a)
#pragma unroll
        for (int b = 0; b < 2; ++b)
#pragma unroll
            for (int m = 0; m < 4; ++m)
#pragma unroll
                for (int n = 0; n < 2; ++n) acc[a][b][m][n] = (f32x4){0.f, 0.f, 0.f, 0.f};
    bf16x8 At[4][2], B0[2][2], B1[2][2];
    const char* cA; const char* cB;
    if constexpr (CUSTOM) { cA = S.abase(g, cur); cB = S.bbase(g, cur); }
    else { cA = (const char*)g.A + (GATHER ? (size_t)0 : (size_t)cur.pm * tstep); cB = (const char*)g.Bt + (size_t)cur.eb * g.estride + (size_t)cur.pn * tstep; }
    S.a_ready(cur);
    if constexpr (GATHER) { PG8_GLOAD(cur.ga);
#pragma unroll
        for (int i = 0; i < 2; ++i) { cvA0[i] = PG8_GOFF(gni[i], i); cvA1[i] = PG8_GOFF(gni[2 + i], i); sA0[i] = cvA0[i]; sA1[i] = cvA1[i]; } }
    if constexpr (SP2) {
        PG8_STAGE(PG8_SB(0, 0), cB, voffB); PG8_STAGE(PG8_SB(0, 1), cB + hstepB, voffB); PG8_STAGE_A(PG8_SA(0, 0), cA, 0, 0); PG8_STAGE_A(PG8_SA(0, 1), cA, 1, 0);
        if (wr == 1) PG8_BAR;
        PG8_WAIT_V(2); PG8_BAR;
        PG8_STAGE(PG8_SB(1, 0), cB + kstepB, voffB); PG8_STAGE_A(PG8_SA(1, 0), cA + kstepA, 0, 0); PG8_STAGE(PG8_SB(1, 1), cB + hstepB + kstepB, voffB);
        PG8_WAIT_V(6); PG8_BAR;
    } else {
        PG8_STAGE(PG8_SB(0, 0), cB, voffB); PG8_STAGE(PG8_SA(0, 0), cA, voffA); PG8_STAGE(PG8_SB(0, 1), cB + hstepB, voffB); PG8_STAGE(PG8_SA(0, 1), cA + hstep, voffA);
        if (wr == 1) PG8_BAR;
        PG8_WAIT_V(4); PG8_BAR;
        PG8_STAGE(PG8_SB(1, 0), cB + kstepB, voffB); PG8_STAGE(PG8_SA(1, 0), cA + kstepA, voffA); PG8_STAGE(PG8_SB(1, 1), cB + hstepB + kstepB, voffB);
        PG8_WAIT_V(6); PG8_BAR;
    }
    for (;;) {
        const bool has_next = PG8_NEXT(ui + 1, nxt);
        const int gan = has_next ? nxt.ga : cur.ga;
        const char* nA; const char* nB;
        if constexpr (CUSTOM) { nA = has_next ? S.abase(g, nxt) : cA; nB = has_next ? S.bbase(g, nxt) : cB; }
        else { nA = (has_next && !GATHER) ? (const char*)g.A + (size_t)nxt.pm * tstep : cA; nB = has_next ? (const char*)g.Bt + (size_t)nxt.eb * g.estride + (size_t)nxt.pn * tstep : cB; }
        for (int t = 0; t < nt; t += 2) {
            const bool last = (t == nt - 2);
#ifndef PG8_RELAX
#define PG8_RELAX 1
#endif
            const int relax = __builtin_amdgcn_readfirstlane((PG8_RELAX && SP2 && Epi::NSTORES > 0 && t == 0 && ui > 0) ? 1 : 0);
            const char* a1 = cA + (size_t)(t + 1) * kstepA;
            const char* a2 = last ? nA : cA + (size_t)(t + 2) * kstepA; const char* b2 = last ? nB : cB + (size_t)(t + 2) * kstepB;
            const char* a3 = a2 + kstepA; const char* b3 = b2 + kstepB;
            if (last && has_next) S.a_ready(nxt);
            if constexpr (GATHER) { const unsigned lm = last ? ~0u : 0u;
#pragma unroll
                for (int i = 0; i < 2; ++i) { const unsigned n0 = PG8_GOFF(gni[i], i), n1 = PG8_GOFF(gni[2 + i], i); sA0[i] = cvA0[i] ^ ((cvA0[i] ^ n0) & lm); sA1[i] = cvA1[i] ^ ((cvA1[i] ^ n1) & lm); } }
            if constexpr (SP2) {
            PG8_LDB(B0, 0, 0); PG8_LDB(B1, 0, 1); PG8_SCHED; PG8_LDA(At, 0, 0); PG8_STAGE_A(PG8_SA(1, 1), a1, 1, 0);
            if constexpr (GATHER && DEFER > 0) { PG8_GLOAD_ASM(gan); PG8_DSTORE(); PG8_WAIT_V(13); }
            else if constexpr (GATHER) { PG8_GLOAD_ASM(gan); PG8_WAIT_VG(); }
            else if constexpr (DEFER > 0) { PG8_DSTORE(); PG8_WAIT_V(9); }
            else { PG8_WAIT_VR(); }
            PG8_WAIT_L(0); PG8_BAR; PG8_MMA(0, 0, At, B0); PG8_MMA(0, 1, At, B1); PG8_BAR; PG8_SCHED;
            PG8_LDA(At, 0, 1); PG8_STAGE(PG8_SB(0, 0), b2, voffB); PG8_STAGE(PG8_SB(0, 1), b2 + hstepB, voffB); PG8_STAGE_A(PG8_SA(0, 0), a2, 0, 1);
            if constexpr (GATHER && DEFER > 0) { PG8_WAIT_V(13); } else if constexpr (GATHER) { PG8_WAIT_VG(); } else if constexpr (DEFER > 0) { PG8_WAIT_V(9); } else { PG8_WAIT_VR(); }
            PG8_WAIT_L(0); PG8_BAR; PG8_MMA(1, 0, At, B0); PG8_MMA(1, 1, At, B1); PG8_BAR; PG8_SCHED;
            PG8_LDB(B0, 1, 0); PG8_LDB(B1, 1, 1); PG8_SCHED; PG8_LDA(At, 1, 0); PG8_STAGE_A(PG8_SA(0, 1), a2, 1, 1);
            PG8_WAIT_V(8); PG8_WAIT_L(0); PG8_BAR; PG8_MMA(0, 0, At, B0); PG8_MMA(0, 1, At, B1); PG8_BAR; PG8_SCHED;
            PG8_LDA(At, 1, 1); PG8_STAGE(PG8_SB(1, 0), b3, voffB); PG8_STAGE(PG8_SB(1, 1), b3 + hstepB, voffB); PG8_STAGE_A(PG8_SA(1, 0), a3, 0, 1);
            PG8_WAIT_V(8); PG8_WAIT_L(0); PG8_BAR; PG8_MMA(1, 0, At, B0); PG8_MMA(1, 1, At, B1); PG8_BAR; PG8_SCHED;
            } else {
            PG8_LDB(B0, 0, 0); PG8_SCHED; PG8_LDA(At, 0, 0); PG8_STAGE(PG8_SA(1, 1), a1 + hstep, voffA);
            PG8_WAIT_L(8); PG8_BAR; PG8_WAIT_L(0); PG8_MMA(0, 0, At, B0); PG8_BAR; PG8_SCHED;
            PG8_LDB(B1, 0, 1); PG8_STAGE(PG8_SB(0, 0), b2, voffB);
            PG8_BAR; PG8_WAIT_L(0); PG8_MMA(0, 1, At, B1); PG8_BAR;
            PG8_LDA(At, 0, 1); PG8_STAGE(PG8_SA(0, 0), a2, voffA);
            PG8_BAR; PG8_WAIT_L(0); PG8_MMA(1, 0, At, B0); PG8_BAR; PG8_SCHED;
            PG8_STAGE(PG8_SB(0, 1), b2 + hstepB, voffB);
            PG8_WAIT_V(6); PG8_BAR; PG8_MMA(1, 1, At, B1); PG8_BAR;
            PG8_LDB(B0, 1, 0); PG8_SCHED; PG8_LDA(At, 1, 0); PG8_STAGE(PG8_SA(0, 1), a2 + hstep, voffA);
            PG8_WAIT_L(8); PG8_BAR; PG8_WAIT_L(0); PG8_MMA(0, 0, At, B0); PG8_BAR; PG8_SCHED;
            PG8_LDB(B1, 1, 1); PG8_STAGE(PG8_SB(1, 0), b3, voffB);
            PG8_BAR; PG8_WAIT_L(0); PG8_MMA(0, 1, At, B1); PG8_BAR;
            PG8_LDA(At, 1, 1); PG8_STAGE(PG8_SA(1, 0), a3, voffA);
            PG8_BAR; PG8_WAIT_L(0); PG8_MMA(1, 0, At, B0); PG8_BAR; PG8_SCHED;
            PG8_STAGE(PG8_SB(1, 1), b3 + hstepB, voffB);
            PG8_WAIT_V(6); PG8_BAR; PG8_MMA(1, 1, At, B1); PG8_BAR;
            }
        }
        if constexpr (ALIGN_EPI) { if (wr == 0) PG8_BAR; }
#ifdef PROBE_KK
        if (ui & 1)
#endif
        if constexpr (!Epi::AFTER_DRAIN) { if constexpr (DEFER > 0) E.pack(acc, cur, wr, wc, fr, fq, dq, dbase, dld); else E(acc, cur, wr, wc, fr, fq);
#ifdef PROBE_EPI2
            asm volatile("" ::: "memory"); E(acc, cur, wr, wc, fr, fq);
#endif
            S.done(cur); }
        if (!has_next) break;
#pragma unroll
        for (int a = 0; a < 2; ++a)
#pragma unroll
            for (int b = 0; b < 2; ++b)
#pragma unroll
                for (int m = 0; m < 4; ++m)
#pragma unroll
                    for (int n = 0; n < 2; ++n) acc[a][b][m][n] = (f32x4){0.f, 0.f, 0.f, 0.f};
        cur = nxt; cA = nA; cB = nB; ++ui;
        if constexpr (GATHER) {
#pragma unroll
            for (int i = 0; i < 2; ++i) { cvA0[i] = PG8_GOFF(gni[i], i); cvA1[i] = PG8_GOFF(gni[2 + i], i); } }
        if constexpr (ALIGN_EPI) { if (wr == 1) PG8_BAR; }
    }
    if constexpr (DEFER > 0) {
#pragma unroll
        for (int k = 0; k < DEFER; ++k) *(__attribute__((address_space(1))) u32x4*)(dbase + PG8_DOFF((8 - DEFER) + k)) = dq[k]; }
    PG8_WAIT_V(0);
    if constexpr (!ALIGN_EPI) { if (wr == 0) PG8_BAR; }
    PG8_BAR;
    if constexpr (Epi::AFTER_DRAIN) { E.fused(acc, cur, wr, wc, fr, fq, lds, wid, lane); S.done(cur); }
#undef PG8_NEXT
#undef PG8_DOFF
#undef PG8_DMIN
#undef PG8_DSTORE
#undef PG8_GOFF
#undef PG8_GLOAD
#undef PG8_GLOAD_ASM
#undef PG8_STAGE_A
#undef PG8_SA
#undef PG8_SB
#undef PG8_STAGE
#undef PG8_LDA
#undef PG8_LDB
#undef PG8_MMA
#undef PG8_WAIT_V
#undef PG8_WAIT_L
#undef PG8_WAIT_VR
#undef PG8_WAIT_VG
#undef PG8_BAR
#undef PG8_SCHED
}
}
#ifndef PG8_SP2
#define PG8_SP2 true
#endif
#ifndef PG8_ALIGN
#define PG8_ALIGN true
#endif

constexpr int NWAVES = 8;
constexpr int BATCH = 16, SEQ = 4096, D = 1024, M = BATCH * SEQ, FF = 3584, NEXP = 8, DEPTH = 4, NH_SB = 16, NH_HG = 8;
constexpr int MODW = 6 * D;
constexpr float LN_EPS = 1e-5f, RMS_EPS = 1e-6f, ALPHA = 1.6817928305074290861f;
constexpr int MPAD = 2 * M + NEXP * 256;
#ifndef MK_ONE_LAUNCH
#define MK_ONE_LAUNCH 1
#endif
constexpr int N_PHASES = 2 + 16 * 2;

constexpr size_t MiB = 1u << 20;
constexpr size_t WS_CTL = 0, CTL_ZERO_BYTES = 1 * MiB;
constexpr size_t WS_MOD = 2 * MiB;
constexpr size_t WS_LB = WS_MOD + 1536 * 1024 + 65536;
constexpr size_t WS_ROUTE = 4 * MiB;
constexpr size_t WS_XBF = 1659 * MiB;
constexpr size_t WS_XB = 6 * MiB;
constexpr size_t WS_W = 8 * MiB;
constexpr size_t W_SB_QKV = 0, W_SB_O = 6 * MiB, W_SB_13 = 8 * MiB, W_SB_2 = 22 * MiB;
constexpr size_t W_HG_IN = 0, W_HG_O = 8 * MiB, W_HG_13 = 10 * MiB, W_HG_2 = 122 * MiB;
constexpr size_t WS_WSB = 1630 * MiB;
constexpr size_t WS_H = 192 * MiB;
constexpr size_t WS_Y = 320 * MiB;
constexpr size_t WS_BIG = 448 * MiB;
constexpr size_t B_Q = WS_BIG, B_K = WS_BIG + 128 * MiB, B_V = WS_BIG + 256 * MiB, B_INTER = WS_BIG + 384 * MiB;
constexpr size_t B_HQ = WS_BIG, B_HF = WS_BIG + 128 * MiB, B_HI = WS_BIG + 384 * MiB, B_HGT = WS_BIG + 512 * MiB, B_HO = WS_BIG + 640 * MiB;
constexpr size_t B_HS = WS_BIG, B_MINTER = WS_BIG + 272 * MiB, B_YS = WS_BIG;
constexpr size_t WS_END = B_MINTER + (size_t)MPAD * FF * 2;
static_assert((size_t)MPAD * D * 2 <= 272 * MiB && WS_END <= WS_WSB && WS_WSB + 29 * MiB <= WS_XBF && WS_XBF + 128 * MiB <= 1792 * MiB, "d_ws map");
constexpr int CW_TMO = 0, CW_CODE = 1, CW_BAR = 4096, CW_CNT = 16384, CW_SEAM = 32768, SEAM_BANK = 256 * 64, CW_RDY = 140000, RDY_BANK = 1024;

static_assert((CW_SEAM + 6 * SEAM_BANK) <= CW_RDY && (CW_RDY + 16 * RDY_BANK) * 4 <= (int)CTL_ZERO_BYTES, "CTL words inside the memset region");

constexpr int RING_OFF = 0, RING_BYTES = 131072;
constexpr int LDSCTL_OFF = RING_BYTES, MISC_OFF = LDSCTL_OFF + 320;
constexpr int LDS_BYTES = 147456;
#define GAS __attribute__((address_space(1)))
#define LAS __attribute__((address_space(3)))
typedef unsigned short bf16;
typedef unsigned v4u __attribute__((ext_vector_type(4)));
typedef float f32x4 __attribute__((ext_vector_type(4)));
typedef short bf16x8 __attribute__((ext_vector_type(8)));
typedef GAS unsigned gu32;
typedef GAS unsigned long long gu64;
#define RLX_AGENT __ATOMIC_RELAXED, __HIP_MEMORY_SCOPE_AGENT
#define LDS_WAIT() asm volatile("s_waitcnt lgkmcnt(0)" ::: "memory")
#define VM_WAIT() asm volatile("s_waitcnt vmcnt(0)" ::: "memory")
__device__ __forceinline__ unsigned long long rt() { return __builtin_amdgcn_s_memrealtime(); }
__device__ __forceinline__ unsigned f2bf(float f) { unsigned u = __builtin_bit_cast(unsigned, f); return (u + 0x7fffu + ((u >> 16) & 1u)) >> 16; }
typedef float pk2_f32x2 __attribute__((ext_vector_type(2))); typedef __bf16 pk2_bf16x2 __attribute__((ext_vector_type(2)));
__device__ __forceinline__ unsigned pk2(float lo, float hi) { const pk2_f32x2 v = {lo, hi}; return __builtin_bit_cast(unsigned, __builtin_convertvector(v, pk2_bf16x2)); }

#define XB_TMO      128
#define XB_XCNT(j)  (256  + 64 * (j))
#define XB_XSUB(j)  (1280 + 64 * (j))
#define XB_XGEN(j)  (2304 + 64 * (j))
#define XB_TOP      3328
#define XB_TOPGEN   3392
#define XCD_BAR_WORDS 3456
#define XB_SPIN_CAP (1u << 18)

__device__ __forceinline__ unsigned xb_ld(unsigned* p)              { return __hip_atomic_load(p, __ATOMIC_RELAXED, __HIP_MEMORY_SCOPE_AGENT); }
__device__ __forceinline__ unsigned xb_add(unsigned* p, unsigned v) { return __hip_atomic_fetch_add(p, v, __ATOMIC_RELAXED, __HIP_MEMORY_SCOPE_AGENT); }
__device__ __forceinline__ unsigned xb_xcc_id() { return (unsigned)__builtin_amdgcn_s_getreg((3 << 11) | 20) & 0xFu; }
#define XB_SPIN(cond, bar) do { unsigned _sp = 0; while (cond) { __builtin_amdgcn_s_sleep(1); \
    if ((++_sp & 255u) == 0u) { if (xb_ld(&(bar)[XB_TMO])) break; if (_sp > XB_SPIN_CAP) { atomicAdd(&(bar)[XB_TMO], 1u); break; } } } } while (0)

struct XcdBarrier {
    unsigned* bar; unsigned x;
    volatile LAS unsigned* st;
};

__device__ __forceinline__ XcdBarrier xcd_barrier_post(unsigned* bar, volatile LAS unsigned* st) {
    XcdBarrier b; b.bar = bar; b.x = xb_xcc_id(); b.st = st;
    if (threadIdx.x == 0) (void)xb_add(&bar[XB_XCNT(b.x)], 1u);
    return b;
}
__device__ __forceinline__ void xcd_barrier_complete(unsigned* bar, unsigned x, unsigned& nloc, unsigned& nx) {
    const unsigned G = gridDim.x * gridDim.y * gridDim.z;
    unsigned sum, cnt, mine, sp = 0u;
    for (;;) {
        sum = 0u; cnt = 0u; mine = 0u;
#pragma unroll
        for (unsigned j = 0; j < 16; ++j) { const unsigned c = xb_ld(&bar[XB_XCNT(j)]); sum += c; cnt += (c > 0u) ? 1u : 0u; mine = (j == x) ? c : mine; }
        if (sum == G) break;
        __builtin_amdgcn_s_sleep(1);
        if ((++sp & 255u) == 0u) { if (xb_ld(&bar[XB_TMO])) break; if (sp > XB_SPIN_CAP) { atomicAdd(&bar[XB_TMO], 1u); break; } }
    }
    nloc = mine > 0u ? mine : 1u; nx = cnt > 0u ? cnt : 1u;
}

__device__ __forceinline__ void xcd_barrier(const XcdBarrier& b) {
    asm volatile("s_waitcnt vmcnt(0)" ::: "memory");
    __syncthreads();
    if (threadIdx.x == 0) {
        unsigned* bar = b.bar;
        __builtin_amdgcn_s_waitcnt(0);
        unsigned nloc = b.st[0], nx = b.st[1];
        if (nloc == 0u) { xcd_barrier_complete(bar, b.x, nloc, nx); b.st[0] = nloc; b.st[1] = nx; }
        const unsigned old = xb_add(&bar[XB_XSUB(b.x)], 1u);
        const unsigned gen = old / nloc;
        if (old + 1u == (gen + 1u) * nloc) {
            __builtin_amdgcn_fence(__ATOMIC_RELEASE, "agent");
            asm volatile("s_waitcnt vmcnt(0)" ::: "memory");
            const unsigned og = xb_add(&bar[XB_TOP], 1u);
            const unsigned tg = og / nx;
            if (og + 1u == (tg + 1u) * nx) xb_add(&bar[XB_TOPGEN], 1u);
            else XB_SPIN(xb_ld(&bar[XB_TOPGEN]) == tg, bar);
            __builtin_amdgcn_fence(__ATOMIC_ACQUIRE, "agent");
            xb_add(&bar[XB_XGEN(b.x)], 1u);
            asm volatile("s_waitcnt vmcnt(0)" ::: "memory");
        } else {
            XB_SPIN(xb_ld(&bar[XB_XGEN(b.x)]) == gen, bar);
            __builtin_amdgcn_fence(__ATOMIC_ACQUIRE, "agent");
            asm volatile("s_waitcnt vmcnt(0)" ::: "memory");
        }
    }
    __syncthreads();
}

typedef unsigned u32x2 __attribute__((ext_vector_type(2)));
struct Frame {
    LAS unsigned char* lds;
    volatile LAS unsigned* MISC;
    gu32* ctl;
    int tid, lane, wave, vcu, G;
};
__device__ __forceinline__ float shx(float v, int o, int lane) { return __int_as_float(__builtin_amdgcn_ds_bpermute((lane ^ o) << 2, __float_as_int(v))); }
__device__ __forceinline__ float wave_sum(float v, int lane) {
#pragma unroll
    for (int o = 1; o < 64; o <<= 1) v += shx(v, o, lane);
    return v;
}
__device__ __forceinline__ float bf_lo(unsigned w) { return __uint_as_float(w << 16); }
__device__ __forceinline__ float bf_hi(unsigned w) { return __uint_as_float(w & 0xffff0000u); }
__device__ __forceinline__ f32x4 ln_unpack4(u32x2 w) { f32x4 r; r[0] = bf_lo(w.x); r[1] = bf_hi(w.x); r[2] = bf_lo(w.y); r[3] = bf_hi(w.y); return r; }
__device__ __forceinline__ float sigmoid_f(float v) { return 1.0f / (1.0f + __expf(-v)); }

#ifndef CONV_ST_NT
#define CONV_ST_NT 0
#endif
__device__ __forceinline__ void conv_item(const float* W, int K, int N, bf16* WT, int drow0, LAS float* scr, int k0, int n0, int lane) {
    float wv[32];
#pragma unroll
    for (int i = 0; i < 32; ++i) wv[i] = __builtin_nontemporal_load((const GAS float*)(W + (size_t)(k0 + 2 * i + (lane >> 5)) * N + n0 + (lane & 31)));
#pragma unroll
    for (int i = 0; i < 32; ++i) scr[(2 * i + (lane >> 5)) * 33 + (lane & 31)] = wv[i];
    LDS_WAIT(); asm volatile("" ::: "memory");
    const int c = lane & 7;
#pragma unroll
    for (int j = 0; j < 4; ++j) { const int n = (lane >> 3) + 8 * j; const LAS float* s = scr + (8 * c) * 33 + n;
        v4u o; o.x = pk2(s[0 * 33], s[1 * 33]); o.y = pk2(s[2 * 33], s[3 * 33]); o.z = pk2(s[4 * 33], s[5 * 33]); o.w = pk2(s[6 * 33], s[7 * 33]);
        const int row_ = drow0 + n;
#if W_PAIR
        if (CONV_ST_NT) __builtin_nontemporal_store(o, (GAS v4u*)(WT + (size_t)(row_ >> 1) * 2 * K + ((k0 + 8 * c) >> 5) * 64 + (row_ & 1) * 32 + ((8 * c) & 31))); else
        *(GAS v4u*)(WT + (size_t)(row_ >> 1) * 2 * K + ((k0 + 8 * c) >> 5) * 64 + (row_ & 1) * 32 + ((8 * c) & 31)) = o; }
#else
        *(GAS v4u*)(WT + (size_t)row_ * K + k0 + 8 * c) = o; }
#endif
    LDS_WAIT(); asm volatile("" ::: "memory");
}
__device__ __forceinline__ int swiglu_row(int n0) { const int bj = n0 / FF, jj = n0 % FF; return 256 * (jj / 128) + 128 * bj + (jj % 128); }
__device__ __forceinline__ void conv_sb(Frame& F, const float* wqkv, const float* wo, const float* w13, const float* w2, unsigned char* wbuf) {
    LAS float* scr = (LAS float*)(F.lds + RING_OFF + F.wave * 16384);
    const int gw = F.vcu * NWAVES + F.wave, NGW = F.G * NWAVES;
    constexpr int I_QKV = 16 * 96, I_O = 16 * 32, I_13 = 16 * 224, I_2 = 56 * 32, NIT = I_QKV + I_O + I_13 + I_2;
    for (int it = gw; it < NIT; it += NGW) {
        int r = it;
        if (r < I_QKV) { conv_item(wqkv, D, 3 * D, (bf16*)(wbuf + W_SB_QKV), 32 * (r % 96), scr, 64 * (r / 96), 32 * (r % 96), F.lane); continue; } r -= I_QKV;
        if (r < I_O) { conv_item(wo, D, D, (bf16*)(wbuf + W_SB_O), 32 * (r % 32), scr, 64 * (r / 32), 32 * (r % 32), F.lane); continue; } r -= I_O;
        if (r < I_13) { conv_item(w13, D, 2 * FF, (bf16*)(wbuf + W_SB_13), swiglu_row(32 * (r % 224)), scr, 64 * (r / 224), 32 * (r % 224), F.lane); continue; } r -= I_13;
        conv_item(w2, FF, D, (bf16*)(wbuf + W_SB_2), 32 * (r % 32), scr, 64 * (r / 32), 32 * (r % 32), F.lane);
    }
}
struct ConvHg { const float* win; const float* wo; const float* m13; const float* m2; unsigned char* wbuf; };
__device__ __forceinline__ void conv_hg_items(Frame& F, const ConvHg& J, LAS float* scr, int k0, int k1) {
    const int gw = F.vcu * NWAVES + F.wave, NGW = F.G * NWAVES;
    constexpr int I_IN = 16 * 128, I_O = 16 * 32, I_13 = 16 * 224, I_2 = 56 * 32, NIT = I_IN + I_O + NEXP * (I_13 + I_2);
    for (int k = k0; k < k1; ++k) {
        int r = gw + k * NGW; if (r >= NIT) break;
        if (r < I_IN) { conv_item(J.win, D, 4 * D, (bf16*)(J.wbuf + W_HG_IN), 32 * (r % 128), scr, 64 * (r / 128), 32 * (r % 128), F.lane); continue; } r -= I_IN;
        if (r < I_O) { conv_item(J.wo, D, D, (bf16*)(J.wbuf + W_HG_O), 32 * (r % 32), scr, 64 * (r / 32), 32 * (r % 32), F.lane); continue; } r -= I_O;
        if (r < NEXP * I_13) { const int e = r / I_13, r2 = r % I_13;
            conv_item(J.m13 + (size_t)e * D * 2 * FF, D, 2 * FF, (bf16*)(J.wbuf + W_HG_13) + (size_t)e * 2 * FF * D, swiglu_row(32 * (r2 % 224)), scr, 64 * (r2 / 224), 32 * (r2 % 224), F.lane); continue; } r -= NEXP * I_13;
        { const int e = r / I_2, r2 = r % I_2;
            conv_item(J.m2 + (size_t)e * FF * D, FF, D, (bf16*)(J.wbuf + W_HG_2) + (size_t)e * D * FF, 32 * (r2 % 32), scr, 64 * (r2 / 32), 32 * (r2 % 32), F.lane); }
    }
}
constexpr int CONV_HG_K = (16 * 128 + 16 * 32 + NEXP * (16 * 224 + 56 * 32) + 2047) / 2048 + 1;

__device__ __forceinline__ void mod_phase(Frame& F, const float* c, const float* ada_w, const float* ada_b, const float* lbl, float* mod, float* lbv) {
    LAS float* condT = (LAS float*)(F.lds + RING_OFF);
    LAS float* part = (LAS float*)(F.lds + RING_OFF + 65536);
    for (int idx = F.tid; idx < BATCH * D; idx += NWAVES * 64) { const int b = idx >> 10, k = idx & 1023; const float v = c[idx]; condT[k * 16 + b] = v * sigmoid_f(v); }
    __syncthreads();
    for (int it = blockIdx.x; it < DEPTH * (MODW / 64); it += F.G) {
        const int l = it / (MODW / 64), nb = it % (MODW / 64), n = nb * 64 + F.lane;
        float acc[16];
#pragma unroll
        for (int b = 0; b < 16; ++b) acc[b] = 0.f;
        const float* wp = ada_w + ((size_t)l * D + 128 * F.wave) * MODW + n;
#pragma unroll 4
        for (int k = 0; k < 128; ++k) { const float wv = wp[(size_t)k * MODW]; const LAS f32x4* cd = (const LAS f32x4*)(condT + (128 * F.wave + k) * 16);
#pragma unroll
            for (int q = 0; q < 4; ++q) { const f32x4 cv = cd[q]; acc[4 * q + 0] += cv[0] * wv; acc[4 * q + 1] += cv[1] * wv; acc[4 * q + 2] += cv[2] * wv; acc[4 * q + 3] += cv[3] * wv; } }
#pragma unroll
        for (int b = 0; b < 16; ++b) part[(F.wave * 16 + b) * 64 + F.lane] = acc[b];
        __syncthreads();
#pragma unroll
        for (int r = 0; r < 2; ++r) { const int idx = F.tid + 512 * r, b = idx >> 6, nn = idx & 63; float s = ada_b[l * MODW + nb * 64 + nn];
#pragma unroll
            for (int w = 0; w < 8; ++w) s += part[(w * 16 + b) * 64 + nn];
            mod[((size_t)l * BATCH + b) * MODW + nb * 64 + nn] = s; }
        __syncthreads();
    }
    if ((int)blockIdx.x == F.G - 1) {
        for (int d = F.tid; d < D; d += NWAVES * 64) { const float g0 = lbl[d], g1 = lbl[D + d], g2 = lbl[2 * D + d], g3 = lbl[3 * D + d];
            const float mx = fmaxf(fmaxf(g0, g1), fmaxf(g2, g3)); const float e0 = __expf(g0 - mx), e1 = __expf(g1 - mx), e2 = __expf(g2 - mx), e3 = __expf(g3 - mx); const float inv = 1.0f / (e0 + e1 + e2 + e3);
            lbv[d] = e1 * inv; lbv[D + d] = (e1 + e2 + e3) * inv; }
    }
    __syncthreads();
}

__device__ __forceinline__ void modulate_phase(Frame& F, const float* x, const float* mod0, bf16* H) {
    const int gw = F.vcu * NWAVES + F.wave, NGW = F.G * NWAVES;
    for (int it = gw; it < M / 32; it += NGW) {
        const int row0 = it * 32, b = row0 / SEQ; const float* mb = mod0 + (size_t)b * MODW;
        f32x4 sh[4], sc[4];
#pragma unroll
        for (int j = 0; j < 4; ++j) { sh[j] = *(const f32x4*)(mb + 256 * j + 4 * F.lane); sc[j] = *(const f32x4*)(mb + D + 256 * j + 4 * F.lane) + 1.0f; }
        for (int r = 0; r < 32; ++r) { const size_t m = (size_t)(row0 + r);
#pragma unroll
            for (int j = 0; j < 4; ++j) { const f32x4 v = __builtin_nontemporal_load((const GAS f32x4*)(x + m * D + 256 * j + 4 * F.lane)) * sc[j] + sh[j];
                u32x2 w; w.x = pk2(v[0], v[1]); w.y = pk2(v[2], v[3]); *(GAS u32x2*)(H + m * D + 256 * j + 4 * F.lane) = w; } }
    }
}

#ifndef LN_PD
#define LN_PD 4
#endif
#ifndef LN_PD_B
#define LN_PD_B 4
#endif
#ifndef LN_PD_MOE_LAST
#define LN_PD_MOE_LAST 2
#endif
#ifndef LN_PD_MOE
#define LN_PD_MOE 2
#endif
#ifndef LN_PD_ROUTE
#define LN_PD_ROUTE 2
#endif
template <bool MOE_Y, bool ROUTE, bool HAS_H, bool RO = false, bool XIB = false, bool XOB = false, bool QP = false>
__device__ __forceinline__ void ln_phase(Frame& F, const float* xin, float* xout, const bf16* Y, const float* gatev, const float* gam, const float* bet,
                                         const float* nsc, const float* nsh, bf16* H, const float* router, unsigned* route, gu32* cnt, unsigned* rtab = nullptr) {
    const int gw = F.vcu * NWAVES + F.wave, NGW = F.G * NWAVES;
    LAS float* rl = (LAS float*)(F.lds + RING_OFF);
    if (ROUTE) { for (int i = F.tid; i < D * NEXP; i += NWAVES * 64) rl[(i & 7) * D + (i >> 3)] = router[i]; __syncthreads(); }
    unsigned rbase[8];
    if (MOE_Y) { unsigned s = 0;
#pragma unroll
        for (int e = 0; e < 8; ++e) { rbase[e] = s; const unsigned ce = (unsigned)__builtin_amdgcn_readfirstlane(__hip_atomic_load(cnt + 64 * e, RLX_AGENT)); s += ((ce + 255u) >> 8) << 8; } }
    constexpr int NR = QP ? 8 : 32;
    for (int it = QP ? ((F.vcu & 1) ? 0 : 8) : gw; it < (QP ? 8 : M / 32); it += (QP ? 1 : NGW)) {
        const int row0 = QP ? ((F.vcu >> 5) * 8192 + it * 1024 + 2 * (((F.vcu & 31) >> 1) * NWAVES + F.wave)) : it * 32, b = row0 / SEQ;
#define LN_ROW(rr) (QP ? (row0 + 256 * ((rr) >> 1) + ((rr) & 1)) : (row0 + (rr)))
        f32x4 gt[4], gm[4], bt[4], sc[4], sh[4];
#pragma unroll
        for (int j = 0; j < 4; ++j) { const int cc = 256 * j + 4 * F.lane; if (!RO) { gt[j] = *(const GAS f32x4*)(gatev + (size_t)b * MODW + cc); gm[j] = *(const f32x4*)(gam + cc); bt[j] = *(const f32x4*)(bet + cc); }
            if (HAS_H) { sc[j] = *(const GAS f32x4*)(nsc + (size_t)b * MODW + cc) + 1.0f; sh[j] = *(const GAS f32x4*)(nsh + (size_t)b * MODW + cc); } }
        unsigned my_e1 = 0, my_e2 = 0; float my_w1 = 0.f, my_w2 = 0.f;
        v4u rt0 = {0u, 0u, 0u, 0u}, rt1 = {0u, 0u, 0u, 0u};
        if (MOE_Y) { const size_t mr = (size_t)LN_ROW(F.lane & 31); rt0 = *(const GAS v4u*)(route + mr * 8); rt1 = *(const GAS v4u*)(route + mr * 8 + 4); }
        constexpr int PD = ROUTE ? LN_PD_ROUTE : (MOE_Y ? (HAS_H ? LN_PD_MOE : LN_PD_MOE_LAST) : (XIB ? LN_PD_B : LN_PD));
        f32x4 nx[PD][4]; u32x2 nxb[PD][4], nya[PD][4], nyb[PD][4]; float nwa[PD], nwb[PD];
#ifndef LN_NT
#define LN_NT 1
#endif
#ifndef H_ST_NT
#define H_ST_NT 0
#endif
#ifndef LN_Y_NT
#define LN_Y_NT 1
#endif
#ifndef LN_XB_ST_NT
#define LN_XB_ST_NT 1
#endif
#ifndef LN_XB_NT
#define LN_XB_NT 1
#endif
#if LN_NT
#define LN_LD4(p_) __builtin_nontemporal_load((const GAS f32x4*)(p_))
#define LN_LD2(p_) (LN_Y_NT ? __builtin_nontemporal_load((const GAS u32x2*)(p_)) : *(const GAS u32x2*)(p_))
#define LN_ST4(p_, v_) __builtin_nontemporal_store((v_), (GAS f32x4*)(p_))
#else
#define LN_LD4(p_) (*(const GAS f32x4*)(p_))
#define LN_LD2(p_) (*(const GAS u32x2*)(p_))
#define LN_ST4(p_, v_) (*(GAS f32x4*)(p_) = (v_))
#endif
#define LN_XLOAD(S_, j_, mm_, cc_) do { if (XIB) nxb[S_][j_] = LN_XB_NT ? __builtin_nontemporal_load((const GAS u32x2*)((const bf16*)xin + (mm_) * D + (cc_))) : *(const GAS u32x2*)((const bf16*)xin + (mm_) * D + (cc_)); else nx[S_][j_] = LN_LD4(xin + (mm_) * D + (cc_)); } while (0)
#define LN_LOAD(rr, S_) do { const size_t m_ = (size_t)LN_ROW(rr); \
            if (MOE_Y) { const unsigned e1_ = (unsigned)__builtin_amdgcn_readlane((int)rt0.x, (rr)), p1_ = (unsigned)__builtin_amdgcn_readlane((int)rt0.y, (rr)), e2_ = (unsigned)__builtin_amdgcn_readlane((int)rt0.z, (rr)), p2_ = (unsigned)__builtin_amdgcn_readlane((int)rt0.w, (rr)); \
                nwa[S_] = __uint_as_float((unsigned)__builtin_amdgcn_readlane((int)rt1.x, (rr))); nwb[S_] = __uint_as_float((unsigned)__builtin_amdgcn_readlane((int)rt1.y, (rr))); \
                unsigned ba_ = 0, bb_ = 0; \
                _Pragma("unroll") for (int e = 0; e < 8; ++e) { ba_ = (e1_ == (unsigned)e) ? rbase[e] : ba_; bb_ = (e2_ == (unsigned)e) ? rbase[e] : bb_; } \
                const size_t ra_ = (size_t)(ba_ + p1_), rb_ = (size_t)(bb_ + p2_); \
                _Pragma("unroll") for (int j = 0; j < 4; ++j) { const int cc = 256 * j + 4 * F.lane; LN_XLOAD(S_, j, m_, cc); nya[S_][j] = LN_LD2(Y + ra_ * D + cc); nyb[S_][j] = LN_LD2(Y + rb_ * D + cc); } \
            } else { \
                _Pragma("unroll") for (int j = 0; j < 4; ++j) { const int cc = 256 * j + 4 * F.lane; LN_XLOAD(S_, j, m_, cc); if (!RO) nya[S_][j] = LN_LD2(Y + m_ * D + cc); } } } while (0)
        if (MOE_Y) { nwa[0] = 0.f; nwb[0] = 0.f; }
#pragma unroll
        for (int s_ = 0; s_ < PD; ++s_) LN_LOAD(s_, s_);
        for (int r2 = 0; r2 < NR; r2 += PD)
#pragma unroll
        for (int s_ = 0; s_ < PD; ++s_) { const int r = r2 + s_; const size_t m = (size_t)LN_ROW(r);
            f32x4 v[4]; float s = 0.f;
            {   f32x4 cx[4]; u32x2 cya[4], cyb[4]; const float wa = MOE_Y ? nwa[s_] : 0.f, wb = MOE_Y ? nwb[s_] : 0.f;
#pragma unroll
                for (int j = 0; j < 4; ++j) { cx[j] = XIB ? ln_unpack4(nxb[s_][j]) : nx[s_][j]; if (!RO) cya[j] = nya[s_][j]; if (MOE_Y) cyb[j] = nyb[s_][j]; }
                if (r + PD < NR) LN_LOAD(r + PD, s_);
#pragma unroll
                for (int j = 0; j < 4; ++j) { f32x4 yv;
                    if (MOE_Y) { yv[0] = wa * bf_lo(cya[j].x) + wb * bf_lo(cyb[j].x); yv[1] = wa * bf_hi(cya[j].x) + wb * bf_hi(cyb[j].x); yv[2] = wa * bf_lo(cya[j].y) + wb * bf_lo(cyb[j].y); yv[3] = wa * bf_hi(cya[j].y) + wb * bf_hi(cyb[j].y); }
                    else if (!RO) { yv[0] = bf_lo(cya[j].x); yv[1] = bf_hi(cya[j].x); yv[2] = bf_lo(cya[j].y); yv[3] = bf_hi(cya[j].y); }
                    if (RO) v[j] = cx[j]; else { v[j] = cx[j] * ALPHA + gt[j] * yv; s += (v[j][0] + v[j][1]) + (v[j][2] + v[j][3]); } }
            }
            float rstd = 1.0f;
            if (!RO) { const float mean = wave_sum(s, F.lane) * (1.0f / D); float s2 = 0.f;
#pragma unroll
                for (int j = 0; j < 4; ++j) { v[j] = v[j] - mean; s2 += (v[j][0] * v[j][0] + v[j][1] * v[j][1]) + (v[j][2] * v[j][2] + v[j][3] * v[j][3]); }
                rstd = 1.0f / sqrtf(wave_sum(s2, F.lane) * (1.0f / D) + LN_EPS); }
            float lg[8];
#pragma unroll
            for (int e = 0; e < 8; ++e) lg[e] = 0.f;
#pragma unroll
            for (int j = 0; j < 4; ++j) { const int cc = 256 * j + 4 * F.lane; const f32x4 xn = RO ? v[j] : v[j] * rstd * gm[j] + bt[j]; if (!RO) { if (XOB) { u32x2 wx; wx.x = pk2(xn[0], xn[1]); wx.y = pk2(xn[2], xn[3]); if (LN_XB_ST_NT) __builtin_nontemporal_store(wx, (GAS u32x2*)((bf16*)xout + m * D + cc)); else *(GAS u32x2*)((bf16*)xout + m * D + cc) = wx; } else LN_ST4(xout + m * D + cc, xn); }
                if (HAS_H) { const f32x4 hv = xn * sc[j] + sh[j]; if (!RO) { u32x2 w; w.x = pk2(hv[0], hv[1]); w.y = pk2(hv[2], hv[3]);
                    if (QP) __hip_atomic_store((gu64*)(H + m * D + cc), (unsigned long long)w.x | ((unsigned long long)w.y << 32), RLX_AGENT);
                    else if (H_ST_NT) __builtin_nontemporal_store(w, (GAS u32x2*)(H + m * D + cc)); else *(GAS u32x2*)(H + m * D + cc) = w; } v[j] = hv; } }
            if (ROUTE) {
#pragma unroll
                for (int j = 0; j < 4; ++j) { const int cc = 256 * j + 4 * F.lane;
#pragma unroll
                    for (int e = 0; e < 8; ++e) { const f32x4 rw = *(const LAS f32x4*)(rl + e * D + cc); lg[e] += (v[j][0] * rw[0] + v[j][1] * rw[1]) + (v[j][2] * rw[2] + v[j][3] * rw[3]); }
                    asm volatile("" ::: "memory"); }
            }
            if (ROUTE) {
#pragma unroll
                for (int e = 0; e < 8; ++e) lg[e] = wave_sum(lg[e], F.lane);
                int i1 = 0; float l1 = lg[0];
#pragma unroll
                for (int e = 1; e < 8; ++e) if (lg[e] > l1) { l1 = lg[e]; i1 = e; }
                int i2 = -1; float l2 = -INFINITY;
#pragma unroll
                for (int e = 0; e < 8; ++e) if (e != i1 && lg[e] > l2) { l2 = lg[e]; i2 = e; }
                const float w1 = 1.0f / (1.0f + __expf(l2 - l1)), w2 = 1.0f - w1;
                if (F.lane == r) { my_e1 = (unsigned)i1; my_e2 = (unsigned)i2; my_w1 = w1; my_w2 = w2; }
            }
        }
        if (QP) { asm volatile("s_waitcnt vmcnt(0)" ::: "memory"); if (F.lane == 0) __hip_atomic_fetch_add(cnt + 16 * (8 * (F.vcu >> 5) + it), 1u, RLX_AGENT); }
        if (ROUTE) {
            const bool act = F.lane < 32; unsigned p1 = 0, p2 = 0; const unsigned long long lt = (1ull << F.lane) - 1ull;
#pragma unroll
            for (int e = 0; e < 8; ++e) { const unsigned long long m1 = __ballot(act && my_e1 == (unsigned)e), m2 = __ballot(act && my_e2 == (unsigned)e);
                const unsigned n1 = (unsigned)__popcll(m1), n2 = (unsigned)__popcll(m2); unsigned base = 0;
                if (F.lane == 0 && (n1 + n2) != 0u) base = __hip_atomic_fetch_add(cnt + 64 * e, n1 + n2, RLX_AGENT);
                base = (unsigned)__builtin_amdgcn_readfirstlane(base);
                if (my_e1 == (unsigned)e) p1 = base + (unsigned)__popcll(m1 & lt);
                if (my_e2 == (unsigned)e) p2 = base + n1 + (unsigned)__popcll(m2 & lt); }
            if (act) { const size_t m = (size_t)LN_ROW(F.lane); v4u a; a.x = my_e1; a.y = p1; a.z = my_e2; a.w = p2; v4u bb; bb.x = __float_as_uint(my_w1); bb.y = __float_as_uint(my_w2); bb.z = 0u; bb.w = 0u;
                *(GAS v4u*)(route + m * 8) = a; *(GAS v4u*)(route + m * 8 + 4) = bb;
                if (rtab != nullptr) { *(GAS unsigned*)(rtab + (size_t)my_e1 * M + p1) = (unsigned)m; *(GAS unsigned*)(rtab + (size_t)my_e2 * M + p2) = (unsigned)m; } }
        }
    }
    if (ROUTE) __syncthreads();
#undef LN_LOAD
#undef LN_XLOAD
#undef LN_LD4
#undef LN_LD2
#undef LN_ST4
#undef LN_ROW
}

__device__ __forceinline__ void moe_tail_reduce(Frame& F, const pg8::GroupedOrder& S, int first, int ntail, int KS, const bf16* PB, bf16* YS) {
    const int gw = F.vcu * NWAVES + F.wave, NGW = F.G * NWAVES;
    for (int it = gw; it < ntail * 256; it += NGW) { const int t = it >> 8, r = it & 255; pg8::Unit u; S.unit_of(first + t, u);
        float a0 = 0.f, a1 = 0.f, a2 = 0.f, a3 = 0.f;
        for (int s = 0; s < KS; ++s) { const u32x2 w = *(const GAS u32x2*)(PB + ((size_t)(s * ntail + t) * 256 + r) * 256 + 4 * F.lane); a0 += bf_lo(w.x); a1 += bf_hi(w.x); a2 += bf_lo(w.y); a3 += bf_hi(w.y); }
        u32x2 o; o.x = pk2(a0, a1); o.y = pk2(a2, a3); *(GAS u32x2*)(YS + ((size_t)u.pm * 256 + r) * D + u.pn * 256 + 4 * F.lane) = o; }
}

__device__ __forceinline__ void permute_phase(Frame& F, const bf16* H, const unsigned* route, gu32* cnt, bf16* HS) {
    const int gw = F.vcu * NWAVES + F.wave, NGW = F.G * NWAVES;
    unsigned rbase[8]; { unsigned s = 0;
#pragma unroll
        for (int e = 0; e < 8; ++e) { rbase[e] = s; const unsigned ce = (unsigned)__builtin_amdgcn_readfirstlane(__hip_atomic_load(cnt + 64 * e, RLX_AGENT)); s += ((ce + 255u) >> 8) << 8; } }
    for (int m0 = gw; m0 < M; m0 += 4 * NGW) {
        v4u rr[4], h0[4], h1[4]; size_t ra[4], rb[4];
#pragma unroll
        for (int k = 0; k < 4; ++k) { const int m = m0 + k * NGW; if (m < M) rr[k] = *(const GAS v4u*)(route + (size_t)m * 8); }
#pragma unroll
        for (int k = 0; k < 4; ++k) { const int m = m0 + k * NGW; if (m < M) { h0[k] = __builtin_nontemporal_load((const GAS v4u*)(H + (size_t)m * D + 8 * F.lane)); h1[k] = __builtin_nontemporal_load((const GAS v4u*)(H + (size_t)m * D + 512 + 8 * F.lane)); } }
#pragma unroll
        for (int k = 0; k < 4; ++k) { unsigned ba = 0, bb = 0;
#pragma unroll
            for (int e = 0; e < 8; ++e) { ba = (rr[k].x == (unsigned)e) ? rbase[e] : ba; bb = (rr[k].z == (unsigned)e) ? rbase[e] : bb; }
            ra[k] = (size_t)(ba + rr[k].y); rb[k] = (size_t)(bb + rr[k].w); }
#pragma unroll
        for (int k = 0; k < 4; ++k) { const int m = m0 + k * NGW; if (m < M) {
            *(GAS v4u*)(HS + ra[k] * D + 8 * F.lane) = h0[k]; *(GAS v4u*)(HS + ra[k] * D + 512 + 8 * F.lane) = h1[k];
            *(GAS v4u*)(HS + rb[k] * D + 8 * F.lane) = h0[k]; *(GAS v4u*)(HS + rb[k] * D + 512 + 8 * F.lane) = h1[k]; } }
    }
}

__device__ __forceinline__ void hgate_phase(Frame& F, const float* O, const bf16* SG, const float* ng, bf16* H) {
    const int gw = F.vcu * NWAVES + F.wave, NGW = F.G * NWAVES;
    const f32x4 g4 = *(const f32x4*)(ng + ((4 * F.lane) & 127));
    for (int m0 = gw; m0 < M; m0 += 2 * NGW) {
        f32x4 ov[2][4]; u32x2 gv[2][4];
#pragma unroll
        for (int k = 0; k < 2; ++k) { const int m = m0 + k * NGW; if (m < M) {
#pragma unroll
            for (int j = 0; j < 4; ++j) { const int cc = 256 * j + 4 * F.lane; ov[k][j] = *(const GAS f32x4*)(O + (size_t)m * D + cc); gv[k][j] = *(const GAS u32x2*)(SG + (size_t)m * D + cc); } } }
#pragma unroll
        for (int k = 0; k < 2; ++k) { const int m = m0 + k * NGW; if (m < M) {
#pragma unroll
            for (int j = 0; j < 4; ++j) { const int cc = 256 * j + 4 * F.lane; const f32x4 o = ov[k][j]; const u32x2 gw2 = gv[k][j];
                float q = (o[0] * o[0] + o[1] * o[1]) + (o[2] * o[2] + o[3] * o[3]);
#pragma unroll
                for (int s2 = 1; s2 < 32; s2 <<= 1) q += shx(q, s2, F.lane);
                const float rs = 1.0f / sqrtf(q * (1.0f / 128.0f) + RMS_EPS);
                f32x4 r; r[0] = o[0] * rs * g4[0] * bf_lo(gw2.x); r[1] = o[1] * rs * g4[1] * bf_hi(gw2.x); r[2] = o[2] * rs * g4[2] * bf_lo(gw2.y); r[3] = o[3] * rs * g4[3] * bf_hi(gw2.y);
                u32x2 w; w.x = pk2(r[0], r[1]); w.y = pk2(r[2], r[3]); *(GAS u32x2*)(H + (size_t)m * D + cc) = w; } } }
    }
}

__device__ __forceinline__ void hgrn_phase(Frame& F, const bf16* Q, const float* Fg, const bf16* I, float* O) {
    LAS float* sq = (LAS float*)(F.lds + RING_OFF);
    LAS float* sf = sq + 4096;
    LAS float* sv = sf + 4096;
    LAS float* so = sv + 2048;
    const int tt = F.tid >> 4, d8 = (F.tid & 15) * 8, c4 = (F.tid & 15) * 4;
    for (int u = blockIdx.x; u < BATCH * NH_HG * 2; u += F.G) {
        const int b = u >> 4, h = (u >> 1) & 7, half = u & 1; const size_t row0 = (size_t)b * SEQ;
        float S[16];
#pragma unroll
        for (int j = 0; j < 16; ++j) S[j] = 0.f;
        const bf16* qp = Q + (row0 + tt) * D + h * 128 + d8; const float* fp = Fg + (row0 + tt) * D + h * 128 + d8; const bf16* ip = I + (row0 + tt) * D + h * 128 + half * 64 + c4;
        v4u rq = *(const GAS v4u*)qp; f32x4 rf0 = *(const GAS f32x4*)fp, rf1 = *(const GAS f32x4*)(fp + 4); u32x2 rv = *(const GAS u32x2*)ip;
        for (int ck = 0; ck < SEQ / 32; ++ck) {
            { LAS float* q8 = sq + tt * 128 + d8; q8[0] = bf_lo(rq.x); q8[1] = bf_hi(rq.x); q8[2] = bf_lo(rq.y); q8[3] = bf_hi(rq.y); q8[4] = bf_lo(rq.z); q8[5] = bf_hi(rq.z); q8[6] = bf_lo(rq.w); q8[7] = bf_hi(rq.w);
              *(LAS f32x4*)(sf + tt * 128 + d8) = rf0; *(LAS f32x4*)(sf + tt * 128 + d8 + 4) = rf1;
              LAS float* v4 = sv + tt * 64 + c4; v4[0] = bf_lo(rv.x); v4[1] = bf_hi(rv.x); v4[2] = bf_lo(rv.y); v4[3] = bf_hi(rv.y); }
            __syncthreads();
            if (ck + 1 < SEQ / 32) { const size_t adv = (size_t)(ck + 1) * 32 * D; rq = *(const GAS v4u*)(qp + adv); rf0 = *(const GAS f32x4*)(fp + adv); rf1 = *(const GAS f32x4*)(fp + adv + 4); rv = *(const GAS u32x2*)(ip + adv); }
            for (int t = 0; t < 32; ++t) {
                const float vt = sv[t * 64 + F.lane]; float op = 0.f;
#pragma unroll
                for (int j4 = 0; j4 < 4; ++j4) { const f32x4 f4 = *(const LAS f32x4*)(sf + t * 128 + 16 * F.wave + 4 * j4), q4 = *(const LAS f32x4*)(sq + t * 128 + 16 * F.wave + 4 * j4);
#pragma unroll
                    for (int i = 0; i < 4; ++i) { const float fj = f4[i]; S[4 * j4 + i] = fj * S[4 * j4 + i] + (1.0f - fj) * vt; op += q4[i] * S[4 * j4 + i]; } }
                so[(F.wave * 32 + t) * 64 + F.lane] = op;
            }
            __syncthreads();
#pragma unroll
            for (int r = 0; r < 4; ++r) { const int idx = F.tid + 512 * r, t = idx >> 6, v = idx & 63; float s = 0.f;
#pragma unroll
                for (int w = 0; w < 8; ++w) s += so[(w * 32 + t) * 64 + v];
                O[(row0 + (size_t)ck * 32 + t) * D + h * 128 + half * 64 + v] = s; }
        }
        __syncthreads();
    }
}

__device__ __forceinline__ void sbattn_phase(Frame& F, const bf16* Q, const bf16* K, const bf16* V, bf16* O) {
    LAS unsigned char* myl = F.lds + RING_OFF + F.wave * 16384;
    const int gw = F.vcu * NWAVES + F.wave, NGW = F.G * NWAVES;
    for (int task = gw; task < BATCH * NH_SB * (SEQ / 64); task += NGW) {
        const int qblk = task & 63, bh = task >> 6, b = bh >> 4, h = bh & 15; const size_t rowb = (size_t)b * SEQ; const int t = qblk * 64 + F.lane;
        float q[64], acc[64];
#pragma unroll
        for (int p = 0; p < 8; ++p) { const v4u w = *(const GAS v4u*)(Q + (rowb + t) * D + h * 64 + 8 * p);
            q[8 * p + 0] = bf_lo(w.x); q[8 * p + 1] = bf_hi(w.x); q[8 * p + 2] = bf_lo(w.y); q[8 * p + 3] = bf_hi(w.y); q[8 * p + 4] = bf_lo(w.z); q[8 * p + 5] = bf_hi(w.z); q[8 * p + 6] = bf_lo(w.w); q[8 * p + 7] = bf_hi(w.w); }
#pragma unroll
        for (int d = 0; d < 64; ++d) acc[d] = 0.f;
        float carry = 1.0f;
        for (int kt = qblk; kt >= 0; --kt) {
            asm volatile("s_waitcnt lgkmcnt(0)" ::: "memory");
#pragma unroll
            for (int i = 0; i < 8; ++i) { const int c = i * 64 + F.lane, key = c >> 3, part = c & 7; const size_t go = (rowb + (size_t)kt * 64 + key) * D + h * 64 + part * 8;
                *(LAS v4u*)(myl + c * 16) = *(const GAS v4u*)(K + go); *(LAS v4u*)(myl + 8192 + c * 16) = *(const GAS v4u*)(V + go); }
            asm volatile("s_waitcnt vmcnt(0) lgkmcnt(0)" ::: "memory");
            for (int sl = 63; sl >= 0; --sl) {
                const int s = kt * 64 + sl;
                float z0 = 0.f, z1 = 0.f;
#pragma unroll
                for (int p = 0; p < 8; ++p) { const v4u w = *(const LAS v4u*)(myl + sl * 128 + p * 16);
                    z0 += q[8 * p + 0] * bf_lo(w.x) + q[8 * p + 2] * bf_lo(w.y) + q[8 * p + 4] * bf_lo(w.z) + q[8 * p + 6] * bf_lo(w.w);
                    z1 += q[8 * p + 1] * bf_hi(w.x) + q[8 * p + 3] * bf_hi(w.y) + q[8 * p + 5] * bf_hi(w.z) + q[8 * p + 7] * bf_hi(w.w); }
                const float z = z0 + z1, e = __expf(-fabsf(z)), rr = 1.0f / (1.0f + e);
                const float beta = z >= 0.f ? rr : e * rr, omb = z >= 0.f ? e * rr : rr;
                const bool valid = s < t;
                const float a = valid ? beta * carry : 0.f; carry = valid ? carry * omb : carry;
#pragma unroll
                for (int p = 0; p < 8; ++p) { const v4u w = *(const LAS v4u*)(myl + 8192 + sl * 128 + p * 16);
                    acc[8 * p + 0] += a * bf_lo(w.x); acc[8 * p + 1] += a * bf_hi(w.x); acc[8 * p + 2] += a * bf_lo(w.y); acc[8 * p + 3] += a * bf_hi(w.y);
                    acc[8 * p + 4] += a * bf_lo(w.z); acc[8 * p + 5] += a * bf_hi(w.z); acc[8 * p + 6] += a * bf_lo(w.w); acc[8 * p + 7] += a * bf_hi(w.w); }
            }
            if (__all(carry < 1e-37f)) break;
        }
#pragma unroll
        for (int p = 0; p < 8; ++p) { v4u w; w.x = pk2(acc[8 * p + 0], acc[8 * p + 1]); w.y = pk2(acc[8 * p + 2], acc[8 * p + 3]); w.z = pk2(acc[8 * p + 4], acc[8 * p + 5]); w.w = pk2(acc[8 * p + 6], acc[8 * p + 7]);
            *(GAS v4u*)(O + (rowb + t) * D + h * 64 + 8 * p) = w; }
    }
}

#ifndef SB_STATIC_PRIO
#define SB_STATIC_PRIO 1
#endif
#ifndef SB_SETPRIO
#define SB_SETPRIO 0
#endif
#if SB_SETPRIO
#define SB_PRIO(x) __builtin_amdgcn_s_setprio(x)
#else
#define SB_PRIO(x) do {} while (0)
#endif
#ifndef SB_Q_NT
#define SB_Q_NT 0
#endif
#ifndef SB_O_NT
#define SB_O_NT 0
#endif
#ifndef SB_STOP
#define SB_STOP 1e-9f
#endif
typedef float f32x16 __attribute__((ext_vector_type(16)));
typedef short s16x4v __attribute__((ext_vector_type(4)));
__device__ __forceinline__ void sb_weights(const f32x16& z, float& carry, bool diag, int kb, int t, int hi, bf16x8& p0, bf16x8& p1) {
    float be[16], om[16];
#pragma unroll
    for (int r = 0; r < 16; ++r) {
        const float e = __builtin_amdgcn_exp2f(fminf(-1.4426950408889634f * z[r], 126.0f)); const float rr = __builtin_amdgcn_rcpf(1.0f + e); be[r] = rr; om[r] = e * rr; }
    if (diag) {
#pragma unroll
        for (int r = 0; r < 16; ++r) { const int key = kb + (r & 7) + 8 * hi + 16 * (r >> 3); const bool valid = key < t; be[r] = valid ? be[r] : 0.f; om[r] = valid ? om[r] : 1.f; } }
    float s1 = 1.f, s0 = 1.f;
#pragma unroll
    for (int r = 15; r >= 8; --r) { const float o = om[r]; om[r] = s1; s1 *= o; }
#pragma unroll
    for (int r = 7; r >= 0; --r) { const float o = om[r]; om[r] = s0; s0 *= o; }
    const auto x1 = __builtin_amdgcn_permlane32_swap(__float_as_uint(s1), __float_as_uint(s1), false, false);
    const auto x0 = __builtin_amdgcn_permlane32_swap(__float_as_uint(s0), __float_as_uint(s0), false, false);
    const float P1lo = __uint_as_float(x1[0]), P1hi = __uint_as_float(x1[1]), P0lo = __uint_as_float(x0[0]), P0hi = __uint_as_float(x0[1]);
    const float f1 = hi ? carry : carry * P1hi; const float c2 = carry * P1hi * P1lo; const float f0 = hi ? c2 : c2 * P0hi;
    carry = c2 * P0hi * P0lo;
    unsigned w[8];
#pragma unroll
    for (int i = 0; i < 4; ++i) { w[i] = pk2(be[2 * i] * om[2 * i] * f0, be[2 * i + 1] * om[2 * i + 1] * f0); w[4 + i] = pk2(be[8 + 2 * i] * om[8 + 2 * i] * f1, be[9 + 2 * i] * om[9 + 2 * i] * f1); }
    v4u a; a.x = w[0]; a.y = w[1]; a.z = w[2]; a.w = w[3]; v4u b; b.x = w[4]; b.y = w[5]; b.z = w[6]; b.w = w[7];
    p0 = __builtin_bit_cast(bf16x8, a); p1 = __builtin_bit_cast(bf16x8, b);
}
__device__ __forceinline__ void sbattn2_phase(Frame& F, const bf16* Q, const bf16* K, const bf16* V, bf16* O) {
    const int lane = F.lane, q = lane & 31, hi = lane >> 5;
    LAS unsigned char* vb = F.lds + RING_OFF + F.wave * 8192;
    const int g = lane >> 4, q_ = (lane & 15) >> 2, p_ = lane & 3;
    const int troff = (8 * (g >> 1) + q_) * 128 + (16 * (g & 1) + 4 * p_) * 2;
    const int pi_q = (q & 3) | (((q >> 3) & 1) << 2) | (((q >> 2) & 1) << 3) | (q & 16);
    const unsigned qoff = (unsigned)(q * D + hi * 8);
    const unsigned koff = (unsigned)(pi_q * D + hi * 8), voff = (unsigned)((lane >> 3) * D + (lane & 7) * 8);
#if SB_STATIC_PRIO
    if (F.wave >= 4) __builtin_amdgcn_s_setprio(1);
#endif
    for (int u = blockIdx.x; u < BATCH * NH_SB * 8; u += F.G) {
        const int bh = u >> 3, chunk = u & 7, b = bh >> 4, h = bh & 15; const int q0 = chunk * 512 + F.wave * 64; const size_t rowb = (size_t)b * SEQ;
        const bf16* Qu = Q + (rowb + q0) * D + h * 64; asm volatile("" : "+s"(Qu));
        bf16x8 qa[4], qb[4];
#pragma unroll
        for (int d0 = 0; d0 < 4; ++d0) { if (SB_Q_NT) { qa[d0] = __builtin_nontemporal_load((const GAS bf16x8*)(Qu + (qoff + d0 * 16))); qb[d0] = __builtin_nontemporal_load((const GAS bf16x8*)(Qu + (qoff + 32 * D + d0 * 16))); }
            else { qa[d0] = *(const GAS bf16x8*)(Qu + (qoff + d0 * 16)); qb[d0] = *(const GAS bf16x8*)(Qu + (qoff + 32 * D + d0 * 16)); } }
        f32x16 oa[2], ob[2];
#pragma unroll
        for (int r = 0; r < 16; ++r) { oa[0][r] = 0.f; oa[1][r] = 0.f; ob[0][r] = 0.f; ob[1][r] = 0.f; }
        float ca = 1.f, cb = 1.f; const int jtop = (q0 >> 5) + 1;
        bf16x8 kn[4];
        { const bf16* Ku = K + (rowb + 32 * jtop) * D + h * 64; const bf16* Vu = V + (rowb + 32 * jtop) * D + h * 64; asm volatile("" : "+s"(Ku), "+s"(Vu));
#pragma unroll
          for (int d0 = 0; d0 < 4; ++d0) kn[d0] = *(const GAS bf16x8*)(Ku + (koff + d0 * 16));
#pragma unroll
          for (int i = 0; i < 4; ++i) __builtin_amdgcn_global_load_lds((const GAS unsigned*)(Vu + (voff + i * 8 * D)), (LAS unsigned*)(vb + (jtop & 1) * 4096 + i * 1024), 16, 0, 0); }
        for (int j = jtop; j >= 0; --j) {
            const int kb = 32 * j;
            asm volatile("s_waitcnt vmcnt(0)" ::: "memory");
            const unsigned vaddr = (unsigned)(uintptr_t)(vb + (j & 1) * 4096 + troff);
            bf16x8 pa0, pa1, pb0, pb1;
            { f32x16 sa;
#pragma unroll
              for (int r = 0; r < 16; ++r) sa[r] = 0.f;
              SB_PRIO(1);
#pragma unroll
              for (int d0 = 0; d0 < 4; ++d0) sa = __builtin_amdgcn_mfma_f32_32x32x16_bf16(kn[d0], qa[d0], sa, 0, 0, 0);
              SB_PRIO(0);
              sb_weights(sa, ca, j >= jtop - 1, kb, q0 + q, hi, pa0, pa1); }
            { f32x16 sb;
#pragma unroll
              for (int r = 0; r < 16; ++r) sb[r] = 0.f;
              SB_PRIO(1);
#pragma unroll
              for (int d0 = 0; d0 < 4; ++d0) sb = __builtin_amdgcn_mfma_f32_32x32x16_bf16(kn[d0], qb[d0], sb, 0, 0, 0);
              SB_PRIO(0);
              if (j > 0) { const bf16* Ku = K + (rowb + kb - 32) * D + h * 64; const bf16* Vu = V + (rowb + kb - 32) * D + h * 64; asm volatile("" : "+s"(Ku), "+s"(Vu));
#pragma unroll
                  for (int d0 = 0; d0 < 4; ++d0) kn[d0] = *(const GAS bf16x8*)(Ku + (koff + d0 * 16));
#pragma unroll
                  for (int i = 0; i < 4; ++i) __builtin_amdgcn_global_load_lds((const GAS unsigned*)(Vu + (voff + i * 8 * D)), (LAS unsigned*)(vb + ((j - 1) & 1) * 4096 + i * 1024), 16, 0, 0); }
              sb_weights(sb, cb, j >= jtop, kb, q0 + 32 + q, hi, pb0, pb1); }
            s16x4v vl[2][2], vu[2][2];
#pragma unroll
            for (int dh = 0; dh < 2; ++dh)
#pragma unroll
                for (int m = 0; m < 2; ++m) {
                    asm volatile("ds_read_b64_tr_b16 %0, %1 offset:%c2" : "=&v"(vl[dh][m]) : "v"(vaddr), "i"(m * 2048 + dh * 64) : "memory");
                    asm volatile("ds_read_b64_tr_b16 %0, %1 offset:%c2" : "=&v"(vu[dh][m]) : "v"(vaddr), "i"(m * 2048 + 512 + dh * 64) : "memory"); }
            asm volatile("s_waitcnt lgkmcnt(0)" ::: "memory"); __builtin_amdgcn_sched_barrier(0);
            SB_PRIO(1);
#pragma unroll
            for (int dh = 0; dh < 2; ++dh)
#pragma unroll
                for (int m = 0; m < 2; ++m) {
                    const bf16x8 vf = (bf16x8){vl[dh][m][0], vl[dh][m][1], vl[dh][m][2], vl[dh][m][3], vu[dh][m][0], vu[dh][m][1], vu[dh][m][2], vu[dh][m][3]};
                    oa[dh] = __builtin_amdgcn_mfma_f32_32x32x16_bf16(vf, m ? pa1 : pa0, oa[dh], 0, 0, 0);
                    ob[dh] = __builtin_amdgcn_mfma_f32_32x32x16_bf16(vf, m ? pb1 : pb0, ob[dh], 0, 0, 0); }
            SB_PRIO(0);
            if (__all(ca < SB_STOP && cb < SB_STOP)) break;
        }
        {   LAS unsigned char* ost = F.lds + RING_OFF + 65536 + F.wave * 8192;
#pragma unroll
            for (int dh = 0; dh < 2; ++dh)
#pragma unroll
                for (int r4 = 0; r4 < 4; ++r4) { u32x2 wa, wb; wa.x = pk2(oa[dh][4 * r4], oa[dh][4 * r4 + 1]); wa.y = pk2(oa[dh][4 * r4 + 2], oa[dh][4 * r4 + 3]); wb.x = pk2(ob[dh][4 * r4], ob[dh][4 * r4 + 1]); wb.y = pk2(ob[dh][4 * r4 + 2], ob[dh][4 * r4 + 3]);
                    const int pc = 4 * dh + r4, ra = q, rb_ = q + 32;
                    *(LAS u32x2*)(ost + ra * 128 + 16 * (pc ^ ((ra >> 1) & 7)) + 8 * hi) = wa; *(LAS u32x2*)(ost + rb_ * 128 + 16 * (pc ^ ((rb_ >> 1) & 7)) + 8 * hi) = wb; }
            bf16* Ou = O + (rowb + q0) * D + h * 64; asm volatile("" : "+s"(Ou));
#pragma unroll
            for (int i = 0; i < 8; ++i) { const int r = 8 * i + (lane >> 3), pc = lane & 7; const v4u w = *(const LAS v4u*)(ost + r * 128 + 16 * (pc ^ ((r >> 1) & 7)));
                if (SB_O_NT) __builtin_nontemporal_store(w, (GAS v4u*)(Ou + (unsigned)(r * D + 8 * pc))); else *(GAS v4u*)(Ou + (unsigned)(r * D + 8 * pc)) = w; }
        }
    }
#if SB_STATIC_PRIO
    __builtin_amdgcn_s_setprio(0);
#endif
}

__device__ __forceinline__ void hgrn2_phase(Frame& F, const bf16* Q, const float* Fg, const bf16* I, float* O) {
    constexpr int RS = 272, VS = 144;
    LAS unsigned char* L = F.lds + RING_OFF;
    LAS float* TOT = (LAS float*)L;
    LAS float* CUM = (LAS float*)(L + 2048);
    LAS unsigned char* QE = L + 18432; LAS unsigned char* KE = QE + 8704; LAS unsigned char* QD = KE + 8704; LAS unsigned char* KD = QD + 8704;
    LAS unsigned char* VV = L + 53248;
    LAS float* EREF = (LAS float*)(L + 57856); LAS float* EER = EREF + 128; LAS float* EEND = EER + 128;
    LAS float* OP = (LAS float*)(L + 59392);
    const int tid = F.tid, lane = F.lane, w = F.wave, dt = w >> 1, vt = w & 1;
    const int dA = tid & 127, qtr = tid >> 7, tB = tid >> 4, d8 = (tid & 15) * 8, c4 = (tid & 15) * 4;
    const int c = lane & 31, hi = lane >> 5, g = lane >> 4, q_ = (lane & 15) >> 2, p_ = lane & 3;
    const int rowfrag = c * RS + (32 * dt + 8 * hi) * 2, qdfrag = c * RS + (32 * dt + 4 * hi) * 2;
    const int trk = (8 * hi + q_) * RS + (32 * dt + 16 * (g & 1) + 4 * p_) * 2;
    const int trv = (8 * hi + q_) * VS + (32 * vt + 16 * (g & 1) + 4 * p_) * 2, trvp = (4 * hi + q_) * VS + (32 * vt + 16 * (g & 1) + 4 * p_) * 2;
    for (int u = blockIdx.x; u < BATCH * NH_HG * 2; u += F.G) {
        const int b = u >> 4, h = (u >> 1) & 7, half = u & 1; const size_t row0 = (size_t)b * SEQ;
        f32x16 S;
#pragma unroll
        for (int r = 0; r < 16; ++r) S[r] = 0.f;
        const float* fA = Fg + (row0 + 8 * qtr) * D + h * 128 + dA;
        const bf16* qB = Q + (row0 + tB) * D + h * 128 + d8; const float* fB = Fg + (row0 + tB) * D + h * 128 + d8; const bf16* vB = I + (row0 + tB) * D + h * 128 + half * 64 + c4;
        float fa[8];
#pragma unroll
        for (int i = 0; i < 8; ++i) fa[i] = *(const GAS float*)(fA + (size_t)i * D);
        v4u rq = *(const GAS v4u*)qB; f32x4 rf0 = *(const GAS f32x4*)fB, rf1 = *(const GAS f32x4*)(fB + 4); u32x2 rv = *(const GAS u32x2*)vB;
        for (int ck = 0; ck < SEQ / 32; ++ck) {
            float cl[8]; { float run = 0.f;
#pragma unroll
                for (int i = 0; i < 8; ++i) { run += __builtin_amdgcn_logf(fa[i]); cl[i] = run; }
                TOT[qtr * 128 + dA] = run; }
            __syncthreads();
            { const float T0 = TOT[dA], T1 = TOT[128 + dA], T2 = TOT[256 + dA], T3 = TOT[384 + dA];
              const float off = (qtr > 0 ? T0 : 0.f) + (qtr > 1 ? T1 : 0.f) + (qtr > 2 ? T2 : 0.f);
#pragma unroll
              for (int i = 0; i < 8; ++i) CUM[(8 * qtr + i) * 128 + dA] = off + cl[i];
              const float ref = T0 + T1, end = (T0 + T1) + (T2 + T3);
              if (qtr == 0) EREF[dA] = __builtin_amdgcn_exp2f(ref); else if (qtr == 1) EER[dA] = __builtin_amdgcn_exp2f(end - ref); else if (qtr == 2) EEND[dA] = __builtin_amdgcn_exp2f(end); }
            __syncthreads();
            { const f32x4 cu0 = *(const LAS f32x4*)(CUM + tB * 128 + d8), cu1 = *(const LAS f32x4*)(CUM + tB * 128 + d8 + 4);
              const f32x4 r0 = *(const LAS f32x4*)(TOT + d8) + *(const LAS f32x4*)(TOT + 128 + d8), r1 = *(const LAS f32x4*)(TOT + d8 + 4) + *(const LAS f32x4*)(TOT + 128 + d8 + 4);
              const f32x4 er0 = *(const LAS f32x4*)(EREF + d8), er1 = *(const LAS f32x4*)(EREF + d8 + 4), ee0 = *(const LAS f32x4*)(EER + d8), ee1 = *(const LAS f32x4*)(EER + d8 + 4);
              float qv[8] = {bf_lo(rq.x), bf_hi(rq.x), bf_lo(rq.y), bf_hi(rq.y), bf_lo(rq.z), bf_hi(rq.z), bf_lo(rq.w), bf_hi(rq.w)};
              float qe[8], ke[8], qd[8], kd[8];
#pragma unroll
              for (int e = 0; e < 8; ++e) { const float cu = e < 4 ? cu0[e & 3] : cu1[e & 3], rf = e < 4 ? r0[e & 3] : r1[e & 3], fv = e < 4 ? rf0[e & 3] : rf1[e & 3];
                  const float a = __builtin_amdgcn_exp2f(cu - rf), ai = __builtin_amdgcn_rcpf(a), kv = 1.0f - fv;
                  qe[e] = qv[e] * a; ke[e] = kv * ai; qd[e] = qe[e] * (e < 4 ? er0[e & 3] : er1[e & 3]); kd[e] = ke[e] * (e < 4 ? ee0[e & 3] : ee1[e & 3]); }
              v4u o; const int ro = tB * RS + d8 * 2;
              o.x = pk2(qe[0], qe[1]); o.y = pk2(qe[2], qe[3]); o.z = pk2(qe[4], qe[5]); o.w = pk2(qe[6], qe[7]); *(LAS v4u*)(QE + ro) = o;
              o.x = pk2(ke[0], ke[1]); o.y = pk2(ke[2], ke[3]); o.z = pk2(ke[4], ke[5]); o.w = pk2(ke[6], ke[7]); *(LAS v4u*)(KE + ro) = o;
              o.x = pk2(qd[0], qd[1]); o.y = pk2(qd[2], qd[3]); o.z = pk2(qd[4], qd[5]); o.w = pk2(qd[6], qd[7]); *(LAS v4u*)(QD + ro) = o;
              o.x = pk2(kd[0], kd[1]); o.y = pk2(kd[2], kd[3]); o.z = pk2(kd[4], kd[5]); o.w = pk2(kd[6], kd[7]); *(LAS v4u*)(KD + ro) = o;
              *(LAS u32x2*)(VV + tB * VS + c4 * 2) = rv; }
            if (ck + 1 < SEQ / 32) { const size_t adv = (size_t)(ck + 1) * 32 * D;
#pragma unroll
                for (int i = 0; i < 8; ++i) fa[i] = *(const GAS float*)(fA + adv + (size_t)i * D);
                rq = *(const GAS v4u*)(qB + adv); rf0 = *(const GAS f32x4*)(fB + adv); rf1 = *(const GAS f32x4*)(fB + adv + 4); rv = *(const GAS u32x2*)(vB + adv); }
            __syncthreads();
            { f32x16 sc;
#pragma unroll
              for (int r = 0; r < 16; ++r) sc[r] = 0.f;
#pragma unroll
              for (int m = 0; m < 2; ++m) { const bf16x8 ka = *(const LAS bf16x8*)(KE + rowfrag + m * 32), qb = *(const LAS bf16x8*)(QE + rowfrag + m * 32);
                  sc = __builtin_amdgcn_mfma_f32_32x32x16_bf16(ka, qb, sc, 0, 0, 0); }
              unsigned pw[8];
#pragma unroll
              for (int i = 0; i < 8; ++i) { const int r0_ = 2 * i, r1_ = 2 * i + 1; const int s0_ = (r0_ & 3) + 8 * (r0_ >> 2) + 4 * hi, s1_ = (r1_ & 3) + 8 * (r1_ >> 2) + 4 * hi;
                  pw[i] = pk2(s0_ <= c ? sc[r0_] : 0.f, s1_ <= c ? sc[r1_] : 0.f); }
              f32x16 o;
#pragma unroll
              for (int r = 0; r < 16; ++r) o[r] = 0.f;
#pragma unroll
              for (int m = 0; m < 2; ++m) {
                  v4u pa; pa.x = pw[4 * m]; pa.y = pw[4 * m + 1]; pa.z = pw[4 * m + 2]; pa.w = pw[4 * m + 3];
                  const s16x4v v0 = __builtin_bit_cast(s16x4v, __builtin_amdgcn_ds_read_tr16_b64_v4i16((LAS s16x4v*)(VV + trvp + m * 16 * VS)));
                  const s16x4v v1 = __builtin_bit_cast(s16x4v, __builtin_amdgcn_ds_read_tr16_b64_v4i16((LAS s16x4v*)(VV + trvp + m * 16 * VS + 8 * VS)));
                  o = __builtin_amdgcn_mfma_f32_32x32x16_bf16(__builtin_bit_cast(bf16x8, pa), (bf16x8){v0[0], v0[1], v0[2], v0[3], v1[0], v1[1], v1[2], v1[3]}, o, 0, 0, 0); }
#pragma unroll
              for (int m = 0; m < 2; ++m) {
                  const u32x2 qa0 = *(const LAS u32x2*)(QD + qdfrag + m * 32), qa1 = *(const LAS u32x2*)(QD + qdfrag + m * 32 + 16);
                  v4u qa; qa.x = qa0.x; qa.y = qa0.y; qa.z = qa1.x; qa.w = qa1.y;
                  v4u sb; sb.x = pk2(S[8 * m + 0], S[8 * m + 1]); sb.y = pk2(S[8 * m + 2], S[8 * m + 3]); sb.z = pk2(S[8 * m + 4], S[8 * m + 5]); sb.w = pk2(S[8 * m + 6], S[8 * m + 7]);
                  o = __builtin_amdgcn_mfma_f32_32x32x16_bf16(__builtin_bit_cast(bf16x8, qa), __builtin_bit_cast(bf16x8, sb), o, 0, 0, 0); }
#pragma unroll
              for (int a4 = 0; a4 < 4; ++a4) { const f32x4 ev = *(const LAS f32x4*)(EEND + 32 * dt + 8 * a4 + 4 * hi);
                  S[4 * a4 + 0] *= ev[0]; S[4 * a4 + 1] *= ev[1]; S[4 * a4 + 2] *= ev[2]; S[4 * a4 + 3] *= ev[3]; }
#pragma unroll
              for (int m = 0; m < 2; ++m) {
                  const s16x4v k0 = __builtin_bit_cast(s16x4v, __builtin_amdgcn_ds_read_tr16_b64_v4i16((LAS s16x4v*)(KD + trk + m * 16 * RS)));
                  const s16x4v k1 = __builtin_bit_cast(s16x4v, __builtin_amdgcn_ds_read_tr16_b64_v4i16((LAS s16x4v*)(KD + trk + m * 16 * RS + 4 * RS)));
                  const s16x4v v0 = __builtin_bit_cast(s16x4v, __builtin_amdgcn_ds_read_tr16_b64_v4i16((LAS s16x4v*)(VV + trv + m * 16 * VS)));
                  const s16x4v v1 = __builtin_bit_cast(s16x4v, __builtin_amdgcn_ds_read_tr16_b64_v4i16((LAS s16x4v*)(VV + trv + m * 16 * VS + 4 * VS)));
                  S = __builtin_amdgcn_mfma_f32_32x32x16_bf16((bf16x8){k0[0], k0[1], k0[2], k0[3], k1[0], k1[1], k1[2], k1[3]}, (bf16x8){v0[0], v0[1], v0[2], v0[3], v1[0], v1[1], v1[2], v1[3]}, S, 0, 0, 0); }
#pragma unroll
              for (int r = 0; r < 16; ++r) OP[(w * 32 + ((r & 3) + 8 * (r >> 2) + 4 * hi)) * 32 + c] = o[r];
            }
            __syncthreads();
#pragma unroll
            for (int i = 0; i < 4; ++i) { const int idx = tid + 512 * i, t = idx >> 6, v = idx & 63, vt_ = v >> 5, vl = v & 31;
                const float s = (OP[((0 * 2 + vt_) * 32 + t) * 32 + vl] + OP[((1 * 2 + vt_) * 32 + t) * 32 + vl]) + (OP[((2 * 2 + vt_) * 32 + t) * 32 + vl] + OP[((3 * 2 + vt_) * 32 + t) * 32 + vl]);
                O[(row0 + (size_t)ck * 32 + t) * D + h * 128 + half * 64 + v] = s; }
        }
        __syncthreads();
    }
}

#ifndef HG_O_NT
#define HG_O_NT 0
#endif
__device__ __forceinline__ void hgrn4_phase(Frame& F, const bf16* Q, const void* Fgv, const bf16* I, bf16* OPART) {
#if HG_KBF
    const bf16* Fg = (const bf16*)Fgv;
#else
    const float* Fg = (const float*)Fgv;
#endif
    constexpr int RS = 144, VS = 272;
#define HG_BAR() asm volatile("s_waitcnt lgkmcnt(0)\n\ts_barrier" ::: "memory")
    LAS unsigned char* L = F.lds + RING_OFF;
    LAS float* TOT = (LAS float*)L;
    LAS float* CUM = (LAS float*)(L + 2048);
    LAS unsigned char* QE = L + 10240; LAS unsigned char* KE = QE + 4608; LAS unsigned char* QD = KE + 4608; LAS unsigned char* KD = QD + 4608;
    LAS unsigned char* VV = L + 28672;
    LAS float* EREF = (LAS float*)(L + 37376); LAS float* EER = EREF + 64; LAS float* EEND = EER + 64; LAS float* REF = EEND + 64;
    LAS float* OP = (LAS float*)(L + 38400);
    const int tid = F.tid, lane = F.lane, w = F.wave, dt = w >> 2, vt = w & 3;
    const int dA = tid & 63, oct = tid >> 6, tB = tid >> 4, d4 = (tid & 15) * 4, v8 = (tid & 15) * 8;
    const int c = lane & 31, hi = lane >> 5, g = lane >> 4, q_ = (lane & 15) >> 2, p_ = lane & 3;
    const int rowfrag = c * RS + (32 * dt + 8 * hi) * 2, qdfrag = c * RS + (32 * dt + 4 * hi) * 2;
    const int trk = (8 * hi + q_) * RS + (32 * dt + 16 * (g & 1) + 4 * p_) * 2;
    const int trv = (8 * hi + q_) * VS + (32 * vt + 16 * (g & 1) + 4 * p_) * 2, trvp = (4 * hi + q_) * VS + (32 * vt + 16 * (g & 1) + 4 * p_) * 2;
    for (int u = blockIdx.x; u < BATCH * NH_HG * 2; u += F.G) {
        const int b = u >> 4, h = (u >> 1) & 7, dh = u & 1; const size_t row0 = (size_t)b * SEQ;
        f32x16 S;
#pragma unroll
        for (int r = 0; r < 16; ++r) S[r] = 0.f;
        const auto* fA = Fg + (row0 + 4 * oct) * D + h * 128 + 64 * dh + dA;
        const bf16* qB = Q + (row0 + tB) * D + h * 128 + 64 * dh + d4; const auto* fB = Fg + (row0 + tB) * D + h * 128 + 64 * dh + d4; const bf16* vB = I + (row0 + tB) * D + h * 128 + v8;
        bf16* oB = OPART + (size_t)dh * M * D + (row0 + tB) * D + h * 128 + v8;
#if HG_KBF
#define HG_FA_T unsigned short
#define HG_LDFA(p_) (*(const GAS unsigned short*)(p_))
#define HG_F_OF(x_) (1.0f - __uint_as_float((unsigned)(x_) << 16))
#define HG_RF_T u32x2
#define HG_LDFB(p_) (*(const GAS u32x2*)(p_))
#define HG_KV(e_) ((e_) == 0 ? bf_lo(rf.x) : (e_) == 1 ? bf_hi(rf.x) : (e_) == 2 ? bf_lo(rf.y) : bf_hi(rf.y))
#else
#define HG_FA_T float
#define HG_LDFA(p_) __builtin_nontemporal_load((const GAS float*)(p_))
#define HG_F_OF(x_) (x_)
#define HG_RF_T f32x4
#define HG_LDFB(p_) __builtin_nontemporal_load((const GAS f32x4*)(p_))
#define HG_KV(e_) (1.0f - rf[e_])
#endif
        HG_FA_T fa[4];
#pragma unroll
        for (int i = 0; i < 4; ++i) fa[i] = HG_LDFA(fA + (size_t)i * D);
        u32x2 rq = __builtin_nontemporal_load((const GAS u32x2*)qB); HG_RF_T rf = HG_LDFB(fB); v4u rv = __builtin_nontemporal_load((const GAS v4u*)vB);
        for (int ck = 0; ck < SEQ / 32; ++ck) {
            float cl[4]; { float run = 0.f;
#pragma unroll
                for (int i = 0; i < 4; ++i) { run += __builtin_amdgcn_logf(HG_F_OF(fa[i])); cl[i] = run; }
                TOT[oct * 64 + dA] = run; }
            HG_BAR();
            { float T[8];
#pragma unroll
              for (int k = 0; k < 8; ++k) T[k] = TOT[k * 64 + dA];
              float off = 0.f;
#pragma unroll
              for (int k = 0; k < 7; ++k) off += (oct > k) ? T[k] : 0.f;
#pragma unroll
              for (int i = 0; i < 4; ++i) CUM[(4 * oct + i) * 64 + dA] = off + cl[i];
              const float ref = (T[0] + T[1]) + (T[2] + T[3]), end = ref + ((T[4] + T[5]) + (T[6] + T[7]));
              if (oct == 0) EREF[dA] = __builtin_amdgcn_exp2f(ref); else if (oct == 1) EER[dA] = __builtin_amdgcn_exp2f(end - ref); else if (oct == 2) EEND[dA] = __builtin_amdgcn_exp2f(end); else if (oct == 3) REF[dA] = ref; }
            HG_BAR();
            { const f32x4 cu = *(const LAS f32x4*)(CUM + tB * 64 + d4), r4 = *(const LAS f32x4*)(REF + d4), er = *(const LAS f32x4*)(EREF + d4), ee = *(const LAS f32x4*)(EER + d4);
              const float qv[4] = {bf_lo(rq.x), bf_hi(rq.x), bf_lo(rq.y), bf_hi(rq.y)};
              float qe[4], ke[4], qd[4], kd[4];
#pragma unroll
              for (int e = 0; e < 4; ++e) { const float a = __builtin_amdgcn_exp2f(cu[e] - r4[e]), ai = __builtin_amdgcn_rcpf(a), kv = HG_KV(e);
                  qe[e] = qv[e] * a; ke[e] = kv * ai; qd[e] = qe[e] * er[e]; kd[e] = ke[e] * ee[e]; }
              u32x2 o; const int ro = tB * RS + d4 * 2;
              o.x = pk2(qe[0], qe[1]); o.y = pk2(qe[2], qe[3]); *(LAS u32x2*)(QE + ro) = o;
              o.x = pk2(ke[0], ke[1]); o.y = pk2(ke[2], ke[3]); *(LAS u32x2*)(KE + ro) = o;
              o.x = pk2(qd[0], qd[1]); o.y = pk2(qd[2], qd[3]); *(LAS u32x2*)(QD + ro) = o;
              o.x = pk2(kd[0], kd[1]); o.y = pk2(kd[2], kd[3]); *(LAS u32x2*)(KD + ro) = o;
              *(LAS v4u*)(VV + tB * VS + v8 * 2) = rv; }
            if (ck + 1 < SEQ / 32) { const size_t adv = (size_t)(ck + 1) * 32 * D;
#pragma unroll
                for (int i = 0; i < 4; ++i) fa[i] = HG_LDFA(fA + adv + (size_t)i * D);
                rq = __builtin_nontemporal_load((const GAS u32x2*)(qB + adv)); rf = HG_LDFB(fB + adv); rv = __builtin_nontemporal_load((const GAS v4u*)(vB + adv)); }
            HG_BAR();
            { f32x16 sc;
#pragma unroll
              for (int r = 0; r < 16; ++r) sc[r] = 0.f;
#pragma unroll
              for (int m = 0; m < 2; ++m) { const bf16x8 ka = *(const LAS bf16x8*)(KE + rowfrag + m * 32), qb = *(const LAS bf16x8*)(QE + rowfrag + m * 32);
                  sc = __builtin_amdgcn_mfma_f32_32x32x16_bf16(ka, qb, sc, 0, 0, 0); }
              unsigned pw[8];
#pragma unroll
              for (int i = 0; i < 8; ++i) { const int r0_ = 2 * i, r1_ = 2 * i + 1; const int s0_ = (r0_ & 3) + 8 * (r0_ >> 2) + 4 * hi, s1_ = (r1_ & 3) + 8 * (r1_ >> 2) + 4 * hi;
                  pw[i] = pk2(s0_ <= c ? sc[r0_] : 0.f, s1_ <= c ? sc[r1_] : 0.f); }
              f32x16 o;
#pragma unroll
              for (int r = 0; r < 16; ++r) o[r] = 0.f;
#pragma unroll
              for (int m = 0; m < 2; ++m) {
                  v4u pa; pa.x = pw[4 * m]; pa.y = pw[4 * m + 1]; pa.z = pw[4 * m + 2]; pa.w = pw[4 * m + 3];
                  const s16x4v v0 = __builtin_bit_cast(s16x4v, __builtin_amdgcn_ds_read_tr16_b64_v4i16((LAS s16x4v*)(VV + trvp + m * 16 * VS)));
                  const s16x4v v1 = __builtin_bit_cast(s16x4v, __builtin_amdgcn_ds_read_tr16_b64_v4i16((LAS s16x4v*)(VV + trvp + m * 16 * VS + 8 * VS)));
                  o = __builtin_amdgcn_mfma_f32_32x32x16_bf16(__builtin_bit_cast(bf16x8, pa), (bf16x8){v0[0], v0[1], v0[2], v0[3], v1[0], v1[1], v1[2], v1[3]}, o, 0, 0, 0); }
#pragma unroll
              for (int m = 0; m < 2; ++m) {
                  const u32x2 qa0 = *(const LAS u32x2*)(QD + qdfrag + m * 32), qa1 = *(const LAS u32x2*)(QD + qdfrag + m * 32 + 16);
                  v4u qa; qa.x = qa0.x; qa.y = qa0.y; qa.z = qa1.x; qa.w = qa1.y;
                  v4u sb; sb.x = pk2(S[8 * m + 0], S[8 * m + 1]); sb.y = pk2(S[8 * m + 2], S[8 * m + 3]); sb.z = pk2(S[8 * m + 4], S[8 * m + 5]); sb.w = pk2(S[8 * m + 6], S[8 * m + 7]);
                  o = __builtin_amdgcn_mfma_f32_32x32x16_bf16(__builtin_bit_cast(bf16x8, qa), __builtin_bit_cast(bf16x8, sb), o, 0, 0, 0); }
#pragma unroll
              for (int a4 = 0; a4 < 4; ++a4) { const f32x4 ev = *(const LAS f32x4*)(EEND + 32 * dt + 8 * a4 + 4 * hi);
                  S[4 * a4 + 0] *= ev[0]; S[4 * a4 + 1] *= ev[1]; S[4 * a4 + 2] *= ev[2]; S[4 * a4 + 3] *= ev[3]; }
#pragma unroll
              for (int m = 0; m < 2; ++m) {
                  const s16x4v k0 = __builtin_bit_cast(s16x4v, __builtin_amdgcn_ds_read_tr16_b64_v4i16((LAS s16x4v*)(KD + trk + m * 16 * RS)));
                  const s16x4v k1 = __builtin_bit_cast(s16x4v, __builtin_amdgcn_ds_read_tr16_b64_v4i16((LAS s16x4v*)(KD + trk + m * 16 * RS + 4 * RS)));
                  const s16x4v v0 = __builtin_bit_cast(s16x4v, __builtin_amdgcn_ds_read_tr16_b64_v4i16((LAS s16x4v*)(VV + trv + m * 16 * VS)));
                  const s16x4v v1 = __builtin_bit_cast(s16x4v, __builtin_amdgcn_ds_read_tr16_b64_v4i16((LAS s16x4v*)(VV + trv + m * 16 * VS + 4 * VS)));
                  S = __builtin_amdgcn_mfma_f32_32x32x16_bf16((bf16x8){k0[0], k0[1], k0[2], k0[3], k1[0], k1[1], k1[2], k1[3]}, (bf16x8){v0[0], v0[1], v0[2], v0[3], v1[0], v1[1], v1[2], v1[3]}, S, 0, 0, 0); }
#pragma unroll
              for (int r = 0; r < 16; ++r) OP[(w * 32 + ((r & 3) + 8 * (r >> 2) + 4 * hi)) * 32 + c] = o[r];
            }
            HG_BAR();
            { const int vt5 = v8 >> 5, c5 = v8 & 31; const LAS float* p0 = OP + ((0 * 4 + vt5) * 32 + tB) * 32 + c5; const LAS float* p1 = OP + ((1 * 4 + vt5) * 32 + tB) * 32 + c5;
              const f32x4 a0 = *(const LAS f32x4*)p0 + *(const LAS f32x4*)p1, a1 = *(const LAS f32x4*)(p0 + 4) + *(const LAS f32x4*)(p1 + 4);
              v4u ov; ov.x = pk2(a0[0], a0[1]); ov.y = pk2(a0[2], a0[3]); ov.z = pk2(a1[0], a1[1]); ov.w = pk2(a1[2], a1[3]);
              if (HG_O_NT) __builtin_nontemporal_store(ov, (GAS v4u*)(oB + (size_t)ck * 32 * D)); else *(GAS v4u*)(oB + (size_t)ck * 32 * D) = ov; }
        }
        __syncthreads();
    }
#undef HG_BAR
}
__device__ __forceinline__ void hgate2_phase(Frame& F, const bf16* OPART, const bf16* SG, const float* ng, bf16* H) {
    const int gw = F.vcu * NWAVES + F.wave, NGW = F.G * NWAVES;
    const f32x4 g4 = *(const f32x4*)(ng + ((4 * F.lane) & 127));
    for (int m0 = gw; m0 < M; m0 += 2 * NGW) {
        u32x2 o0[2][4], o1[2][4], gv[2][4];
#pragma unroll
        for (int k = 0; k < 2; ++k) { const int m = m0 + k * NGW; if (m < M) {
#pragma unroll
            for (int j = 0; j < 4; ++j) { const int cc = 256 * j + 4 * F.lane; o0[k][j] = __builtin_nontemporal_load((const GAS u32x2*)(OPART + (size_t)m * D + cc)); o1[k][j] = __builtin_nontemporal_load((const GAS u32x2*)(OPART + (size_t)M * D + (size_t)m * D + cc)); gv[k][j] = __builtin_nontemporal_load((const GAS u32x2*)(SG + (size_t)m * D + cc)); } } }
#pragma unroll
        for (int k = 0; k < 2; ++k) { const int m = m0 + k * NGW; if (m < M) {
#pragma unroll
            for (int j = 0; j < 4; ++j) { const int cc = 256 * j + 4 * F.lane; const u32x2 gw2 = gv[k][j];
                f32x4 o; o[0] = bf_lo(o0[k][j].x) + bf_lo(o1[k][j].x); o[1] = bf_hi(o0[k][j].x) + bf_hi(o1[k][j].x); o[2] = bf_lo(o0[k][j].y) + bf_lo(o1[k][j].y); o[3] = bf_hi(o0[k][j].y) + bf_hi(o1[k][j].y);
                float q = (o[0] * o[0] + o[1] * o[1]) + (o[2] * o[2] + o[3] * o[3]);
#pragma unroll
                for (int s2 = 1; s2 < 32; s2 <<= 1) q += shx(q, s2, F.lane);
                const float rs = 1.0f / sqrtf(q * (1.0f / 128.0f) + RMS_EPS);
                f32x4 r; r[0] = o[0] * rs * g4[0] * bf_lo(gw2.x); r[1] = o[1] * rs * g4[1] * bf_hi(gw2.x); r[2] = o[2] * rs * g4[2] * bf_lo(gw2.y); r[3] = o[3] * rs * g4[3] * bf_hi(gw2.y);
                u32x2 wv; wv.x = pk2(r[0], r[1]); wv.y = pk2(r[2], r[3]); if (H_ST_NT) __builtin_nontemporal_store(wv, (GAS u32x2*)(H + (size_t)m * D + cc)); else *(GAS u32x2*)(H + (size_t)m * D + cc) = wv; } } }
    }
}

#ifndef PHMASK
#define PHMASK 0x3ffffff
#endif
#define ON(i) (((PHMASK) >> (i)) & 1)
#ifndef DUPMASK
#define DUPMASK 0
#endif
#define DUP(i) (((DUPMASK) >> (i)) & 1)
#define RUN(i, ...) do { if constexpr (ON(i)) { __VA_ARGS__; if constexpr (DUP(i)) { __syncthreads(); __VA_ARGS__; } } } while (0)
struct Args { const float* in[19]; float* out; unsigned char* ws; int ph_lo, ph_hi, one, pad; };
__global__ void __launch_bounds__(NWAVES * 64, 2) trunk_fwd(Args args) {
    extern __shared__ __attribute__((aligned(16))) unsigned char lds[];
    Frame F;
    F.lds = (LAS unsigned char*)lds;
    F.MISC = (volatile LAS unsigned*)(F.lds + MISC_OFF);
    F.tid = threadIdx.x; F.lane = F.tid & 63; F.wave = __builtin_amdgcn_readfirstlane(F.tid >> 6);
    F.G = gridDim.x; { const int bx = blockIdx.x; F.vcu = (F.G % 8 == 0) ? (bx % 8) * (F.G / 8) + bx / 8 : bx; }
    unsigned char* ws = args.ws;
    F.ctl = (gu32*)(ws + WS_CTL);
    for (int u = F.tid; u < (LDS_BYTES - LDSCTL_OFF) / 4; u += NWAVES * 64) ((LAS unsigned*)(F.lds + LDSCTL_OFF))[u] = 0u;
    __syncthreads();
    const bool one = args.one != 0;
    XcdBarrier bar; bar.bar = (unsigned*)(F.ctl + CW_BAR); bar.x = 0; bar.st = nullptr;
    if (one) bar = xcd_barrier_post((unsigned*)(F.ctl + CW_BAR), F.MISC + 8);
    const int lo = args.ph_lo, hi = args.ph_hi;
#define IN(k) (lo <= (k) && (k) < hi)
#ifndef HGRN
#define HGRN hgrn2_phase
#endif
#ifndef SBATTN
#define SBATTN sbattn2_phase
#endif
#define ENTER() do { int t_ = threadIdx.x; asm volatile("" : "+v"(t_)); F.tid = t_; F.lane = t_ & 63; F.wave = __builtin_amdgcn_readfirstlane(t_ >> 6); asm volatile("" : "+s"(ws)); } while (0)
#define SEAM(k) do { if (IN((k) + 1)) xcd_barrier(bar); } while (0)
#define FUSED_LN_GEMM(KIND, Aptr, Bptr, Kdim, XIN, GATE, GAM, BET, NSC, NSH, BANK, CODE) do { \
        const unsigned poison_ = (__hip_atomic_load((gu32*)(ws + WS_CTL) + CW_TMO, RLX_AGENT) != 0u) ? 1u : 0u; \
        pg8::Gemm g{Aptr, Bptr, M, D, Kdim, 0}; pg8::StaticOrder S0; S0.init(M, D, F.G, (int)blockIdx.x); \
        pg8::PanelStats st{(unsigned*)(ws + WS_XB + (size_t)(BANK) * 2 * MiB), (unsigned*)(ws + WS_CTL) + CW_SEAM + (BANK) * SEAM_BANK, (unsigned*)(ws + WS_CTL) + CW_TMO, 4, LN_EPS, (unsigned)(CODE)}; \
        pg8::EpiLnMod E{XIN, xres, Hb, GATE, GAM, BET, NSC, NSH, st, poison_}; \
        for (int sl = 0; sl < (M / 256) * (D / 256) / 256; ++sl) { pg8::SliceOrder S{S0, sl}; \
            RUN(KIND, pg8::gemm_phase<pg8::EpiLnMod, pg8::SliceOrder, false, PG8_SP2>(F.lds + RING_OFF, g, S, E)); __syncthreads(); } } while (0)
#ifndef CONV_EARLY
#define CONV_EARLY 0
#endif
#define CONV_EARLY_K 15
#ifdef FUSE_LN
#define FUSE_LN_GUARD FUSE_LN
#else
#define FUSE_LN_GUARD 0
#endif
#ifndef SWIGLU_DEFER
#define SWIGLU_DEFER 0
#endif
#ifndef WIDE_ST
#define WIDE_ST 1
#endif
#if WIDE_ST
#define EPI_Y pg8::EpiBf16W
#define EPI_Y_NB
#else
#define EPI_Y pg8::EpiBf16<0>
#define EPI_Y_NB nullptr,
#endif
#ifndef MOE_TAIL
#define MOE_TAIL 0
#endif
static_assert(!(INTER_PAIR && MOE_TAIL) && !(INTER_PAIR && FUSE_LN_GUARD), "the row-pair interleaved FFN hidden layout is wired into the plain W2 GEMM phases only");
#ifndef MOE_GATHER
#define MOE_GATHER 1
#endif
#ifndef QP_ON
#define QP_ON 0
#endif
#ifndef QP_R0_W13
#define QP_R0_W13 6
#endif
#ifndef WGM_N1024
#define WGM_N1024 8
#endif
#ifndef W2_REV
#define W2_REV 0
#endif
#ifndef FUSE_LN
#define FUSE_LN 0
#endif
#ifndef FUSE_SITES
#define FUSE_SITES 7
#endif
    const bool qp = QP_ON && (F.G == 256);
    const bool fuseok = FUSE_LN && (F.G == 256); const bool fuse0 = fuseok && (FUSE_SITES & 1), fuse1 = fuseok && (FUSE_SITES & 2), fuse2 = fuseok && (FUSE_SITES & 4);
    const float* x_in = args.in[0]; const float* c_in = args.in[1]; const float* ada_w = args.in[2]; const float* ada_b = args.in[3];
    const float* ln1_g = args.in[4]; const float* ln1_b = args.in[5]; const float* ln2_g = args.in[6]; const float* ln2_b = args.in[7];
    const float* sb_w_qkv = args.in[8]; const float* sb_w_o = args.in[9]; const float* hg_w_in = args.in[10]; const float* hg_norm_g = args.in[11]; const float* hg_w_o = args.in[12];
    const float* hg_lb = args.in[13]; const float* ffn_w13 = args.in[14]; const float* ffn_w2 = args.in[15]; const float* moe_router = args.in[16]; const float* moe_w13 = args.in[17]; const float* moe_w2 = args.in[18];
    float* xout_final = args.out;
#ifndef XBF16
#define XBF16 0
#endif
#if XBF16
#define xres ((float*)(ws + WS_XBF))
#else
#define xres xout_final
#endif
#define mod ((float*)(ws + WS_MOD))
#define lbv ((float*)(ws + WS_LB))
#define route ((unsigned*)(ws + WS_ROUTE))
#define wbuf (ws + WS_W)
#define wsb (ws + WS_WSB)
#define Hb ((bf16*)(ws + WS_H))
#define Yb ((bf16*)(ws + WS_Y))

    if (IN(0)) { ENTER(); RUN(0, mod_phase(F, c_in, ada_w, ada_b, hg_lb, mod, lbv)); RUN(1, conv_sb(F, sb_w_qkv, sb_w_o, ffn_w13, ffn_w2, wsb)); SEAM(0); }
    if (IN(1)) { ENTER(); RUN(2, modulate_phase(F, x_in, mod, Hb)); SEAM(1); }

    for (int pair = 0; pair < 2; ++pair) {
        const int pb = 2 + 16 * pair, lS = 2 * pair, lH = 2 * pair + 1;
#define modS (mod + (size_t)lS * BATCH * MODW)
#define modH (mod + (size_t)lH * BATCH * MODW)
        if (IN(pb + 0)) { ENTER();
            pg8::Gemm g{Hb, (const bf16*)(wsb + W_SB_QKV), M, 3 * D, D, 0}; pg8::StaticOrder S; S.init(M, 3 * D, F.G, (int)blockIdx.x);
            EPI_Y E{(bf16*)(ws + B_Q), D, EPI_Y_NB D, (size_t)(B_K - B_Q) / 2, 0.125f};
            RUN(3, pg8::gemm_phase<EPI_Y, pg8::StaticOrder, PG8_ALIGN, PG8_SP2>(F.lds + RING_OFF, g, S, E));
            SEAM(pb + 0); }
        if (IN(pb + 1)) { ENTER(); RUN(4, SBATTN(F, (const bf16*)(ws + B_Q), (const bf16*)(ws + B_K), (const bf16*)(ws + B_V), Hb)); SEAM(pb + 1); }
        if (IN(pb + 2)) { ENTER();
            if (fuse0) { FUSED_LN_GEMM(18, Hb, (const bf16*)(wsb + W_SB_O), D, pair == 0 ? x_in : xres, modS + 2 * D, ln1_g + lS * D, ln1_b + lS * D, modS + 4 * D, modS + 3 * D, pair * 3 + 0, 0x710); }
            else {
            pg8::Gemm g{Hb, (const bf16*)(wsb + W_SB_O), M, D, D, 0}; pg8::StaticOrder S; S.init(M, D, F.G, (int)blockIdx.x, 0, WGM_N1024);
            EPI_Y E{Yb, D, EPI_Y_NB 0, 0, 1.f};
            RUN(5, pg8::gemm_phase<EPI_Y, pg8::StaticOrder, PG8_ALIGN, PG8_SP2>(F.lds + RING_OFF, g, S, E)); }
            SEAM(pb + 2); }
        if (IN(pb + 3) && !fuse0) { ENTER();
            if (qp) {
                gu32* rdy = (gu32*)(ws + WS_CTL) + CW_RDY + (pair * 4 + 0) * RDY_BANK;
                if (pair == 0) { RUN(23, ln_phase<false, false, true, false, false, false, true>(F, x_in, xres, Yb, modS + 2 * D, ln1_g + lS * D, ln1_b + lS * D, modS + 4 * D, modS + 3 * D, Hb, nullptr, nullptr, rdy)); }
                else RUN(24, ln_phase<false, false, true, false, false, false, true>(F, xres, xres, Yb, modS + 2 * D, ln1_g + lS * D, ln1_b + lS * D, modS + 4 * D, modS + 3 * D, Hb, nullptr, nullptr, rdy));
            } else {
            if (pair == 0) { RUN(6, ln_phase<false, false, true, false, false, XBF16 != 0>(F, x_in, xres, Yb, modS + 2 * D, ln1_g + lS * D, ln1_b + lS * D, modS + 4 * D, modS + 3 * D, Hb, nullptr, nullptr, nullptr)); }
            else RUN(22, ln_phase<false, false, true, false, XBF16 != 0, XBF16 != 0>(F, xres, xres, Yb, modS + 2 * D, ln1_g + lS * D, ln1_b + lS * D, modS + 4 * D, modS + 3 * D, Hb, nullptr, nullptr, nullptr));
            SEAM(pb + 3); } }
        if (IN(pb + 4)) { ENTER();
            pg8::Gemm g{Hb, (const bf16*)(wsb + W_SB_13), M, 2 * FF, D, 0};
            pg8::EpiSwiGLU E{(bf16*)(ws + B_INTER), FF};
            if (qp) { pg8::TwoSpeedOrder S; S.init(2 * FF, (int)blockIdx.x, QP_R0_W13, (const unsigned*)(ws + WS_CTL) + CW_RDY + (pair * 4 + 0) * RDY_BANK, 128u, (unsigned*)(ws + WS_CTL) + CW_TMO);
                RUN(25, pg8::gemm_phase<pg8::EpiSwiGLU, pg8::TwoSpeedOrder, PG8_ALIGN, PG8_SP2>(F.lds + RING_OFF, g, S, E)); }
            else { pg8::StaticOrder S; S.init(M, 2 * FF, F.G, (int)blockIdx.x);
#if SWIGLU_DEFER
                pg8::EpiSwiGLUD<SWIGLU_DEFER> ED{(bf16*)(ws + B_INTER), FF, (void*)Yb};
                RUN(7, pg8::gemm_phase<pg8::EpiSwiGLUD<SWIGLU_DEFER>, pg8::StaticOrder, PG8_ALIGN, PG8_SP2>(F.lds + RING_OFF, g, S, ED));
#else
                RUN(7, pg8::gemm_phase<pg8::EpiSwiGLU, pg8::StaticOrder, PG8_ALIGN, PG8_SP2>(F.lds + RING_OFF, g, S, E));
#endif
                }
            SEAM(pb + 4); }
        if (IN(pb + 5)) { ENTER();
            if (fuse1) { FUSED_LN_GEMM(19, (const bf16*)(ws + B_INTER), (const bf16*)(wsb + W_SB_2), FF, xres, modS + 5 * D, ln2_g + lS * D, ln2_b + lS * D, modH + 1 * D, modH + 0 * D, pair * 3 + 1, 0x720); }
            else {
            pg8::Gemm g{(const bf16*)(ws + B_INTER), (const bf16*)(wsb + W_SB_2), M, D, FF, 0, 0, INTER_PAIR}; pg8::StaticOrder S; S.init(M, D, F.G, (int)blockIdx.x, W2_REV, WGM_N1024);
            EPI_Y E{Yb, D, EPI_Y_NB 0, 0, 1.f};
            RUN(8, pg8::gemm_phase<EPI_Y, pg8::StaticOrder, PG8_ALIGN, PG8_SP2>(F.lds + RING_OFF, g, S, E)); }
            SEAM(pb + 5); }
        if (IN(pb + 6)) { ENTER();
            if (!fuse1) { RUN(22, ln_phase<false, false, true, false, XBF16 != 0, XBF16 != 0>(F, xres, xres, Yb, modS + 5 * D, ln2_g + lS * D, ln2_b + lS * D, modH + 1 * D, modH + 0 * D, Hb, nullptr, nullptr, nullptr)); }
            { const ConvHg J{hg_w_in + (size_t)pair * D * 4 * D, hg_w_o + (size_t)pair * D * D, moe_w13 + (size_t)pair * NEXP * D * 2 * FF, moe_w2 + (size_t)pair * NEXP * FF * D, wbuf};
              int k0c = 0;
#if CONV_EARLY
              if (pair == 1 && one && F.G == 256) { unsigned c0[8];
#pragma unroll
                  for (int e = 0; e < 8; ++e) c0[e] = (unsigned)__builtin_amdgcn_readfirstlane(__hip_atomic_load((gu32*)(ws + WS_CTL) + CW_CNT + 64 * e, RLX_AGENT));
                  pg8::GroupedOrder S0; S0.init(c0, D, F.G, (int)blockIdx.x); pg8::Unit ut;
                  if ((S0.nwg % F.G) != 0 && !S0.next(S0.nwg / F.G, ut)) k0c = CONV_EARLY_K; }
#endif
              RUN(9, conv_hg_items(F, J, (LAS float*)(F.lds + RING_OFF + F.wave * 16384), k0c, (45568 + F.G * NWAVES - 1) / (F.G * NWAVES))); }
            SEAM(pb + 6); }
#define cnt ((gu32*)(ws + WS_CTL) + CW_CNT + pair * 8 * 64)
        if (IN(pb + 7)) { ENTER();
            pg8::Gemm g{Hb, (const bf16*)(wbuf + W_HG_IN), M, 4 * D, D, 0}; pg8::StaticOrder S; S.init(M, 4 * D, F.G, (int)blockIdx.x);
            static_assert(B_HF - B_HQ == pg8::EpiHgIn::OFF_F && B_HI - B_HQ == pg8::EpiHgIn::OFF_I && B_HGT - B_HQ == pg8::EpiHgIn::OFF_G, "EpiHgIn offsets");
            pg8::EpiHgIn E{ws + B_HQ, lbv + pair * D};
            RUN(10, pg8::gemm_phase<pg8::EpiHgIn, pg8::StaticOrder, PG8_ALIGN, PG8_SP2>(F.lds + RING_OFF, g, S, E));
            SEAM(pb + 7); }
        if (IN(pb + 8)) { ENTER(); RUN(11, hgrn4_phase(F, (const bf16*)(ws + B_HQ), (const void*)(ws + B_HF), (const bf16*)(ws + B_HI), (bf16*)(ws + B_HO))); SEAM(pb + 8); }
        if (IN(pb + 9)) { ENTER(); RUN(12, hgate2_phase(F, (const bf16*)(ws + B_HO), (const bf16*)(ws + B_HGT), hg_norm_g + pair * 128, Hb)); SEAM(pb + 9); }
        if (IN(pb + 10)) { ENTER();
            if (fuse2) { FUSED_LN_GEMM(20, Hb, (const bf16*)(wbuf + W_HG_O), D, xres, modH + 2 * D, ln1_g + lH * D, ln1_b + lH * D, modH + 4 * D, modH + 3 * D, pair * 3 + 2, 0x730); }
            else {
            pg8::Gemm g{Hb, (const bf16*)(wbuf + W_HG_O), M, D, D, 0}; pg8::StaticOrder S; S.init(M, D, F.G, (int)blockIdx.x, 0, WGM_N1024);
            EPI_Y E{Yb, D, EPI_Y_NB 0, 0, 1.f};
            RUN(5, pg8::gemm_phase<EPI_Y, pg8::StaticOrder, PG8_ALIGN, PG8_SP2>(F.lds + RING_OFF, g, S, E)); }
            SEAM(pb + 10); }
        if (IN(pb + 11)) { ENTER();
            if (fuse2) { RUN(21, ln_phase<false, true, true, true>(F, xres, xres, Yb, modH + 2 * D, ln1_g + lH * D, ln1_b + lH * D, modH + 4 * D, modH + 3 * D, Hb, moe_router + (size_t)pair * D * NEXP, route, cnt, MOE_GATHER ? (unsigned*)(ws + WS_XB) : nullptr)); }
            else { RUN(13, ln_phase<false, true, true, false, XBF16 != 0, XBF16 != 0>(F, xres, xres, Yb, modH + 2 * D, ln1_g + lH * D, ln1_b + lH * D, modH + 4 * D, modH + 3 * D, Hb, moe_router + (size_t)pair * D * NEXP, route, cnt, MOE_GATHER ? (unsigned*)(ws + WS_XB) : nullptr)); }
            SEAM(pb + 11); }
#if !MOE_GATHER
        if (IN(pb + 12)) { ENTER(); RUN(14, permute_phase(F, Hb, route, cnt, (bf16*)(ws + B_HS))); SEAM(pb + 12); }
#endif
        if (IN(pb + 13)) { ENTER();
            unsigned cv[8];
#pragma unroll
            for (int e = 0; e < 8; ++e) cv[e] = (unsigned)__builtin_amdgcn_readfirstlane(__hip_atomic_load(cnt + 64 * e, RLX_AGENT));
            pg8::EpiSwiGLU E{(bf16*)(ws + B_MINTER), FF};
#if MOE_GATHER
            pg8::Gemm g{Hb, (const bf16*)(wbuf + W_HG_13), M, 2 * FF, D, (size_t)2 * FF * D * 2}; pg8::GatherOrder S; S.init(cv, 2 * FF, F.G, (int)blockIdx.x); S.tab = (const unsigned*)(ws + WS_XB); S.tab_stride = M;
            RUN(15, pg8::gemm_phase<pg8::EpiSwiGLU, pg8::GatherOrder, PG8_ALIGN, PG8_SP2>(F.lds + RING_OFF, g, S, E));
#else
            pg8::Gemm g{(const bf16*)(ws + B_HS), (const bf16*)(wbuf + W_HG_13), MPAD, 2 * FF, D, (size_t)2 * FF * D * 2}; pg8::GroupedOrder S; S.init(cv, 2 * FF, F.G, (int)blockIdx.x);
            RUN(15, pg8::gemm_phase<pg8::EpiSwiGLU, pg8::GroupedOrder, PG8_ALIGN, PG8_SP2>(F.lds + RING_OFF, g, S, E));
#endif
            SEAM(pb + 13); }
        if (IN(pb + 14)) { ENTER();
            unsigned cv[8];
#pragma unroll
            for (int e = 0; e < 8; ++e) cv[e] = (unsigned)__builtin_amdgcn_readfirstlane(__hip_atomic_load(cnt + 64 * e, RLX_AGENT));
            pg8::Gemm g{(const bf16*)(ws + B_MINTER), (const bf16*)(wbuf + W_HG_2), MPAD, D, FF, (size_t)D * FF * 2, 0, INTER_PAIR && !MOE_TAIL}; pg8::GroupedOrder S; S.init(cv, D, F.G, (int)blockIdx.x);
            EPI_Y E{(bf16*)(ws + B_YS), D, EPI_Y_NB 0, 0, 1.f};
#if MOE_TAIL
            const int t_first = (S.nwg / F.G) * F.G, t_n = S.nwg - t_first;
            const int t_ks = (t_n * 7 <= F.G) ? 7 : (t_n * 4 <= F.G) ? 4 : (t_n * 2 <= F.G) ? 2 : 1;
            const bool t_split = one && t_n > 0 && t_ks > 1;
            if (t_split) S.lim = t_first;
#endif
            RUN(16, pg8::gemm_phase<EPI_Y, pg8::GroupedOrder, PG8_ALIGN, PG8_SP2>(F.lds + RING_OFF, g, S, E));
#if MOE_TAIL
            if (t_split) { __syncthreads();
                pg8::TailOrder T{S, t_first, t_n, t_ks, FF / t_ks, (int)blockIdx.x};
                pg8::Gemm gt{(const bf16*)(ws + B_MINTER), (const bf16*)(wbuf + W_HG_2), MPAD, D, FF / t_ks, (size_t)D * FF * 2, FF};
                pg8::EpiBf16<0> Et{Hb, 256, nullptr, 0, 0, 1.f};
                RUN(16, pg8::gemm_phase<pg8::EpiBf16<0>, pg8::TailOrder, PG8_ALIGN, PG8_SP2>(F.lds + RING_OFF, gt, T, Et));
                xcd_barrier(bar);
                RUN(16, moe_tail_reduce(F, S, t_first, t_n, t_ks, Hb, (bf16*)(ws + B_YS))); }
#endif
#if CONV_EARLY
            if (pair == 0 && one && F.G == 256) { pg8::Unit ut;
                if ((S.nwg % F.G) != 0 && !S.next(S.nwg / F.G, ut)) { __syncthreads();
                    const ConvHg J1{hg_w_in + (size_t)1 * D * 4 * D, hg_w_o + (size_t)1 * D * D, moe_w13 + (size_t)1 * NEXP * D * 2 * FF, moe_w2 + (size_t)1 * NEXP * FF * D, wbuf};
                    RUN(9, conv_hg_items(F, J1, (LAS float*)(F.lds + RING_OFF + F.wave * 16384), 0, CONV_EARLY_K)); } }
#endif
            SEAM(pb + 14); }
        if (IN(pb + 15)) { ENTER();
            if (pair == 0) {
                const float* modN = mod + (size_t)(lH + 1) * BATCH * MODW;
                RUN(17, ln_phase<true, false, true, false, XBF16 != 0, XBF16 != 0>(F, xres, xres, (const bf16*)(ws + B_YS), modH + 5 * D, ln2_g + lH * D, ln2_b + lH * D, modN + 1 * D, modN + 0 * D, Hb, nullptr, route, cnt));
                RUN(1, conv_sb(F, sb_w_qkv + (size_t)D * 3 * D, sb_w_o + (size_t)D * D, ffn_w13 + (size_t)D * 2 * FF, ffn_w2 + (size_t)FF * D, wsb));
                SEAM(pb + 15);
            } else {
                RUN(17, ln_phase<true, false, false, false, XBF16 != 0, false>(F, xres, xout_final, (const bf16*)(ws + B_YS), modH + 5 * D, ln2_g + lH * D, ln2_b + lH * D, nullptr, nullptr, nullptr, nullptr, route, cnt));
            } }
    }
#undef IN
#undef SEAM
#undef FUSED_LN_GEMM
#undef mod
#undef lbv
#undef route
#undef wbuf
#undef xres
#undef wsb
#undef Hb
#undef Yb
#undef modS
#undef modH
#undef cnt
}

extern "C" void kernel_launch(void* const* d_in, const int* in_sizes, int n_in, void* d_out, int out_size, void* d_ws, size_t ws_size, hipStream_t stream) {
    static int grid = 0;
    if (grid == 0) {
        if (n_in != 19 || in_sizes[0] != M * D || out_size != M * D || ws_size < WS_END) { fprintf(stderr, "kernel_launch: unexpected shapes (n_in %d, in0 %d, out %d, ws %zu < %zu)\n", n_in, n_in > 0 ? in_sizes[0] : -1, out_size, ws_size, (size_t)WS_END); grid = -1; return; }
        int dev = 0, cus = 0, per_cu = 0;
        if (hipGetDevice(&dev) != hipSuccess || hipDeviceGetAttribute(&cus, hipDeviceAttributeMultiprocessorCount, dev) != hipSuccess) { grid = -1; return; }
        if (hipFuncSetAttribute((const void*)trunk_fwd, hipFuncAttributeMaxDynamicSharedMemorySize, LDS_BYTES) != hipSuccess) { fprintf(stderr, "kernel_launch: hipFuncSetAttribute failed\n"); grid = -1; return; }
        if (hipOccupancyMaxActiveBlocksPerMultiprocessor(&per_cu, (const void*)trunk_fwd, NWAVES * 64, LDS_BYTES) != hipSuccess || per_cu < 1) fprintf(stderr, "kernel_launch: note: occupancy query reports %d\n", per_cu);
        (void)hipGetLastError();
        grid = cus;
    }
    if (grid < 0) return;
    if (hipMemsetAsync((char*)d_ws + WS_CTL, 0, CTL_ZERO_BYTES, stream) != hipSuccess) return;
    Args a{};
    for (int i = 0; i < 19; ++i) a.in[i] = (const float*)d_in[i];
    a.out = (float*)d_out; a.ws = (unsigned char*)d_ws; a.pad = 0;
#if MK_ONE_LAUNCH
    a.ph_lo = 0; a.ph_hi = N_PHASES; a.one = 1;
    hipLaunchKernelGGL(trunk_fwd, dim3(grid), dim3(NWAVES * 64), LDS_BYTES, stream, a);
#else
    for (int p = 0; p < N_PHASES; ++p) { a.ph_lo = p; a.ph_hi = p + 1; a.one = 0;
        hipLaunchKernelGGL(trunk_fwd, dim3(grid), dim3(NWAVES * 64), LDS_BYTES, stream, a); }
#endif
}
```
